# Optimizing an MI355X kernel written in HIP

```python
import jax, jax.numpy as jnp
from jax import lax
import numpy as np

D_MODEL = 1024
BATCH = 8
SEQ = 8192
DEPTH = 1
DEC_BATCH = 2
DEC_SEQ = 8192
PAST_LEN = 128

N_HEADS = 8
N_KV_HEADS = 2
HEAD_DIM = 64
GROUP = N_HEADS // N_KV_HEADS
ATTN_WIDTH = N_HEADS * HEAD_DIM
KV_WIDTH = N_KV_HEADS * HEAD_DIM
WINDOW = 128
BLOCK = 128
ROPE_THETA = 10000.0
POOL_WINDOWS = (2, 4, 8, 16)
N_POOL_GROUPS = 4
POOL_GROUP_DIM = 128
POOL_WIDTH = N_POOL_GROUPS * POOL_GROUP_DIM
N_BRANCHES = 2
IN_WIDTH = ATTN_WIDTH + 2 * KV_WIDTH + POOL_WIDTH + N_BRANCHES * D_MODEL
D_FF = 2816
N_SUBLAYERS = 3
FFN_RES_WEIGHT = 0.5
EPS = 1e-6
NEG_INF = -1e30

kernel_name = "hybrid_swa_pool_macaron_encoder"


def rmsnorm(x, g):
    xf = x.astype(jnp.float32)
    y = xf * lax.rsqrt(jnp.mean(xf * xf, axis=-1, keepdims=True) + EPS)
    return (y * g.astype(jnp.float32)).astype(x.dtype)


def rope(x, pos):
    half = HEAD_DIM // 2
    inv_freq = ROPE_THETA ** (-jnp.arange(half, dtype=jnp.float32) / half)
    ang = pos.astype(jnp.float32)[:, None] * inv_freq[None, :]
    cos = jnp.cos(ang)[None, :, None, :]
    sin = jnp.sin(ang)[None, :, None, :]
    xf = x.astype(jnp.float32)
    x1, x2 = xf[..., :half], xf[..., half:]
    out = jnp.concatenate([x1 * cos - x2 * sin, x2 * cos + x1 * sin], axis=-1)
    return out.astype(x.dtype)


def windowed_attention(q, k, v, sink):
    B, S = q.shape[0], q.shape[1]
    nb = S // BLOCK
    qb = jnp.moveaxis(q.reshape(B, nb, BLOCK, N_KV_HEADS, GROUP, HEAD_DIM), 1, 0)
    kp = jnp.pad(k, ((0, 0), (BLOCK, BLOCK), (0, 0), (0, 0)))
    vp = jnp.pad(v, ((0, 0), (BLOCK, BLOCK), (0, 0), (0, 0)))
    scale = HEAD_DIM ** -0.5
    r = jnp.arange(BLOCK)
    jj = jnp.arange(3 * BLOCK)
    sink_g = sink.astype(jnp.float32).reshape(N_KV_HEADS, GROUP)[None, :, :, None, None]

    def block_fn(args):
        i, qi = args
        ki = lax.dynamic_slice_in_dim(kp, i * BLOCK, 3 * BLOCK, axis=1)
        vi = lax.dynamic_slice_in_dim(vp, i * BLOCK, 3 * BLOCK, axis=1)
        s = jnp.einsum('bqkgd,bnkd->bkgqn', qi, ki,
                       preferred_element_type=jnp.float32) * scale
        qpos = i * BLOCK + r
        kpos = (i - 1) * BLOCK + jj
        valid = (jnp.abs(qpos[:, None] - kpos[None, :]) <= WINDOW) & (kpos[None, :] >= 0) & (kpos[None, :] < S)
        s = jnp.where(valid, s, NEG_INF)
        m = jnp.maximum(jnp.max(s, axis=-1, keepdims=True), sink_g)
        p = jnp.exp(s - m)
        p = p / (jnp.sum(p, axis=-1, keepdims=True) + jnp.exp(sink_g - m))
        return jnp.einsum('bkgqn,bnkd->bqkgd', p.astype(vi.dtype), vi)

    out = lax.map(block_fn, (jnp.arange(nb), qb))
    return jnp.moveaxis(out, 0, 1).reshape(B, S, ATTN_WIDTH)


def multiscale_pool(u, pool_w, pool_scale):
    B, S, _ = u.shape
    uf = u.astype(jnp.float32)
    cs = jnp.pad(jnp.cumsum(uf, axis=1), ((0, 0), (1, 0), (0, 0)))
    t = jnp.arange(S)
    outs = []
    for g, w in enumerate(POOL_WINDOWS):
        lo = jnp.clip(t - w // 2, 0, S)
        hi = jnp.clip(t + w // 2, 0, S)
        csg = cs[..., g * POOL_GROUP_DIM:(g + 1) * POOL_GROUP_DIM]
        cnt = (hi - lo).astype(jnp.float32)[None, :, None]
        mean = (csg[:, hi] - csg[:, lo]) / cnt
        outs.append(mean - uf[..., g * POOL_GROUP_DIM:(g + 1) * POOL_GROUP_DIM])
    pooled = jnp.stack(outs, axis=2).astype(u.dtype)
    mixed = jnp.einsum('bsgc,gcd->bsgd', pooled, pool_w).reshape(B, S, POOL_WIDTH)
    return mixed * pool_scale


def swiglu(h, w_gate, w_up, w_down):
    return (jax.nn.silu(h @ w_gate) * (h @ w_up)) @ w_down


def token_mixer(h, w_in, attn_sink, w_attn_branch, pool_w, pool_scale, w_pool_branch, w_out):
    B, S, _ = h.shape
    proj = h @ w_in
    e_q = ATTN_WIDTH
    e_k = e_q + KV_WIDTH
    e_v = e_k + KV_WIDTH
    e_u = e_v + POOL_WIDTH
    q = proj[..., :e_q].reshape(B, S, N_HEADS, HEAD_DIM)
    k = proj[..., e_q:e_k].reshape(B, S, N_KV_HEADS, HEAD_DIM)
    v = proj[..., e_k:e_v].reshape(B, S, N_KV_HEADS, HEAD_DIM)
    u = proj[..., e_v:e_u]
    g_a = proj[..., e_u:e_u + D_MODEL]
    g_b = proj[..., e_u + D_MODEL:]
    pos = jnp.arange(S)
    q = rope(q, pos)
    k = rope(k, pos)
    a = windowed_attention(q, k, v, attn_sink) @ w_attn_branch
    p = multiscale_pool(u, pool_w, pool_scale) @ w_pool_branch
    merged = jax.nn.sigmoid(g_a) * a + jax.nn.sigmoid(g_b) * p
    return merged @ w_out


def encoder_layer(x, c, ada_w, ada_b, norm_pre, norm_post,
                  ffn1_w_gate, ffn1_w_up, ffn1_w_down,
                  w_in, attn_sink, w_attn_branch, pool_w, pool_scale, w_pool_branch, w_out,
                  ffn2_w_gate, ffn2_w_up, ffn2_w_down):
    B = x.shape[0]
    mod = (jax.nn.silu(c) @ ada_w + ada_b).reshape(B, N_SUBLAYERS, 3, D_MODEL)

    def sublayer(x, j, fn, res_w):
        shift = mod[:, j, 0][:, None, :]
        scl = mod[:, j, 1][:, None, :]
        gate = mod[:, j, 2][:, None, :]
        h = rmsnorm(x, norm_pre[j]) * (1.0 + scl) + shift
        y = rmsnorm(fn(h), norm_post[j])
        return x + res_w * gate * y

    x = sublayer(x, 0, lambda h: swiglu(h, ffn1_w_gate, ffn1_w_up, ffn1_w_down), FFN_RES_WEIGHT)
    x = sublayer(x, 1, lambda h: token_mixer(h, w_in, attn_sink, w_attn_branch, pool_w,
                                             pool_scale, w_pool_branch, w_out), 1.0)
    x = sublayer(x, 2, lambda h: swiglu(h, ffn2_w_gate, ffn2_w_up, ffn2_w_down), FFN_RES_WEIGHT)
    return x


def setup_inputs(seed: int = 0) -> dict:
    key = jax.random.key(seed)
    ks = jax.random.split(key, 24)
    f32 = jnp.float32

    def nrm(k, shape, s):
        return jax.random.normal(k, shape, f32) * s

    L = DEPTH
    return {
        "x_prompt": nrm(ks[0], (BATCH, SEQ, D_MODEL), 1.0),
        "x_sample": nrm(ks[1], (DEC_BATCH, DEC_SEQ, D_MODEL), 1.0),
        "c_prompt": nrm(ks[2], (BATCH, D_MODEL), 1.0),
        "c_sample": nrm(ks[3], (DEC_BATCH, D_MODEL), 1.0),
        "ada_w": nrm(ks[4], (L, D_MODEL, N_SUBLAYERS * 3 * D_MODEL), 0.5 * D_MODEL ** -0.5),
        "ada_b": nrm(ks[5], (L, N_SUBLAYERS * 3 * D_MODEL), 0.01),
        "norm_pre": 1.0 + nrm(ks[6], (L, N_SUBLAYERS, D_MODEL), 0.05),
        "norm_post": 1.0 + nrm(ks[7], (L, N_SUBLAYERS, D_MODEL), 0.05),
        "ffn1_w_gate": nrm(ks[8], (L, D_MODEL, D_FF), D_MODEL ** -0.5),
        "ffn1_w_up": nrm(ks[9], (L, D_MODEL, D_FF), D_MODEL ** -0.5),
        "ffn1_w_down": nrm(ks[10], (L, D_FF, D_MODEL), D_FF ** -0.5),
        "w_in": nrm(ks[11], (L, D_MODEL, IN_WIDTH), D_MODEL ** -0.5),
        "attn_sink": nrm(ks[12], (L, N_HEADS), 1.0),
        "w_attn_branch": nrm(ks[13], (L, ATTN_WIDTH, D_MODEL), ATTN_WIDTH ** -0.5),
        "pool_w": nrm(ks[14], (L, N_POOL_GROUPS, POOL_GROUP_DIM, POOL_GROUP_DIM), POOL_GROUP_DIM ** -0.5),
        "pool_scale": 1.0 + nrm(ks[15], (L, POOL_WIDTH), 0.1),
        "w_pool_branch": nrm(ks[16], (L, POOL_WIDTH, D_MODEL), POOL_WIDTH ** -0.5),
        "w_out": nrm(ks[17], (L, D_MODEL, D_MODEL), D_MODEL ** -0.5),
        "ffn2_w_gate": nrm(ks[18], (L, D_MODEL, D_FF), D_MODEL ** -0.5),
        "ffn2_w_up": nrm(ks[19], (L, D_MODEL, D_FF), D_MODEL ** -0.5),
        "ffn2_w_down": nrm(ks[20], (L, D_FF, D_MODEL), D_FF ** -0.5),
    }


def reference(x_prompt, x_sample, c_prompt, c_sample, ada_w, ada_b, norm_pre, norm_post,
              ffn1_w_gate, ffn1_w_up, ffn1_w_down, w_in, attn_sink, w_attn_branch, pool_w,
              pool_scale, w_pool_branch, w_out, ffn2_w_gate, ffn2_w_up, ffn2_w_down):
    y_prompt = x_prompt
    y_sample = x_sample
    for l in range(DEPTH):
        lp = (ada_w[l], ada_b[l], norm_pre[l], norm_post[l],
              ffn1_w_gate[l], ffn1_w_up[l], ffn1_w_down[l],
              w_in[l], attn_sink[l], w_attn_branch[l], pool_w[l], pool_scale[l],
              w_pool_branch[l], w_out[l],
              ffn2_w_gate[l], ffn2_w_up[l], ffn2_w_down[l])
        y_prompt = encoder_layer(y_prompt, c_prompt, *lp)
        y_sample = encoder_layer(y_sample, c_sample, *lp)
    return (y_prompt, y_sample)
```

```cpp
#include <hip/hip_runtime.h>
#include <hip/hip_cooperative_groups.h>
#include <cstdio>
#include <cstdint>
namespace cg = cooperative_groups;

#ifndef MK_MULTI_LAUNCH
#define MK_MULTI_LAUNCH 0
#endif

#define LAS __attribute__((address_space(3)))
typedef unsigned short bf16_t;
typedef short bf16x8 __attribute__((ext_vector_type(8)));
typedef float f32x4 __attribute__((ext_vector_type(4)));
typedef float f32x2 __attribute__((ext_vector_type(2)));
typedef unsigned u32x4 __attribute__((ext_vector_type(4)));
typedef unsigned u32x2 __attribute__((ext_vector_type(2)));

constexpr int D = 1024, SEQ = 8192, NSEQ = 10, NPROMPT = 8, T = NSEQ * SEQ, FF = 2816, NIN = 3328;
constexpr int NMOD = 9 * D;
constexpr float EPS = 1e-6f;
constexpr float LOG2E = 1.4426950408889634f;

constexpr size_t MiB = 1u << 20;
constexpr size_t WS_MOD = 0;
constexpr size_t WS_CT = 1 * MiB, WS_ST = 2 * MiB;
constexpr size_t WS_W1GU = 3 * MiB;
constexpr size_t WS_W1D = 14 * MiB;
constexpr size_t WS_W2GU = 20 * MiB;
constexpr size_t WS_W2D = 31 * MiB;
constexpr size_t WS_WIN = 37 * MiB;
constexpr size_t WS_WAB = 44 * MiB;
constexpr size_t WS_WPB = 45 * MiB;
constexpr size_t WS_WOUT = 46 * MiB;
constexpr size_t WS_H = 48 * MiB;
constexpr size_t WS_Y = 208 * MiB;
constexpr size_t WS_BIG = 368 * MiB;
constexpr size_t WS_Q = WS_BIG, WS_K = WS_Q + 80 * MiB, WS_V = WS_K + 20 * MiB, WS_U = WS_V + 20 * MiB, WS_GA = WS_U + 80 * MiB, WS_GB = WS_GA + 160 * MiB;
constexpr size_t WS_END = WS_GB + 160 * MiB;
static_assert((size_t)T * D * 2 == 160 * MiB && (size_t)T * FF * 2 == 440 * MiB && (size_t)T * 512 * 2 == 80 * MiB && (size_t)T * 128 * 2 == 20 * MiB, "ws map");

constexpr int LDS_BYTES = 135168;

typedef __bf16 bf16x2v __attribute__((ext_vector_type(2)));
__device__ __forceinline__ unsigned cvt_pk_bf16(float lo, float hi) { const f32x2 v = {lo, hi}; return __builtin_bit_cast(unsigned, __builtin_convertvector(v, bf16x2v)); }
__device__ __forceinline__ float bf_lo(unsigned w) { return __builtin_bit_cast(float, w << 16); }
__device__ __forceinline__ float bf_hi(unsigned w) { return __builtin_bit_cast(float, w & 0xffff0000u); }
__device__ __forceinline__ float fast_sigmoid(float x) { return __builtin_amdgcn_rcpf(1.0f + __builtin_amdgcn_exp2f(-x * LOG2E)); }
__device__ __forceinline__ float fast_silu(float x) { return x * fast_sigmoid(x); }
__device__ __forceinline__ float wave_sum(float v) {
#pragma unroll
    for (int o = 1; o < 64; o <<= 1) v += __shfl_xor(v, o);
    return v;
}
#define LDS_WAIT() asm volatile("s_waitcnt lgkmcnt(0)" ::: "memory")

namespace pg8 {
constexpr int BM = 256, BK = 64, HALF = 128, HTB = HALF * BK * 2, STAGE_BYTES = 8 * HTB, NXCD = 8, WGM = 8;
__host__ __device__ __forceinline__ int lds_byte(int r, int c) { const int st = (r >> 4) * 2 + (c >> 5), rr = r & 15, cc = c & 31, ob = rr * 64 + cc * 2; return st * 1024 + (ob ^ (((ob >> 9) & 1) << 5)); }
__host__ __device__ __forceinline__ void stage_rc(int b, int& R, int& C) { const int st = b / 1024, sb = b % 1024, swz = sb ^ (((sb >> 9) & 1) << 5); R = (st >> 1) * 16 + swz / 64; C = (st & 1) * 32 + (swz % 64) / 2; }
__host__ __device__ __forceinline__ int perm32(int rho) { const int n = rho >> 4, i = rho & 15; return 8 * (i >> 2) + 4 * n + (i & 3); }

struct Unit { int pm, pn; };
struct Gemm { const bf16_t* A; const bf16_t* Bt; int M, N, K; };

struct StaticOrder {
    int nM, nN, nwg, G, c;
    __device__ void init(int M, int N, int G_, int c_) { nM = M / BM; nN = N / BM; nwg = nM * nN; G = G_; c = c_; }
    __device__ bool next(int i, Unit& u) const {
        const long L = (long)i * G + c; if (L >= nwg) return false;
        int wgid = (int)L; { const int q = nwg / NXCD, r = nwg % NXCD, xcd = wgid % NXCD, off = wgid / NXCD; wgid = (xcd < r ? xcd * (q + 1) : r * (q + 1) + (xcd - r) * q) + off; }
        const int nig = WGM * nN, gid = wgid / nig, fm = gid * WGM, gsz = (nM - fm) < WGM ? (nM - fm) : WGM;
        u.pm = fm + ((wgid % nig) % gsz); u.pn = (wgid % nig) / gsz; return true;
    }
    __device__ __forceinline__ void a_ready(const Unit&) const {}
    __device__ __forceinline__ void done(const Unit&) const {}
};

typedef f32x4 Acc[2][2][4][2];

struct EpiBf16 {
    static constexpr bool PERM = true, AFTER_DRAIN = false;
    bf16_t* O; int ldc;
    __device__ __forceinline__ void operator()(const Acc& acc, const Unit& u, int wr, int wc, int fr, int fq) const {
        const int row0 = u.pm * BM + wr * 64 + fr, col0 = u.pn * BM + wc * 32 + 8 * fq;
#pragma unroll
        for (int ai = 0; ai < 2; ++ai)
#pragma unroll
            for (int m = 0; m < 4; ++m) { bf16_t* rowp = O + (size_t)(row0 + ai * HALF + m * 16) * ldc + col0;
#pragma unroll
                for (int bj = 0; bj < 2; ++bj) { const f32x4 v0 = acc[ai][bj][m][0], v1 = acc[ai][bj][m][1];
                    u32x4 w; w.x = cvt_pk_bf16(v0[0], v0[1]); w.y = cvt_pk_bf16(v0[2], v0[3]); w.z = cvt_pk_bf16(v1[0], v1[1]); w.w = cvt_pk_bf16(v1[2], v1[3]);
                    *(u32x4*)(rowp + bj * HALF) = w; } }
    }
};

struct EpiSwiGLU {
    static constexpr bool PERM = true, AFTER_DRAIN = false;
    bf16_t* O; int ldc;
    __device__ __forceinline__ void operator()(const Acc& acc, const Unit& u, int wr, int wc, int fr, int fq) const {
        const int row0 = u.pm * BM + wr * 64 + fr, col0 = u.pn * HALF + wc * 32 + 8 * fq;
#pragma unroll
        for (int ai = 0; ai < 2; ++ai)
#pragma unroll
            for (int m = 0; m < 4; ++m) { bf16_t* rowp = O + (size_t)(row0 + ai * HALF + m * 16) * ldc + col0;
                const f32x4 g0 = acc[ai][0][m][0], g1 = acc[ai][0][m][1], u0 = acc[ai][1][m][0], u1 = acc[ai][1][m][1];
                u32x4 w;
                w.x = cvt_pk_bf16(fast_silu(g0[0]) * u0[0], fast_silu(g0[1]) * u0[1]); w.y = cvt_pk_bf16(fast_silu(g0[2]) * u0[2], fast_silu(g0[3]) * u0[3]);
                w.z = cvt_pk_bf16(fast_silu(g1[0]) * u1[0], fast_silu(g1[1]) * u1[1]); w.w = cvt_pk_bf16(fast_silu(g1[2]) * u1[2], fast_silu(g1[3]) * u1[3]);
                *(u32x4*)rowp = w; }
    }
};

struct EpiProj {
    static constexpr bool PERM = true, AFTER_DRAIN = false;
    bf16_t *Q, *K, *V, *U, *GA, *GB; const float *ct, *st;
    __device__ __forceinline__ void rope_store(const Acc& acc, int row0, bf16_t* base, int ld, int colbase, int fq, float sc) const {
#pragma unroll
        for (int ai = 0; ai < 2; ++ai)
#pragma unroll
            for (int m = 0; m < 4; ++m) { const int row = row0 + ai * HALF + m * 16; const int pos = row & (SEQ - 1);
                const float* cp = ct + pos * 32 + 8 * fq; const float* sp = st + pos * 32 + 8 * fq;
                const f32x4 c0 = *(const f32x4*)cp, c1 = *(const f32x4*)(cp + 4), s0 = *(const f32x4*)sp, s1 = *(const f32x4*)(sp + 4);
                const f32x4 a0 = acc[ai][0][m][0] * sc, a1 = acc[ai][0][m][1] * sc, b0 = acc[ai][1][m][0] * sc, b1 = acc[ai][1][m][1] * sc;
                const f32x4 lo0 = a0 * c0 - b0 * s0, lo1 = a1 * c1 - b1 * s1, hi0 = b0 * c0 + a0 * s0, hi1 = b1 * c1 + a1 * s1;
                bf16_t* p = base + (size_t)row * ld + colbase + 8 * fq;
                u32x4 w; w.x = cvt_pk_bf16(lo0[0], lo0[1]); w.y = cvt_pk_bf16(lo0[2], lo0[3]); w.z = cvt_pk_bf16(lo1[0], lo1[1]); w.w = cvt_pk_bf16(lo1[2], lo1[3]);
                *(u32x4*)p = w;
                w.x = cvt_pk_bf16(hi0[0], hi0[1]); w.y = cvt_pk_bf16(hi0[2], hi0[3]); w.z = cvt_pk_bf16(hi1[0], hi1[1]); w.w = cvt_pk_bf16(hi1[2], hi1[3]);
                *(u32x4*)(p + 32) = w;
                asm volatile("" ::: "memory"); }
    }
    template <int ACT> __device__ __forceinline__ void plain_store(const Acc& acc, int row0, bf16_t* base, int ld, int col0) const {
#pragma unroll
        for (int ai = 0; ai < 2; ++ai)
#pragma unroll
            for (int m = 0; m < 4; ++m) { bf16_t* rowp = base + (size_t)(row0 + ai * HALF + m * 16) * ld + col0;
#pragma unroll
                for (int bj = 0; bj < 2; ++bj) { f32x4 v0 = acc[ai][bj][m][0], v1 = acc[ai][bj][m][1];
                    if (ACT == 1) { for (int i = 0; i < 4; ++i) { v0[i] = fast_sigmoid(v0[i]); v1[i] = fast_sigmoid(v1[i]); } }
                    u32x4 w; w.x = cvt_pk_bf16(v0[0], v0[1]); w.y = cvt_pk_bf16(v0[2], v0[3]); w.z = cvt_pk_bf16(v1[0], v1[1]); w.w = cvt_pk_bf16(v1[2], v1[3]);
                    *(u32x4*)(rowp + bj * HALF) = w; }
                asm volatile("" ::: "memory"); }
    }
    __device__ __forceinline__ void operator()(const Acc& acc, const Unit& u, int wr, int wc, int fr, int fq) const {
        int row0 = u.pm * BM + wr * 64 + fr; const int pn = u.pn;
#define OPAQUE_ROW() asm volatile("" : "+v"(row0))
        if (pn < 2) { OPAQUE_ROW(); rope_store(acc, row0, Q, 512, (4 * pn + wc) * 64, fq, 0.125f); }
        else if (pn == 2) {
            if (wc < 2) { OPAQUE_ROW(); rope_store(acc, row0, K, 128, wc * 64, fq, 1.0f); }
            else { OPAQUE_ROW();
#pragma unroll
                for (int ai = 0; ai < 2; ++ai)
#pragma unroll
                    for (int m = 0; m < 4; ++m) { bf16_t* rowp = V + (size_t)(row0 + ai * HALF + m * 16) * 128 + (wc - 2) * 32 + 8 * fq;
#pragma unroll
                        for (int bj = 0; bj < 2; ++bj) { const f32x4 v0 = acc[ai][bj][m][0], v1 = acc[ai][bj][m][1];
                            u32x4 w; w.x = cvt_pk_bf16(v0[0], v0[1]); w.y = cvt_pk_bf16(v0[2], v0[3]); w.z = cvt_pk_bf16(v1[0], v1[1]); w.w = cvt_pk_bf16(v1[2], v1[3]);
                            *(u32x4*)(rowp + bj * 64) = w; } }
            }
        }
        else if (pn < 5) { OPAQUE_ROW(); plain_store<0>(acc, row0, U, 512, (pn - 3) * BM + wc * 32 + 8 * fq); }
        else { OPAQUE_ROW(); bf16_t* gbase = pn < 9 ? GA : GB; const int gt = pn < 9 ? pn - 5 : pn - 9; plain_store<1>(acc, row0, gbase, D, gt * BM + wc * 32 + 8 * fq); }
#undef OPAQUE_ROW
    }
};

template <int MODE> struct EpiGate {
    static constexpr bool PERM = true, AFTER_DRAIN = false;
    bf16_t* O; const bf16_t* Gt;
    __device__ __forceinline__ void operator()(const Acc& acc, const Unit& u, int wr, int wc, int fr, int fq) const {
        const int row0 = u.pm * BM + wr * 64 + fr, col0 = u.pn * BM + wc * 32 + 8 * fq;
#pragma unroll
        for (int ai = 0; ai < 2; ++ai)
#pragma unroll
            for (int m = 0; m < 4; ++m) { const size_t off = (size_t)(row0 + ai * HALF + m * 16) * D + col0;
#pragma unroll
                for (int bj = 0; bj < 2; ++bj) { const f32x4 v0 = acc[ai][bj][m][0], v1 = acc[ai][bj][m][1];
                    const u32x4 g = *(const u32x4*)(Gt + off + bj * HALF);
                    float r[8] = { v0[0] * bf_lo(g.x), v0[1] * bf_hi(g.x), v0[2] * bf_lo(g.y), v0[3] * bf_hi(g.y), v1[0] * bf_lo(g.z), v1[1] * bf_hi(g.z), v1[2] * bf_lo(g.w), v1[3] * bf_hi(g.w) };
                    if (MODE == 1) { const u32x4 o = *(const u32x4*)(O + off + bj * HALF);
                        r[0] += bf_lo(o.x); r[1] += bf_hi(o.x); r[2] += bf_lo(o.y); r[3] += bf_hi(o.y); r[4] += bf_lo(o.z); r[5] += bf_hi(o.z); r[6] += bf_lo(o.w); r[7] += bf_hi(o.w); }
                    u32x4 w; w.x = cvt_pk_bf16(r[0], r[1]); w.y = cvt_pk_bf16(r[2], r[3]); w.z = cvt_pk_bf16(r[4], r[5]); w.w = cvt_pk_bf16(r[6], r[7]);
                    *(u32x4*)(O + off + bj * HALF) = w; }
                asm volatile("" ::: "memory"); }
    }
};

template <class Epi, class Sched, bool ALIGN_EPI = false, bool SP2 = false>
__device__ __forceinline__ void gemm_phase(LAS unsigned char* lds, const Gemm g, const Sched& S, const Epi& E) {
    const int tid = threadIdx.x, wid = __builtin_amdgcn_readfirstlane(tid >> 6), lane = tid & 63, wr = wid >> 2, wc = wid & 3, fr = lane & 15, fq = lane >> 4;
    const int K = g.K, nt = K / BK;
    unsigned voffA[2], voffB[2];
#pragma unroll
    for (int i = 0; i < 2; ++i) { int R, C; stage_rc(tid * 16 + i * 8192, R, C); const int Rb = Epi::PERM ? ((R & ~31) + perm32(R & 31)) : R;
        voffA[i] = (unsigned)(R * K + C) * 2u; voffB[i] = (unsigned)(Rb * K + C) * 2u; }
    const size_t kstep = (size_t)(BK * 2);
    const size_t hstep = (size_t)HALF * K * 2;
    const size_t tstep = 2 * hstep;
    const unsigned ldsw = (unsigned)wid * 1024u;
    const int aoff = lds_byte(wr * 64 + fr, fq * 8), boff = lds_byte(wc * 32 + fr, fq * 8);
#define PG8_SA(b, h) (((b) * 2 + (h)) * HTB)
#define PG8_SB(b, h) ((4 + (b) * 2 + (h)) * HTB)
#define PG8_STAGE(bufoff, gbase, voff) do { _Pragma("unroll") for (int _i = 0; _i < 2; ++_i) \
        __builtin_amdgcn_global_load_lds((const unsigned*)((const char*)(gbase) + (voff)[_i]), (LAS unsigned*)(lds + (bufoff) + ldsw + _i * 8192), 16, 0, 0); } while (0)
#define PG8_LDA(dst, b, h) do { _Pragma("unroll") for (int m = 0; m < 4; ++m) _Pragma("unroll") for (int k = 0; k < 2; ++k) dst[m][k] = *(const LAS bf16x8*)(lds + PG8_SA(b, h) + aoff + m * 2048 + k * 1024); } while (0)
#define PG8_LDB(dst, b, h) do { _Pragma("unroll") for (int n = 0; n < 2; ++n) _Pragma("unroll") for (int k = 0; k < 2; ++k) dst[n][k] = *(const LAS bf16x8*)(lds + PG8_SB(b, h) + boff + n * 2048 + k * 1024); } while (0)
#define PG8_MMA(ai, bj, At, Bt) do { __builtin_amdgcn_s_setprio(1); _Pragma("unroll") for (int m = 0; m < 4; ++m) _Pragma("unroll") for (int n = 0; n < 2; ++n) _Pragma("unroll") for (int k = 0; k < 2; ++k) \
        acc[ai][bj][m][n] = __builtin_amdgcn_mfma_f32_16x16x32_bf16(Bt[n][k], At[m][k], acc[ai][bj][m][n], 0, 0, 0); __builtin_amdgcn_s_setprio(0); } while (0)
#define PG8_WAIT_V(n) asm volatile("s_waitcnt vmcnt(" #n ")" ::: "memory")
#define PG8_WAIT_L(n) asm volatile("s_waitcnt lgkmcnt(" #n ")" ::: "memory")
#define PG8_BAR __builtin_amdgcn_s_barrier()
#define PG8_SCHED __builtin_amdgcn_sched_barrier(0)
    Unit cur, nxt; int ui = 0;
    if (!S.next(0, cur)) return;
    f32x4 acc[2][2][4][2];
#pragma unroll
    for (int a = 0; a < 2; ++a)
#pragma unroll
        for (int b = 0; b < 2; ++b)
#pragma unroll
            for (int m = 0; m < 4; ++m)
#pragma unroll
                for (int n = 0; n < 2; ++n) acc[a][b][m][n] = (f32x4){0.f, 0.f, 0.f, 0.f};
    bf16x8 At[4][2], B0[2][2], B1[2][2];
    const char* cA = (const char*)g.A + (size_t)cur.pm * tstep; const char* cB = (const char*)g.Bt + (size_t)cur.pn * tstep;
    S.a_ready(cur);
    if constexpr (SP2) {
        PG8_STAGE(PG8_SB(0, 0), cB, voffB); PG8_STAGE(PG8_SB(0, 1), cB + hstep, voffB); PG8_STAGE(PG8_SA(0, 0), cA, voffA); PG8_STAGE(PG8_SA(0, 1), cA + hstep, voffA);
        if (wr == 1) PG8_BAR;
        PG8_WAIT_V(2); PG8_BAR;
        PG8_STAGE(PG8_SB(1, 0), cB + kstep, voffB); PG8_STAGE(PG8_SA(1, 0), cA + kstep, voffA); PG8_STAGE(PG8_SB(1, 1), cB + hstep + kstep, voffB);
        PG8_WAIT_V(6); PG8_BAR;
    } else {
        PG8_STAGE(PG8_SB(0, 0), cB, voffB); PG8_STAGE(PG8_SA(0, 0), cA, voffA); PG8_STAGE(PG8_SB(0, 1), cB + hstep, voffB); PG8_STAGE(PG8_SA(0, 1), cA + hstep, voffA);
        if (wr == 1) PG8_BAR;
        PG8_WAIT_V(4); PG8_BAR;
        PG8_STAGE(PG8_SB(1, 0), cB + kstep, voffB); PG8_STAGE(PG8_SA(1, 0), cA + kstep, voffA); PG8_STAGE(PG8_SB(1, 1), cB + hstep + kstep, voffB);
        PG8_WAIT_V(6); PG8_BAR;
    }
    for (;;) {
        const bool has_next = S.next(ui + 1, nxt);
        const char* nA = has_next ? (const char*)g.A + (size_t)nxt.pm * tstep : cA; const char* nB = has_next ? (const char*)g.Bt + (size_t)nxt.pn * tstep : cB;
        for (int t = 0; t < nt; t += 2) {
            const bool last = (t == nt - 2);
            const char* a1 = cA + (size_t)(t + 1) * kstep;
            const char* a2 = last ? nA : cA + (size_t)(t + 2) * kstep; const char* b2 = last ? nB : cB + (size_t)(t + 2) * kstep;
            const char* a3 = a2 + kstep; const char* b3 = b2 + kstep;
            if (last && has_next) S.a_ready(nxt);
            if constexpr (SP2) {
            PG8_LDB(B0, 0, 0); PG8_LDB(B1, 0, 1); PG8_SCHED; PG8_LDA(At, 0, 0); PG8_STAGE(PG8_SA(1, 1), a1 + hstep, voffA);
            PG8_WAIT_V(8); PG8_WAIT_L(0); PG8_BAR; PG8_MMA(0, 0, At, B0); PG8_MMA(0, 1, At, B1); PG8_BAR; PG8_SCHED;
            PG8_LDA(At, 0, 1); PG8_STAGE(PG8_SB(0, 0), b2, voffB); PG8_STAGE(PG8_SB(0, 1), b2 + hstep, voffB); PG8_STAGE(PG8_SA(0, 0), a2, voffA);
            PG8_WAIT_V(8); PG8_WAIT_L(0); PG8_BAR; PG8_MMA(1, 0, At, B0); PG8_MMA(1, 1, At, B1); PG8_BAR; PG8_SCHED;
            PG8_LDB(B0, 1, 0); PG8_LDB(B1, 1, 1); PG8_SCHED; PG8_LDA(At, 1, 0); PG8_STAGE(PG8_SA(0, 1), a2 + hstep, voffA);
            PG8_WAIT_V(8); PG8_WAIT_L(0); PG8_BAR; PG8_MMA(0, 0, At, B0); PG8_MMA(0, 1, At, B1); PG8_BAR; PG8_SCHED;
            PG8_LDA(At, 1, 1); PG8_STAGE(PG8_SB(1, 0), b3, voffB); PG8_STAGE(PG8_SB(1, 1), b3 + hstep, voffB); PG8_STAGE(PG8_SA(1, 0), a3, voffA);
            PG8_WAIT_V(8); PG8_WAIT_L(0); PG8_BAR; PG8_MMA(1, 0, At, B0); PG8_MMA(1, 1, At, B1); PG8_BAR; PG8_SCHED;
            } else {
            PG8_LDB(B0, 0, 0); PG8_SCHED; PG8_LDA(At, 0, 0); PG8_STAGE(PG8_SA(1, 1), a1 + hstep, voffA);
            PG8_WAIT_L(8); PG8_BAR; PG8_WAIT_L(0); PG8_MMA(0, 0, At, B0); PG8_BAR; PG8_SCHED;
            PG8_LDB(B1, 0, 1); PG8_STAGE(PG8_SB(0, 0), b2, voffB);
            PG8_BAR; PG8_WAIT_L(0); PG8_MMA(0, 1, At, B1); PG8_BAR;
            PG8_LDA(At, 0, 1); PG8_STAGE(PG8_SA(0, 0), a2, voffA);
            PG8_BAR; PG8_WAIT_L(0); PG8_MMA(1, 0, At, B0); PG8_BAR; PG8_SCHED;
            PG8_STAGE(PG8_SB(0, 1), b2 + hstep, voffB);
            PG8_WAIT_V(6); PG8_BAR; PG8_MMA(1, 1, At, B1); PG8_BAR;
            PG8_LDB(B0, 1, 0); PG8_SCHED; PG8_LDA(At, 1, 0); PG8_STAGE(PG8_SA(0, 1), a2 + hstep, voffA);
            PG8_WAIT_L(8); PG8_BAR; PG8_WAIT_L(0); PG8_MMA(0, 0, At, B0); PG8_BAR; PG8_SCHED;
            PG8_LDB(B1, 1, 1); PG8_STAGE(PG8_SB(1, 0), b3, voffB);
            PG8_BAR; PG8_WAIT_L(0); PG8_MMA(0, 1, At, B1); PG8_BAR;
            PG8_LDA(At, 1, 1); PG8_STAGE(PG8_SA(1, 0), a3, voffA);
            PG8_BAR; PG8_WAIT_L(0); PG8_MMA(1, 0, At, B0); PG8_BAR; PG8_SCHED;
            PG8_STAGE(PG8_SB(1, 1), b3 + hstep, voffB);
            PG8_WAIT_V(6); PG8_BAR; PG8_MMA(1, 1, At, B1); PG8_BAR;
            }
        }
        if constexpr (ALIGN_EPI) { if (wr == 0) PG8_BAR; }
        if constexpr (!Epi::AFTER_DRAIN) { E(acc, cur, wr, wc, fr, fq); S.done(cur); }
        if (!has_next) break;
#pragma unroll
        for (int a = 0; a < 2; ++a)
#pragma unroll
            for (int b = 0; b < 2; ++b)
#pragma unroll
                for (int m = 0; m < 4; ++m)
#pragma unroll
                    for (int n = 0; n < 2; ++n) acc[a][b][m][n] = (f32x4){0.f, 0.f, 0.f, 0.f};
        cur = nxt; cA = nA; cB = nB; ++ui;
        if constexpr (ALIGN_EPI) { if (wr == 1) PG8_BAR; }
    }
    PG8_WAIT_V(0);
    if constexpr (!ALIGN_EPI) { if (wr == 0) PG8_BAR; }
    PG8_BAR;
#undef PG8_SA
#undef PG8_SB
#undef PG8_STAGE
#undef PG8_LDA
#undef PG8_LDB
#undef PG8_MMA
#undef PG8_WAIT_V
#undef PG8_WAIT_L
#undef PG8_BAR
#undef PG8_SCHED
}
}

struct Args { const float* in[21]; float* out; unsigned char* ws; int ph_lo, ph_hi; };
enum { I_XP = 0, I_XS, I_CP, I_CS, I_ADAW, I_ADAB, I_NPRE, I_NPOST, I_F1G, I_F1U, I_F1D, I_WIN, I_SINK, I_WAB, I_POOLW, I_POOLS, I_WPB, I_WOUT, I_F2G, I_F2U, I_F2D };

__device__ __forceinline__ int map_row(int mode, int n0) {
    if (mode == 0) return n0;
    if (mode == 1) return 256 * (n0 >> 7) + (n0 & 127);
    if (mode == 2) return 256 * (n0 >> 7) + 128 + (n0 & 127);
    if (n0 < 512) { const int head = n0 >> 6, half = (n0 >> 5) & 1; return 256 * (head >> 2) + 128 * half + (head & 3) * 32; }
    if (n0 < 640) { const int kh = (n0 - 512) >> 6, half = (n0 >> 5) & 1; return 512 + 128 * half + kh * 32; }
    if (n0 < 768) { const int vv = n0 - 640; return 512 + 128 * (vv >> 6) + 64 + (vv & 63); }
    return n0;
}
__device__ __forceinline__ void transpose_item(const float* W, int K, int N, bf16_t* WT, int mode, LAS float* scr, int item, int lane) {
    const int nblk = N / 32, kb = item / nblk, nb = item % nblk, k0 = 64 * kb, n0 = 32 * nb;
#pragma unroll 8
    for (int i = 0; i < 32; ++i) { const int kk = 2 * i + (lane >> 5); scr[kk * 33 + (lane & 31)] = W[(size_t)(k0 + kk) * N + n0 + (lane & 31)]; }
    LDS_WAIT();
    const int rb = map_row(mode, n0);
    const int c = lane & 7;
#pragma unroll
    for (int j = 0; j < 4; ++j) { const int n = (lane >> 3) + 8 * j; const LAS float* s = scr + (8 * c) * 33 + n;
        u32x4 o; o.x = cvt_pk_bf16(s[0 * 33], s[1 * 33]); o.y = cvt_pk_bf16(s[2 * 33], s[3 * 33]); o.z = cvt_pk_bf16(s[4 * 33], s[5 * 33]); o.w = cvt_pk_bf16(s[6 * 33], s[7 * 33]);
        *(u32x4*)(WT + (size_t)(rb + n) * K + k0 + 8 * c) = o; }
    LDS_WAIT();
}

__device__ __forceinline__ void prep_phase(LAS unsigned char* lds, const Args& a, int G, int bid) {
    const int tid = threadIdx.x, lane = tid & 63, wid = tid >> 6;
    unsigned char* ws = a.ws;
    if (bid < 144) {
        LAS float* sc = (LAS float*)lds;
        LAS float* part = (LAS float*)(lds + 40960);
        for (int i = tid; i < NSEQ * D; i += 512) { const int b = i >> 10, k = i & 1023; const float c = (b < NPROMPT) ? a.in[I_CP][b * D + k] : a.in[I_CS][(b - NPROMPT) * D + k]; sc[i] = c / (1.0f + expf(-c)); }
        __syncthreads();
        float* mod = (float*)(ws + WS_MOD);
        for (int it = bid; it < 144; it += G) {
            const int j0 = it * 64;
            float acc[NSEQ];
#pragma unroll
            for (int b = 0; b < NSEQ; ++b) acc[b] = 0.f;
            const float* w = a.in[I_ADAW] + (size_t)(wid * 128) * NMOD + j0 + lane;
#pragma unroll 4
            for (int k = 0; k < 128; ++k) { const float wv = w[(size_t)k * NMOD];
#pragma unroll
                for (int b = 0; b < NSEQ; ++b) acc[b] += sc[b * D + wid * 128 + k] * wv; }
#pragma unroll
            for (int b = 0; b < NSEQ; ++b) part[(wid * NSEQ + b) * 64 + lane] = acc[b];
            __syncthreads();
            for (int i = tid; i < NSEQ * 64; i += 512) { const int b = i >> 6, l = i & 63; float s = a.in[I_ADAB][j0 + l];
#pragma unroll
                for (int w8 = 0; w8 < 8; ++w8) s += part[(w8 * NSEQ + b) * 64 + l];
                mod[b * NMOD + j0 + l] = s; }
            __syncthreads();
        }
    }
    __syncthreads();
    LAS float* scr = (LAS float*)(lds + wid * 16384);
    const int gw = bid * 8 + wid, NGW = G * 8;
    constexpr int I_GU = (D / 64) * (FF / 32), I_DN = (FF / 64) * (D / 32), I_IN = (D / 64) * (NIN / 32), I_AB = (512 / 64) * (D / 32), I_OUT = (D / 64) * (D / 32);
    constexpr int NITEMS = 4 * I_GU + 2 * I_DN + I_IN + I_AB + I_OUT;
    for (int it = gw; it < NITEMS; it += NGW) {
        int r = it;
        if (r < I_GU) { transpose_item(a.in[I_F1G], D, FF, (bf16_t*)(ws + WS_W1GU), 1, scr, r, lane); continue; } r -= I_GU;
        if (r < I_GU) { transpose_item(a.in[I_F1U], D, FF, (bf16_t*)(ws + WS_W1GU), 2, scr, r, lane); continue; } r -= I_GU;
        if (r < I_GU) { transpose_item(a.in[I_F2G], D, FF, (bf16_t*)(ws + WS_W2GU), 1, scr, r, lane); continue; } r -= I_GU;
        if (r < I_GU) { transpose_item(a.in[I_F2U], D, FF, (bf16_t*)(ws + WS_W2GU), 2, scr, r, lane); continue; } r -= I_GU;
        if (r < I_DN) { transpose_item(a.in[I_F1D], FF, D, (bf16_t*)(ws + WS_W1D), 0, scr, r, lane); continue; } r -= I_DN;
        if (r < I_DN) { transpose_item(a.in[I_F2D], FF, D, (bf16_t*)(ws + WS_W2D), 0, scr, r, lane); continue; } r -= I_DN;
        if (r < I_IN) { transpose_item(a.in[I_WIN], D, NIN, (bf16_t*)(ws + WS_WIN), 3, scr, r, lane); continue; } r -= I_IN;
        if (r < I_AB) { transpose_item(a.in[I_WAB], 512, D, (bf16_t*)(ws + WS_WAB), 0, scr, r, lane); continue; } r -= I_AB;
        transpose_item(a.in[I_WOUT], D, D, (bf16_t*)(ws + WS_WOUT), 0, scr, r, lane);
    }
    {
        const float* pw = a.in[I_POOLW]; const float* ps = a.in[I_POOLS]; const float* wpb = a.in[I_WPB]; bf16_t* o = (bf16_t*)(ws + WS_WPB);
        for (int it = gw; it < 2048; it += NGW) {
            const int nq = it & 3, c = (it >> 2) & 127, g = it >> 9;
            scr[lane] = pw[(g * 128 + c) * 128 + lane] * ps[g * 128 + lane];
            scr[lane + 64] = pw[(g * 128 + c) * 128 + lane + 64] * ps[g * 128 + lane + 64];
            LDS_WAIT();
            for (int nc = 0; nc < 4; ++nc) { const int n = nq * 256 + nc * 64 + lane; float s = 0.f; const float* wp = wpb + (size_t)(g * 128) * D + n;
#pragma unroll 8
                for (int d = 0; d < 128; ++d) s += scr[d] * wp[(size_t)d * D];
                o[(size_t)n * 512 + g * 128 + c] = (bf16_t)(cvt_pk_bf16(s, 0.f) & 0xffffu); }
            LDS_WAIT();
        }
    }
    {
        float* ct = (float*)(ws + WS_CT); float* st = (float*)(ws + WS_ST);
        for (int i = bid * 512 + tid; i < SEQ * 32; i += G * 512) { const int pos = i >> 5, f = i & 31;
            const float inv = exp2f(-(float)f * (13.287712379549449f / 32.0f));
            const float ang = (float)pos * inv;
            const double ad = (double)ang; const double kk = rint(ad * 0.15915494309189535);
            double r = fma(-kk, 6.283185307179586, ad); r = fma(-kk, 2.4492935982947064e-16, r);
            const float rf = (float)r;
            ct[i] = cosf(rf); st[i] = sinf(rf); }
    }
}

__device__ __forceinline__ const float* xrow_in(const Args& a, int row) { return row < NPROMPT * SEQ ? a.in[I_XP] + (size_t)row * D : a.in[I_XS] + (size_t)(row - NPROMPT * SEQ) * D; }

template <int MODE> __device__ __forceinline__ void norm_phase(const Args& a, int j, float rw, int G, int bid) {
    const int tid = threadIdx.x, lane = tid & 63, wid = tid >> 6;
    const int gw = bid * 8 + wid, NGW = G * 8;
    const float* mod = (const float*)(a.ws + WS_MOD);
    const bf16_t* Y = (const bf16_t*)(a.ws + WS_Y); bf16_t* H = (bf16_t*)(a.ws + WS_H);
    const float* npre = a.in[I_NPRE]; const float* npost = a.in[I_NPOST];
    for (int row = gw; row < T; row += NGW) {
        const int b = row >> 13;
        f32x4 x[4];
        if (MODE == 0) {
            const f32x4* xr = (const f32x4*)xrow_in(a, row) + lane;
#pragma unroll
            for (int q = 0; q < 4; ++q) x[q] = xr[64 * q];
        } else {
            const f32x4* xr = (j == 0) ? (const f32x4*)xrow_in(a, row) + lane : (const f32x4*)(a.out + (size_t)row * D) + lane;
            const u32x2* yr = (const u32x2*)(Y + (size_t)row * D) + lane;
            f32x4 y[4]; float ss = 0.f;
#pragma unroll
            for (int q = 0; q < 4; ++q) { x[q] = xr[64 * q]; const u32x2 w = yr[64 * q]; y[q] = (f32x4){bf_lo(w.x), bf_hi(w.x), bf_lo(w.y), bf_hi(w.y)};
                ss += (y[q][0] * y[q][0] + y[q][1] * y[q][1]) + (y[q][2] * y[q][2] + y[q][3] * y[q][3]); }
            const float rstd = rsqrtf(wave_sum(ss) * (1.0f / D) + EPS);
            const f32x4* gp = (const f32x4*)(npost + j * D) + lane; const f32x4* gt = (const f32x4*)(mod + (size_t)b * NMOD + j * 3 * D + 2 * D) + lane;
            f32x4* xo = (f32x4*)(a.out + (size_t)row * D) + lane;
#pragma unroll
            for (int q = 0; q < 4; ++q) { x[q] = x[q] + (y[q] * rstd) * gp[64 * q] * (gt[64 * q] * rw); xo[64 * q] = x[q]; }
        }
        if (MODE != 2) {
            const int jn = (MODE == 0) ? j : j + 1;
            float ss = 0.f;
#pragma unroll
            for (int q = 0; q < 4; ++q) ss += (x[q][0] * x[q][0] + x[q][1] * x[q][1]) + (x[q][2] * x[q][2] + x[q][3] * x[q][3]);
            const float rstd = rsqrtf(wave_sum(ss) * (1.0f / D) + EPS);
            const f32x4* gp = (const f32x4*)(npre + jn * D) + lane; const f32x4* sh = (const f32x4*)(mod + (size_t)b * NMOD + jn * 3 * D) + lane; const f32x4* sc = sh + D / 4;
            u32x2* ho = (u32x2*)(H + (size_t)row * D) + lane;
#pragma unroll
            for (int q = 0; q < 4; ++q) { const f32x4 h = (x[q] * rstd) * gp[64 * q] * (sc[64 * q] + 1.0f) + sh[64 * q];
                u32x2 w; w.x = cvt_pk_bf16(h[0], h[1]); w.y = cvt_pk_bf16(h[2], h[3]); ho[64 * q] = w; }
        }
    }
}

namespace att {
constexpr int KSTR = 144;
constexpr int VSTR = 784;
constexpr int K_OFF = 0, V_OFF = 384 * KSTR, BYTES = V_OFF + 64 * VSTR;
static_assert(BYTES <= 131072, "attention LDS");
}
__device__ __forceinline__ void attn_phase(LAS unsigned char* lds, const bf16_t* Q, const bf16_t* K, const bf16_t* V, bf16_t* O, const float* sink, int G, int bid) {
    using namespace att;
    const int tid = threadIdx.x, lane = tid & 63, wid = tid >> 6, fr = lane & 15, fq = lane >> 4;
    for (int unit = bid; unit < NSEQ * 64 * 2; unit += G) {
        const int kvh = unit & 1, blk = (unit >> 1) & 63, b = unit >> 7;
        const size_t seq0 = (size_t)b * SEQ;
        const int kp0 = (blk - 1) * 128;
        __syncthreads();
#pragma unroll
        for (int it = 0; it < 6; ++it) {
            const int id = tid + 512 * it, row = id >> 3, ch = id & 7; const int kpos = kp0 + row;
            u32x4 kv = {0u, 0u, 0u, 0u}, vv = {0u, 0u, 0u, 0u};
            if (kpos >= 0 && kpos < SEQ) { const size_t off = (seq0 + kpos) * 128 + kvh * 64 + ch * 8; kv = *(const u32x4*)(K + off); vv = *(const u32x4*)(V + off); }
            *(LAS u32x4*)(lds + K_OFF + row * KSTR + ch * 16) = kv;
            LAS unsigned short* vt = (LAS unsigned short*)(lds + V_OFF + (ch * 8) * VSTR + row * 2);
            vt[0 * (VSTR / 2)] = (unsigned short)(vv.x & 0xffffu); vt[1 * (VSTR / 2)] = (unsigned short)(vv.x >> 16);
            vt[2 * (VSTR / 2)] = (unsigned short)(vv.y & 0xffffu); vt[3 * (VSTR / 2)] = (unsigned short)(vv.y >> 16);
            vt[4 * (VSTR / 2)] = (unsigned short)(vv.z & 0xffffu); vt[5 * (VSTR / 2)] = (unsigned short)(vv.z >> 16);
            vt[6 * (VSTR / 2)] = (unsigned short)(vv.w & 0xffffu); vt[7 * (VSTR / 2)] = (unsigned short)(vv.w >> 16);
        }
        __syncthreads();
        const int qg = wid;
        const int jt0 = qg < 6 ? qg : 6;
        const int r = qg * 16 + fr;
        const size_t qrow = seq0 + (size_t)blk * 128 + r;
        for (int h4 = 0; h4 < 4; ++h4) {
            const int head = kvh * 4 + h4;
            const bf16x8 qf0 = *(const bf16x8*)(Q + qrow * 512 + head * 64 + fq * 8);
            const bf16x8 qf1 = *(const bf16x8*)(Q + qrow * 512 + head * 64 + 32 + fq * 8);
            f32x4 s[18];
            const LAS unsigned char* kb = lds + K_OFF + (jt0 * 16 + fr) * KSTR + fq * 16;
#pragma unroll
            for (int t = 0; t < 18; ++t) {
                const bf16x8 k0 = *(const LAS bf16x8*)(kb + t * 16 * KSTR), k1 = *(const LAS bf16x8*)(kb + t * 16 * KSTR + 64);
                f32x4 c = {0.f, 0.f, 0.f, 0.f};
                c = __builtin_amdgcn_mfma_f32_16x16x32_bf16(k0, qf0, c, 0, 0, 0);
                c = __builtin_amdgcn_mfma_f32_16x16x32_bf16(k1, qf1, c, 0, 0, 0);
                s[t] = c;
            }
            const float sk = sink[head];
            float mx = sk;
            int jlo = r > -kp0 ? r : -kp0, jhi = (r + 256) < (SEQ - 1 - kp0) ? (r + 256) : (SEQ - 1 - kp0);
            int d0 = jt0 * 16 + fq * 4 - jlo; unsigned span = (unsigned)(jhi - jlo);
            asm volatile("" : "+v"(d0), "+v"(span));
#pragma unroll
            for (int t = 0; t < 18; ++t)
#pragma unroll
                for (int e = 0; e < 4; ++e) { const bool valid = (unsigned)(d0 + t * 16 + e) <= span;
                    const float v = valid ? s[t][e] : -1e30f; s[t][e] = v; mx = fmaxf(mx, v); }
            mx = fmaxf(mx, __shfl_xor(mx, 16)); mx = fmaxf(mx, __shfl_xor(mx, 32));
            float l = 0.f;
#pragma unroll
            for (int t = 0; t < 18; ++t)
#pragma unroll
                for (int e = 0; e < 4; ++e) { const float p = __builtin_amdgcn_exp2f((s[t][e] - mx) * LOG2E); s[t][e] = p; l += p; }
            l += __shfl_xor(l, 16); l += __shfl_xor(l, 32);
            l += __builtin_amdgcn_exp2f((sk - mx) * LOG2E);
            const float inv = 1.0f / l;
            f32x4 o[4];
#pragma unroll
            for (int dt = 0; dt < 4; ++dt) o[dt] = (f32x4){0.f, 0.f, 0.f, 0.f};
#pragma unroll
            for (int pp = 0; pp < 9; ++pp) {
                u32x4 pw; pw.x = cvt_pk_bf16(s[2 * pp][0], s[2 * pp][1]); pw.y = cvt_pk_bf16(s[2 * pp][2], s[2 * pp][3]);
                pw.z = cvt_pk_bf16(s[2 * pp + 1][0], s[2 * pp + 1][1]); pw.w = cvt_pk_bf16(s[2 * pp + 1][2], s[2 * pp + 1][3]);
                const bf16x8 pf = __builtin_bit_cast(bf16x8, pw);
#pragma unroll
                for (int dt = 0; dt < 4; ++dt) {
                    const LAS unsigned char* vb = lds + V_OFF + (dt * 16 + fr) * VSTR + ((jt0 + 2 * pp) * 16 + fq * 4) * 2;
                    const u32x2 va = *(const LAS u32x2*)vb, vc = *(const LAS u32x2*)(vb + 32);
                    u32x4 vw; vw.x = va.x; vw.y = va.y; vw.z = vc.x; vw.w = vc.y;
                    o[dt] = __builtin_amdgcn_mfma_f32_16x16x32_bf16(__builtin_bit_cast(bf16x8, vw), pf, o[dt], 0, 0, 0);
                }
            }
            bf16_t* op = O + qrow * 512 + head * 64 + fq * 4;
#pragma unroll
            for (int dt = 0; dt < 4; ++dt) { u32x2 w; w.x = cvt_pk_bf16(o[dt][0] * inv, o[dt][1] * inv); w.y = cvt_pk_bf16(o[dt][2] * inv, o[dt][3] * inv); *(u32x2*)(op + dt * 16) = w; }
        }
    }
}
__device__ __forceinline__ void pool_phase(const bf16_t* U, bf16_t* P, int G, int bid) {
    const int tid = threadIdx.x;
    for (int id = bid * 512 + tid; id < T * 64; id += G * 512) {
        const int t = id >> 6, ch = id & 63, g = ch >> 4, hw = 1 << g;
        const int s = t & (SEQ - 1); const int lo = (s - hw) < 0 ? 0 : (s - hw), hi = (s + hw) > SEQ ? SEQ : (s + hw);
        const bf16_t* base = U + (size_t)(t - s) * 512 + ch * 8;
        float acc[8];
#pragma unroll
        for (int e = 0; e < 8; ++e) acc[e] = 0.f;
        for (int p = lo; p < hi; ++p) { const u32x4 w = *(const u32x4*)(base + (size_t)p * 512);
            acc[0] += bf_lo(w.x); acc[1] += bf_hi(w.x); acc[2] += bf_lo(w.y); acc[3] += bf_hi(w.y); acc[4] += bf_lo(w.z); acc[5] += bf_hi(w.z); acc[6] += bf_lo(w.w); acc[7] += bf_hi(w.w); }
        const float ic = 1.0f / (float)(hi - lo);
        const u32x4 w = *(const u32x4*)(base + (size_t)s * 512);
        u32x4 o; o.x = cvt_pk_bf16(acc[0] * ic - bf_lo(w.x), acc[1] * ic - bf_hi(w.x)); o.y = cvt_pk_bf16(acc[2] * ic - bf_lo(w.y), acc[3] * ic - bf_hi(w.y));
        o.z = cvt_pk_bf16(acc[4] * ic - bf_lo(w.z), acc[5] * ic - bf_hi(w.z)); o.w = cvt_pk_bf16(acc[6] * ic - bf_lo(w.w), acc[7] * ic - bf_hi(w.w));
        *(u32x4*)(P + (size_t)t * 512 + ch * 8) = o;
    }
}

__global__ void __launch_bounds__(512, 2) mega_fwd(Args a) {
    extern __shared__ __attribute__((aligned(16))) unsigned char lds_raw[];
    LAS unsigned char* lds = (LAS unsigned char*)lds_raw;
    const int G = gridDim.x, bid = blockIdx.x;
    unsigned char* ws = a.ws;
#define IN(k) (a.ph_lo <= (k) && (k) < a.ph_hi)
#define SEAM(k) do { if (IN(k) && IN((k) + 1)) { __builtin_amdgcn_fence(__ATOMIC_RELEASE, "agent"); asm volatile("s_waitcnt vmcnt(0) lgkmcnt(0)" ::: "memory"); \
        cg::this_grid().sync(); \
        __builtin_amdgcn_fence(__ATOMIC_ACQUIRE, "agent"); asm volatile("s_waitcnt vmcnt(0)" ::: "memory"); } } while (0)
    typedef pg8::StaticOrder SO;
    bf16_t* H = (bf16_t*)(ws + WS_H); bf16_t* Y = (bf16_t*)(ws + WS_Y); bf16_t* ACT = (bf16_t*)(ws + WS_BIG);

    if (IN(0)) prep_phase(lds, a, G, bid);
    SEAM(0);
    if (IN(1)) norm_phase<0>(a, 0, 0.f, G, bid);
    SEAM(1);
    if (IN(2)) { pg8::Gemm g{H, (const bf16_t*)(ws + WS_W1GU), T, 2 * FF, D}; SO S; S.init(T, 2 * FF, G, bid); pg8::EpiSwiGLU E{ACT, FF};
        pg8::gemm_phase<pg8::EpiSwiGLU, SO, true, true>(lds, g, S, E); }
    SEAM(2);
    if (IN(3)) { pg8::Gemm g{ACT, (const bf16_t*)(ws + WS_W1D), T, D, FF}; SO S; S.init(T, D, G, bid); pg8::EpiBf16 E{Y, D};
        pg8::gemm_phase<pg8::EpiBf16, SO, true, true>(lds, g, S, E); }
    SEAM(3);
    if (IN(4)) norm_phase<1>(a, 0, 0.5f, G, bid);
    SEAM(4);
    if (IN(5)) { pg8::Gemm g{H, (const bf16_t*)(ws + WS_WIN), T, NIN, D}; SO S; S.init(T, NIN, G, bid);
        pg8::EpiProj E{(bf16_t*)(ws + WS_Q), (bf16_t*)(ws + WS_K), (bf16_t*)(ws + WS_V), (bf16_t*)(ws + WS_U), (bf16_t*)(ws + WS_GA), (bf16_t*)(ws + WS_GB), (const float*)(ws + WS_CT), (const float*)(ws + WS_ST)};
        pg8::gemm_phase<pg8::EpiProj, SO, true, true>(lds, g, S, E); }
    SEAM(5);
    if (IN(6)) {
        attn_phase(lds, (const bf16_t*)(ws + WS_Q), (const bf16_t*)(ws + WS_K), (const bf16_t*)(ws + WS_V), Y, a.in[I_SINK], G, bid);
        pool_phase((const bf16_t*)(ws + WS_U), Y + (size_t)T * 512, G, bid);
        __syncthreads();
    }
    SEAM(6);
    if (IN(7)) {
        { pg8::Gemm g{Y, (const bf16_t*)(ws + WS_WAB), T, D, 512}; SO S; S.init(T, D, G, bid); pg8::EpiGate<0> E{H, (const bf16_t*)(ws + WS_GA)};
          pg8::gemm_phase<pg8::EpiGate<0>, SO, true, true>(lds, g, S, E); }
        { pg8::Gemm g{Y + (size_t)T * 512, (const bf16_t*)(ws + WS_WPB), T, D, 512}; SO S; S.init(T, D, G, bid); pg8::EpiGate<1> E{H, (const bf16_t*)(ws + WS_GB)};
          pg8::gemm_phase<pg8::EpiGate<1>, SO, true, true>(lds, g, S, E); }
    }
    SEAM(7);
    if (IN(8)) { pg8::Gemm g{H, (const bf16_t*)(ws + WS_WOUT), T, D, D}; SO S; S.init(T, D, G, bid); pg8::EpiBf16 E{Y, D};
        pg8::gemm_phase<pg8::EpiBf16, SO, true, true>(lds, g, S, E); }
    SEAM(8);
    if (IN(9)) norm_phase<1>(a, 1, 1.0f, G, bid);
    SEAM(9);
    if (IN(10)) { pg8::Gemm g{H, (const bf16_t*)(ws + WS_W2GU), T, 2 * FF, D}; SO S; S.init(T, 2 * FF, G, bid); pg8::EpiSwiGLU E{ACT, FF};
        pg8::gemm_phase<pg8::EpiSwiGLU, SO, true, true>(lds, g, S, E); }
    SEAM(10);
    if (IN(11)) { pg8::Gemm g{ACT, (const bf16_t*)(ws + WS_W2D), T, D, FF}; SO S; S.init(T, D, G, bid); pg8::EpiBf16 E{Y, D};
        pg8::gemm_phase<pg8::EpiBf16, SO, true, true>(lds, g, S, E); }
    SEAM(11);
    if (IN(12)) norm_phase<2>(a, 2, 0.5f, G, bid);
#undef IN
#undef SEAM
}

__global__ void chk_kernel(const unsigned* p, size_t nwords, unsigned long long* dst) {
    unsigned long long s = 0;
    for (size_t i = (size_t)blockIdx.x * blockDim.x + threadIdx.x; i < nwords; i += (size_t)gridDim.x * blockDim.x) s += p[i];
    atomicAdd(dst, s);
}
__global__ void verdict_kernel(const unsigned long long* chk, float* out, size_t n) {
    int code = 0;
    for (int p = 0; p < 6; ++p) if (chk[p] != chk[16 + p]) code |= 1 << p;
    for (size_t i = (size_t)blockIdx.x * blockDim.x + threadIdx.x; i < n; i += (size_t)gridDim.x * blockDim.x) out[i] = (float)code;
}
constexpr int NPHASE = 13;
extern "C" void kernel_launch(void* const* d_in, const int* in_sizes, int n_in, void* d_out, int out_size, void* d_ws, size_t ws_size, hipStream_t stream) {
    static int grid = 0;
    if (grid == 0) {
        if (n_in != 21 || out_size != T * D || ws_size < WS_END) { fprintf(stderr, "kernel_launch: unexpected shapes: n_in %d out %d ws %zu (need %zu)\n", n_in, out_size, ws_size, (size_t)WS_END); grid = -1; return; }
        int dev = 0, cus = 0, per_cu = 0;
        if (hipGetDevice(&dev) != hipSuccess || hipDeviceGetAttribute(&cus, hipDeviceAttributeMultiprocessorCount, dev) != hipSuccess) { grid = -1; return; }
        if (hipFuncSetAttribute((const void*)mega_fwd, hipFuncAttributeMaxDynamicSharedMemorySize, LDS_BYTES) != hipSuccess) { fprintf(stderr, "kernel_launch: hipFuncSetAttribute failed\n"); grid = -1; return; }
        if (hipOccupancyMaxActiveBlocksPerMultiprocessor(&per_cu, (const void*)mega_fwd, 512, LDS_BYTES) != hipSuccess || per_cu < 1) { fprintf(stderr, "kernel_launch: occupancy query says %d\n", per_cu); per_cu = 1; }
        (void)hipGetLastError();
        grid = cus * 1;
    }
    if (grid < 0) return;
    Args a{};
    for (int i = 0; i < 21; ++i) a.in[i] = (const float*)d_in[i];
    a.out = (float*)d_out; a.ws = (unsigned char*)d_ws;
#if MK_MULTI_LAUNCH == 2
    {
        unsigned char* ws = (unsigned char*)d_ws; unsigned long long* chk = (unsigned long long*)(ws + 900 * MiB);
        (void)hipMemsetAsync(chk, 0, 4096, stream);
        const size_t offs[7] = {WS_Q, WS_K, WS_V, WS_U, WS_GA, WS_GB, WS_END};
        for (int run = 0; run < 2; ++run) {
            for (int p = 0; p < 6; ++p) { a.ph_lo = p; a.ph_hi = p + 1; hipLaunchKernelGGL(mega_fwd, dim3(grid), dim3(512), LDS_BYTES, stream, a); }
            for (int i = 0; i < 6; ++i) hipLaunchKernelGGL(chk_kernel, dim3(2048), dim3(256), 0, stream, (const unsigned*)(ws + offs[i]), (offs[i + 1] - offs[i]) / 4, chk + run * 16 + i);
        }
        hipLaunchKernelGGL(verdict_kernel, dim3(2048), dim3(256), 0, stream, (const unsigned long long*)chk, (float*)d_out, (size_t)T * D);
    }
#elif MK_MULTI_LAUNCH
    for (int p = 0; p < NPHASE; ++p) { a.ph_lo = p; a.ph_hi = p + 1; hipLaunchKernelGGL(mega_fwd, dim3(grid), dim3(512), LDS_BYTES, stream, a); }
#else
    a.ph_lo = 0; a.ph_hi = NPHASE;
    void* args[] = {&a};
    hipError_t e = hipLaunchCooperativeKernel((const void*)mega_fwd, dim3(grid), dim3(512), args, LDS_BYTES, stream);
    if (e != hipSuccess) fprintf(stderr, "kernel_launch: cooperative launch failed: %s (grid %d)\n", hipGetErrorString(e), grid);
#endif
}
```

```cpp
#include <hip/hip_runtime.h>
#include <hip/hip_cooperative_groups.h>
#include <cstdio>
#include <cstdint>
namespace cg = cooperative_groups;

#ifndef MK_MULTI_LAUNCH
#define MK_MULTI_LAUNCH 0
#endif
#ifndef MK_GEMM_REP
#define MK_GEMM_REP 1
#endif
#ifndef MK_DUP
#define MK_DUP -1
#endif

#define LAS __attribute__((address_space(3)))
typedef unsigned short bf16_t;
typedef short bf16x8 __attribute__((ext_vector_type(8)));
typedef float f32x4 __attribute__((ext_vector_type(4)));
typedef float f32x2 __attribute__((ext_vector_type(2)));
typedef unsigned u32x4 __attribute__((ext_vector_type(4)));
typedef unsigned u32x2 __attribute__((ext_vector_type(2)));

constexpr int D = 1024, SEQ = 8192, NSEQ = 10, NPROMPT = 8, T = NSEQ * SEQ, FF = 2816, NIN = 3328;
constexpr int NMOD = 9 * D;
constexpr float EPS = 1e-6f;
constexpr float LOG2E = 1.4426950408889634f;

constexpr size_t MiB = 1u << 20;
constexpr size_t WS_MOD = 0;
constexpr size_t WS_CTL = 384 * 1024, CTL_BYTES = 16 * 1024;
constexpr size_t WS_CT = 1 * MiB, WS_ST = 2 * MiB;
constexpr size_t WS_W1GU = 3 * MiB;
constexpr size_t WS_W1D = 14 * MiB;
constexpr size_t WS_W2GU = 20 * MiB;
constexpr size_t WS_W2D = 31 * MiB;
constexpr size_t WS_WIN = 37 * MiB;
constexpr size_t WS_WAB = 44 * MiB;
constexpr size_t WS_WPB = 45 * MiB;
constexpr size_t WS_WOUT = 46 * MiB;
constexpr size_t WS_H = 48 * MiB;
constexpr size_t WS_Y = 208 * MiB;
constexpr size_t WS_BIG = 368 * MiB;
constexpr size_t WS_Q = WS_BIG, WS_K = WS_Q + 80 * MiB, WS_V = WS_K + 20 * MiB, WS_U = WS_V + 20 * MiB, WS_GA = WS_U + 80 * MiB, WS_GB = WS_GA + 160 * MiB;
constexpr size_t WS_END = WS_GB + 160 * MiB;
static_assert((size_t)T * D * 2 == 160 * MiB && (size_t)T * FF * 2 == 440 * MiB && (size_t)T * 512 * 2 == 80 * MiB && (size_t)T * 128 * 2 == 20 * MiB, "ws map");

constexpr int LDS_BYTES = 135168;

typedef __bf16 bf16x2v __attribute__((ext_vector_type(2)));
__device__ __forceinline__ unsigned cvt_pk_bf16(float lo, float hi) { const f32x2 v = {lo, hi}; return __builtin_bit_cast(unsigned, __builtin_convertvector(v, bf16x2v)); }
__device__ __forceinline__ float bf_lo(unsigned w) { return __builtin_bit_cast(float, w << 16); }
__device__ __forceinline__ float bf_hi(unsigned w) { return __builtin_bit_cast(float, w & 0xffff0000u); }
__device__ __forceinline__ float fast_sigmoid(float x) { return __builtin_amdgcn_rcpf(1.0f + __builtin_amdgcn_exp2f(-x * LOG2E)); }
__device__ __forceinline__ float fast_silu(float x) { return x * fast_sigmoid(x); }
__device__ __forceinline__ float wave_sum(float v) {
#pragma unroll
    for (int o = 1; o < 64; o <<= 1) v += __shfl_xor(v, o);
    return v;
}
#define LDS_WAIT() asm volatile("s_waitcnt lgkmcnt(0)" ::: "memory")

namespace pg8 {
constexpr int BM = 256, BK = 64, HALF = 128, HTB = HALF * BK * 2, STAGE_BYTES = 8 * HTB, NXCD = 8, WGM = 8;
__host__ __device__ __forceinline__ int lds_byte(int r, int c) { const int st = (r >> 4) * 2 + (c >> 5), rr = r & 15, cc = c & 31, ob = rr * 64 + cc * 2; return st * 1024 + (ob ^ (((ob >> 9) & 1) << 5)); }
__host__ __device__ __forceinline__ void stage_rc(int b, int& R, int& C) { const int st = b / 1024, sb = b % 1024, swz = sb ^ (((sb >> 9) & 1) << 5); R = (st >> 1) * 16 + swz / 64; C = (st & 1) * 32 + (swz % 64) / 2; }
__host__ __device__ __forceinline__ int perm32(int rho) { const int n = rho >> 4, i = rho & 15; return 8 * (i >> 2) + 4 * n + (i & 3); }

struct Unit { int pm, pn; };
struct Gemm { const bf16_t* A; const bf16_t* Bt; int M, N, K; };

struct StaticOrder {
    int nM, nN, nwg, G, c;
    __device__ void init(int M, int N, int G_, int c_) { nM = M / BM; nN = N / BM; nwg = nM * nN; G = G_; c = c_; }
    __device__ bool next(int i, Unit& u) const {
        const long L = (long)i * G + c; if (L >= nwg) return false;
        int wgid = (int)L; { const int q = nwg / NXCD, r = nwg % NXCD, xcd = wgid % NXCD, off = wgid / NXCD; wgid = (xcd < r ? xcd * (q + 1) : r * (q + 1) + (xcd - r) * q) + off; }
        const int nig = WGM * nN, gid = wgid / nig, fm = gid * WGM, gsz = (nM - fm) < WGM ? (nM - fm) : WGM;
        u.pm = fm + ((wgid % nig) % gsz); u.pn = (wgid % nig) / gsz; return true;
    }
    __device__ __forceinline__ void a_ready(const Unit&) const {}
    __device__ __forceinline__ void done(const Unit&) const {}
};

typedef f32x4 Acc[2][2][4][2];

struct EpiBf16 {
    static constexpr bool PERM = true, AFTER_DRAIN = false;
    bf16_t* O; int ldc;
    __device__ __forceinline__ void operator()(const Acc& acc, const Unit& u, int wr, int wc, int fr, int fq) const {
        const int row0 = u.pm * BM + wr * 64 + fr, col0 = u.pn * BM + wc * 32 + 8 * fq;
#pragma unroll
        for (int ai = 0; ai < 2; ++ai)
#pragma unroll
            for (int m = 0; m < 4; ++m) { bf16_t* rowp = O + (size_t)(row0 + ai * HALF + m * 16) * ldc + col0;
#pragma unroll
                for (int bj = 0; bj < 2; ++bj) { const f32x4 v0 = acc[ai][bj][m][0], v1 = acc[ai][bj][m][1];
                    u32x4 w; w.x = cvt_pk_bf16(v0[0], v0[1]); w.y = cvt_pk_bf16(v0[2], v0[3]); w.z = cvt_pk_bf16(v1[0], v1[1]); w.w = cvt_pk_bf16(v1[2], v1[3]);
                    *(u32x4*)(rowp + bj * HALF) = w; } }
    }
};

struct EpiSwiGLU {
    static constexpr bool PERM = true, AFTER_DRAIN = false;
    bf16_t* O; int ldc;
    __device__ __forceinline__ void operator()(const Acc& acc, const Unit& u, int wr, int wc, int fr, int fq) const {
        const int row0 = u.pm * BM + wr * 64 + fr, col0 = u.pn * HALF + wc * 32 + 8 * fq;
#pragma unroll
        for (int ai = 0; ai < 2; ++ai)
#pragma unroll
            for (int m = 0; m < 4; ++m) { bf16_t* rowp = O + (size_t)(row0 + ai * HALF + m * 16) * ldc + col0;
                const f32x4 g0 = acc[ai][0][m][0], g1 = acc[ai][0][m][1], u0 = acc[ai][1][m][0], u1 = acc[ai][1][m][1];
                u32x4 w;
                w.x = cvt_pk_bf16(fast_silu(g0[0]) * u0[0], fast_silu(g0[1]) * u0[1]); w.y = cvt_pk_bf16(fast_silu(g0[2]) * u0[2], fast_silu(g0[3]) * u0[3]);
                w.z = cvt_pk_bf16(fast_silu(g1[0]) * u1[0], fast_silu(g1[1]) * u1[1]); w.w = cvt_pk_bf16(fast_silu(g1[2]) * u1[2], fast_silu(g1[3]) * u1[3]);
                *(u32x4*)rowp = w; }
    }
};

struct EpiProj {
    static constexpr bool PERM = true, AFTER_DRAIN = false;
    bf16_t *Q, *K, *V, *U, *GA, *GB; const float *ct, *st;
    __device__ __forceinline__ void rope_store(const Acc& acc, int row0, bf16_t* base, int ld, int colbase, int fq, float sc) const {
#pragma unroll
        for (int ai = 0; ai < 2; ++ai)
#pragma unroll
            for (int m = 0; m < 4; ++m) { const int row = row0 + ai * HALF + m * 16; const int pos = row & (SEQ - 1);
                const float* cp = ct + pos * 32 + 8 * fq; const float* sp = st + pos * 32 + 8 * fq;
                const f32x4 c0 = *(const f32x4*)cp, c1 = *(const f32x4*)(cp + 4), s0 = *(const f32x4*)sp, s1 = *(const f32x4*)(sp + 4);
                const f32x4 a0 = acc[ai][0][m][0] * sc, a1 = acc[ai][0][m][1] * sc, b0 = acc[ai][1][m][0] * sc, b1 = acc[ai][1][m][1] * sc;
                const f32x4 lo0 = a0 * c0 - b0 * s0, lo1 = a1 * c1 - b1 * s1, hi0 = b0 * c0 + a0 * s0, hi1 = b1 * c1 + a1 * s1;
                bf16_t* p = base + (size_t)row * ld + colbase + 8 * fq;
                u32x4 w; w.x = cvt_pk_bf16(lo0[0], lo0[1]); w.y = cvt_pk_bf16(lo0[2], lo0[3]); w.z = cvt_pk_bf16(lo1[0], lo1[1]); w.w = cvt_pk_bf16(lo1[2], lo1[3]);
                *(u32x4*)p = w;
                w.x = cvt_pk_bf16(hi0[0], hi0[1]); w.y = cvt_pk_bf16(hi0[2], hi0[3]); w.z = cvt_pk_bf16(hi1[0], hi1[1]); w.w = cvt_pk_bf16(hi1[2], hi1[3]);
                *(u32x4*)(p + 32) = w;
                asm volatile("" ::: "memory"); }
    }
    template <int ACT> __device__ __forceinline__ void plain_store(const Acc& acc, int row0, bf16_t* base, int ld, int col0) const {
#pragma unroll
        for (int ai = 0; ai < 2; ++ai)
#pragma unroll
            for (int m = 0; m < 4; ++m) { bf16_t* rowp = base + (size_t)(row0 + ai * HALF + m * 16) * ld + col0;
#pragma unroll
                for (int bj = 0; bj < 2; ++bj) { f32x4 v0 = acc[ai][bj][m][0], v1 = acc[ai][bj][m][1];
                    if (ACT == 1) { for (int i = 0; i < 4; ++i) { v0[i] = fast_sigmoid(v0[i]); v1[i] = fast_sigmoid(v1[i]); } }
                    u32x4 w; w.x = cvt_pk_bf16(v0[0], v0[1]); w.y = cvt_pk_bf16(v0[2], v0[3]); w.z = cvt_pk_bf16(v1[0], v1[1]); w.w = cvt_pk_bf16(v1[2], v1[3]);
                    *(u32x4*)(rowp + bj * HALF) = w; }
                asm volatile("" ::: "memory"); }
    }
    __device__ __forceinline__ void operator()(const Acc& acc, const Unit& u, int wr, int wc, int fr, int fq) const {
        int row0 = u.pm * BM + wr * 64 + fr; const int pn = u.pn;
#define OPAQUE_ROW() asm volatile("" : "+v"(row0))
        if (pn < 2) { OPAQUE_ROW(); rope_store(acc, row0, Q, 512, (4 * pn + wc) * 64, fq, 0.125f); }
        else if (pn == 2) {
            if (wc < 2) { OPAQUE_ROW(); rope_store(acc, row0, K, 128, wc * 64, fq, 1.0f); }
            else { OPAQUE_ROW();
#pragma unroll
                for (int ai = 0; ai < 2; ++ai)
#pragma unroll
                    for (int m = 0; m < 4; ++m) { bf16_t* rowp = V + (size_t)(row0 + ai * HALF + m * 16) * 128 + (wc - 2) * 32 + 8 * fq;
#pragma unroll
                        for (int bj = 0; bj < 2; ++bj) { const f32x4 v0 = acc[ai][bj][m][0], v1 = acc[ai][bj][m][1];
                            u32x4 w; w.x = cvt_pk_bf16(v0[0], v0[1]); w.y = cvt_pk_bf16(v0[2], v0[3]); w.z = cvt_pk_bf16(v1[0], v1[1]); w.w = cvt_pk_bf16(v1[2], v1[3]);
                            *(u32x4*)(rowp + bj * 64) = w; } }
            }
        }
        else if (pn < 5) { OPAQUE_ROW(); plain_store<0>(acc, row0, U, 512, (pn - 3) * BM + wc * 32 + 8 * fq); }
        else { OPAQUE_ROW(); bf16_t* gbase = pn < 9 ? GA : GB; const int gt = pn < 9 ? pn - 5 : pn - 9; plain_store<1>(acc, row0, gbase, D, gt * BM + wc * 32 + 8 * fq); }
#undef OPAQUE_ROW
    }
};

template <int MODE> struct EpiGate {
    static constexpr bool PERM = true, AFTER_DRAIN = false;
    bf16_t* O; const bf16_t* Gt;
    __device__ __forceinline__ void operator()(const Acc& acc, const Unit& u, int wr, int wc, int fr, int fq) const {
        const int row0 = u.pm * BM + wr * 64 + fr, col0 = u.pn * BM + wc * 32 + 8 * fq;
#pragma unroll
        for (int ai = 0; ai < 2; ++ai)
#pragma unroll
            for (int m = 0; m < 4; ++m) { const size_t off = (size_t)(row0 + ai * HALF + m * 16) * D + col0;
#pragma unroll
                for (int bj = 0; bj < 2; ++bj) { const f32x4 v0 = acc[ai][bj][m][0], v1 = acc[ai][bj][m][1];
                    const u32x4 g = *(const u32x4*)(Gt + off + bj * HALF);
                    float r[8] = { v0[0] * bf_lo(g.x), v0[1] * bf_hi(g.x), v0[2] * bf_lo(g.y), v0[3] * bf_hi(g.y), v1[0] * bf_lo(g.z), v1[1] * bf_hi(g.z), v1[2] * bf_lo(g.w), v1[3] * bf_hi(g.w) };
                    if (MODE == 1) { const u32x4 o = *(const u32x4*)(O + off + bj * HALF);
                        r[0] += bf_lo(o.x); r[1] += bf_hi(o.x); r[2] += bf_lo(o.y); r[3] += bf_hi(o.y); r[4] += bf_lo(o.z); r[5] += bf_hi(o.z); r[6] += bf_lo(o.w); r[7] += bf_hi(o.w); }
                    u32x4 w; w.x = cvt_pk_bf16(r[0], r[1]); w.y = cvt_pk_bf16(r[2], r[3]); w.z = cvt_pk_bf16(r[4], r[5]); w.w = cvt_pk_bf16(r[6], r[7]);
                    *(u32x4*)(O + off + bj * HALF) = w; }
                asm volatile("" ::: "memory"); }
    }
};

template <class Epi, class Sched, bool ALIGN_EPI = false, bool SP2 = false>
__device__ __forceinline__ void gemm_phase(LAS unsigned char* lds, const Gemm g, const Sched& S, const Epi& E) {
    const int tid = threadIdx.x, wid = __builtin_amdgcn_readfirstlane(tid >> 6), lane = tid & 63, wr = wid >> 2, wc = wid & 3, fr = lane & 15, fq = lane >> 4;
    const int K = g.K, nt = K / BK;
    unsigned voffA[2], voffB[2];
#pragma unroll
    for (int i = 0; i < 2; ++i) { int R, C; stage_rc(tid * 16 + i * 8192, R, C); const int Rb = Epi::PERM ? ((R & ~31) + perm32(R & 31)) : R;
        voffA[i] = (unsigned)(R * K + C) * 2u; voffB[i] = (unsigned)(Rb * K + C) * 2u; }
    const size_t kstep = (size_t)(BK * 2);
    const size_t hstep = (size_t)HALF * K * 2;
    const size_t tstep = 2 * hstep;
    const unsigned ldsw = (unsigned)wid * 1024u;
    const int aoff = lds_byte(wr * 64 + fr, fq * 8), boff = lds_byte(wc * 32 + fr, fq * 8);
#define PG8_SA(b, h) (((b) * 2 + (h)) * HTB)
#define PG8_SB(b, h) ((4 + (b) * 2 + (h)) * HTB)
#define PG8_STAGE(bufoff, gbase, voff) do { _Pragma("unroll") for (int _i = 0; _i < 2; ++_i) \
        __builtin_amdgcn_global_load_lds((const unsigned*)((const char*)(gbase) + (voff)[_i]), (LAS unsigned*)(lds + (bufoff) + ldsw + _i * 8192), 16, 0, 0); } while (0)
#define PG8_LDA(dst, b, h) do { _Pragma("unroll") for (int m = 0; m < 4; ++m) _Pragma("unroll") for (int k = 0; k < 2; ++k) dst[m][k] = *(const LAS bf16x8*)(lds + PG8_SA(b, h) + aoff + m * 2048 + k * 1024); } while (0)
#define PG8_LDB(dst, b, h) do { _Pragma("unroll") for (int n = 0; n < 2; ++n) _Pragma("unroll") for (int k = 0; k < 2; ++k) dst[n][k] = *(const LAS bf16x8*)(lds + PG8_SB(b, h) + boff + n * 2048 + k * 1024); } while (0)
#define PG8_MMA(ai, bj, At, Bt) do { __builtin_amdgcn_s_setprio(1); _Pragma("unroll") for (int m = 0; m < 4; ++m) _Pragma("unroll") for (int n = 0; n < 2; ++n) _Pragma("unroll") for (int k = 0; k < 2; ++k) \
        acc[ai][bj][m][n] = __builtin_amdgcn_mfma_f32_16x16x32_bf16(Bt[n][k], At[m][k], acc[ai][bj][m][n], 0, 0, 0); __builtin_amdgcn_s_setprio(0); } while (0)
#define PG8_WAIT_V(n) asm volatile("s_waitcnt vmcnt(" #n ")" ::: "memory")
#define PG8_WAIT_L(n) asm volatile("s_waitcnt lgkmcnt(" #n ")" ::: "memory")
#define PG8_BAR __builtin_amdgcn_s_barrier()
#define PG8_SCHED __builtin_amdgcn_sched_barrier(0)
    Unit cur, nxt; int ui = 0;
    if (!S.next(0, cur)) return;
    f32x4 acc[2][2][4][2];
#pragma unroll
    for (int a = 0; a < 2; ++a)
#pragma unroll
        for (int b = 0; b < 2; ++b)
#pragma unroll
            for (int m = 0; m < 4; ++m)
#pragma unroll
                for (int n = 0; n < 2; ++n) acc[a][b][m][n] = (f32x4){0.f, 0.f, 0.f, 0.f};
    bf16x8 At[4][2], B0[2][2], B1[2][2];
    const char* cA = (const char*)g.A + (size_t)cur.pm * tstep; const char* cB = (const char*)g.Bt + (size_t)cur.pn * tstep;
    S.a_ready(cur);
    if constexpr (SP2) {
        PG8_STAGE(PG8_SB(0, 0), cB, voffB); PG8_STAGE(PG8_SB(0, 1), cB + hstep, voffB); PG8_STAGE(PG8_SA(0, 0), cA, voffA); PG8_STAGE(PG8_SA(0, 1), cA + hstep, voffA);
        if (wr == 1) PG8_BAR;
        PG8_WAIT_V(2); PG8_BAR;
        PG8_STAGE(PG8_SB(1, 0), cB + kstep, voffB); PG8_STAGE(PG8_SA(1, 0), cA + kstep, voffA); PG8_STAGE(PG8_SB(1, 1), cB + hstep + kstep, voffB);
        PG8_WAIT_V(6); PG8_BAR;
    } else {
        PG8_STAGE(PG8_SB(0, 0), cB, voffB); PG8_STAGE(PG8_SA(0, 0), cA, voffA); PG8_STAGE(PG8_SB(0, 1), cB + hstep, voffB); PG8_STAGE(PG8_SA(0, 1), cA + hstep, voffA);
        if (wr == 1) PG8_BAR;
        PG8_WAIT_V(4); PG8_BAR;
        PG8_STAGE(PG8_SB(1, 0), cB + kstep, voffB); PG8_STAGE(PG8_SA(1, 0), cA + kstep, voffA); PG8_STAGE(PG8_SB(1, 1), cB + hstep + kstep, voffB);
        PG8_WAIT_V(6); PG8_BAR;
    }
    for (;;) {
        const bool has_next = S.next(ui + 1, nxt);
        const char* nA = has_next ? (const char*)g.A + (size_t)nxt.pm * tstep : cA; const char* nB = has_next ? (const char*)g.Bt + (size_t)nxt.pn * tstep : cB;
        for (int t = 0; t < nt; t += 2) {
            const bool last = (t == nt - 2);
            const char* a1 = cA + (size_t)(t + 1) * kstep;
            const char* a2 = last ? nA : cA + (size_t)(t + 2) * kstep; const char* b2 = last ? nB : cB + (size_t)(t + 2) * kstep;
            const char* a3 = a2 + kstep; const char* b3 = b2 + kstep;
            if (last && has_next) S.a_ready(nxt);
            if constexpr (SP2) {
            PG8_LDB(B0, 0, 0); PG8_LDB(B1, 0, 1); PG8_SCHED; PG8_LDA(At, 0, 0); PG8_STAGE(PG8_SA(1, 1), a1 + hstep, voffA);
            PG8_WAIT_V(8); PG8_WAIT_L(0); PG8_BAR; PG8_MMA(0, 0, At, B0); PG8_MMA(0, 1, At, B1); PG8_BAR; PG8_SCHED;
            PG8_LDA(At, 0, 1); PG8_STAGE(PG8_SB(0, 0), b2, voffB); PG8_STAGE(PG8_SB(0, 1), b2 + hstep, voffB); PG8_STAGE(PG8_SA(0, 0), a2, voffA);
            PG8_WAIT_V(8); PG8_WAIT_L(0); PG8_BAR; PG8_MMA(1, 0, At, B0); PG8_MMA(1, 1, At, B1); PG8_BAR; PG8_SCHED;
            PG8_LDB(B0, 1, 0); PG8_LDB(B1, 1, 1); PG8_SCHED; PG8_LDA(At, 1, 0); PG8_STAGE(PG8_SA(0, 1), a2 + hstep, voffA);
            PG8_WAIT_V(8); PG8_WAIT_L(0); PG8_BAR; PG8_MMA(0, 0, At, B0); PG8_MMA(0, 1, At, B1); PG8_BAR; PG8_SCHED;
            PG8_LDA(At, 1, 1); PG8_STAGE(PG8_SB(1, 0), b3, voffB); PG8_STAGE(PG8_SB(1, 1), b3 + hstep, voffB); PG8_STAGE(PG8_SA(1, 0), a3, voffA);
            PG8_WAIT_V(8); PG8_WAIT_L(0); PG8_BAR; PG8_MMA(1, 0, At, B0); PG8_MMA(1, 1, At, B1); PG8_BAR; PG8_SCHED;
            } else {
            PG8_LDB(B0, 0, 0); PG8_SCHED; PG8_LDA(At, 0, 0); PG8_STAGE(PG8_SA(1, 1), a1 + hstep, voffA);
            PG8_WAIT_L(8); PG8_BAR; PG8_WAIT_L(0); PG8_MMA(0, 0, At, B0); PG8_BAR; PG8_SCHED;
            PG8_LDB(B1, 0, 1); PG8_STAGE(PG8_SB(0, 0), b2, voffB);
            PG8_BAR; PG8_WAIT_L(0); PG8_MMA(0, 1, At, B1); PG8_BAR;
            PG8_LDA(At, 0, 1); PG8_STAGE(PG8_SA(0, 0), a2, voffA);
            PG8_BAR; PG8_WAIT_L(0); PG8_MMA(1, 0, At, B0); PG8_BAR; PG8_SCHED;
            PG8_STAGE(PG8_SB(0, 1), b2 + hstep, voffB);
            PG8_WAIT_V(6); PG8_BAR; PG8_MMA(1, 1, At, B1); PG8_BAR;
            PG8_LDB(B0, 1, 0); PG8_SCHED; PG8_LDA(At, 1, 0); PG8_STAGE(PG8_SA(0, 1), a2 + hstep, voffA);
            PG8_WAIT_L(8); PG8_BAR; PG8_WAIT_L(0); PG8_MMA(0, 0, At, B0); PG8_BAR; PG8_SCHED;
            PG8_LDB(B1, 1, 1); PG8_STAGE(PG8_SB(1, 0), b3, voffB);
            PG8_BAR; PG8_WAIT_L(0); PG8_MMA(0, 1, At, B1); PG8_BAR;
            PG8_LDA(At, 1, 1); PG8_STAGE(PG8_SA(1, 0), a3, voffA);
            PG8_BAR; PG8_WAIT_L(0); PG8_MMA(1, 0, At, B0); PG8_BAR; PG8_SCHED;
            PG8_STAGE(PG8_SB(1, 1), b3 + hstep, voffB);
            PG8_WAIT_V(6); PG8_BAR; PG8_MMA(1, 1, At, B1); PG8_BAR;
            }
        }
        if constexpr (ALIGN_EPI) { if (wr == 0) PG8_BAR; }
        if constexpr (!Epi::AFTER_DRAIN) { E(acc, cur, wr, wc, fr, fq); S.done(cur); }
        if (!has_next) break;
#pragma unroll
        for (int a = 0; a < 2; ++a)
#pragma unroll
            for (int b = 0; b < 2; ++b)
#pragma unroll
                for (int m = 0; m < 4; ++m)
#pragma unroll
                    for (int n = 0; n < 2; ++n) acc[a][b][m][n] = (f32x4){0.f, 0.f, 0.f, 0.f};
        cur = nxt; cA = nA; cB = nB; ++ui;
        if constexpr (ALIGN_EPI) { if (wr == 1) PG8_BAR; }
    }
    PG8_WAIT_V(0);
    if constexpr (!ALIGN_EPI) { if (wr == 0) PG8_BAR; }
    PG8_BAR;
#undef PG8_SA
#undef PG8_SB
#undef PG8_STAGE
#undef PG8_LDA
#undef PG8_LDB
#undef PG8_MMA
#undef PG8_WAIT_V
#undef PG8_WAIT_L
#undef PG8_BAR
#undef PG8_SCHED
}
}

#define XB_TMO      128
#define XB_XCNT(j)  (256  + 64 * (j))
#define XB_XSUB(j)  (1280 + 64 * (j))
#define XB_XGEN(j)  (2304 + 64 * (j))
#define XB_TOP      3328
#define XB_TOPGEN   3392
#define XCD_BAR_WORDS 3456
#define XB_SPIN_CAP (1u << 22)
__device__ __forceinline__ unsigned xb_ld(unsigned* p)              { return __hip_atomic_load(p, __ATOMIC_RELAXED, __HIP_MEMORY_SCOPE_AGENT); }
__device__ __forceinline__ unsigned xb_add(unsigned* p, unsigned v) { return __hip_atomic_fetch_add(p, v, __ATOMIC_RELAXED, __HIP_MEMORY_SCOPE_AGENT); }
__device__ __forceinline__ unsigned xb_xcc_id() { return (unsigned)__builtin_amdgcn_s_getreg((3 << 11) | 20) & 0xFu; }
#define XB_SPIN(cond, bar) do { unsigned _sp = 0; while (cond) { __builtin_amdgcn_s_sleep(1); \
    if ((++_sp & 255u) == 0u) { if (xb_ld(&(bar)[XB_TMO])) break; if (_sp > XB_SPIN_CAP) { atomicAdd(&(bar)[XB_TMO], 1u); break; } } } } while (0)
struct XcdBarrier { unsigned* bar; unsigned x; volatile LAS unsigned* st; };
__device__ __forceinline__ XcdBarrier xcd_barrier_post(unsigned* bar, volatile LAS unsigned* st) {
    XcdBarrier b; b.bar = bar; b.x = xb_xcc_id(); b.st = st;
    if (threadIdx.x == 0) (void)xb_add(&bar[XB_XCNT(b.x)], 1u);
    return b;
}
__device__ __forceinline__ void xcd_barrier_complete(unsigned* bar, unsigned x, unsigned& nloc, unsigned& nx) {
    const unsigned G = gridDim.x * gridDim.y * gridDim.z;
    unsigned sum, cnt, mine, sp = 0u;
    for (;;) {
        sum = 0u; cnt = 0u; mine = 0u;
#pragma unroll
        for (unsigned j = 0; j < 16; ++j) { const unsigned c = xb_ld(&bar[XB_XCNT(j)]); sum += c; cnt += (c > 0u) ? 1u : 0u; mine = (j == x) ? c : mine; }
        if (sum == G) break;
        __builtin_amdgcn_s_sleep(1);
        if ((++sp & 255u) == 0u) { if (xb_ld(&bar[XB_TMO])) break; if (sp > XB_SPIN_CAP) { atomicAdd(&bar[XB_TMO], 1u); break; } }
    }
    nloc = mine > 0u ? mine : 1u; nx = cnt > 0u ? cnt : 1u;
}
__device__ __forceinline__ void xcd_barrier(const XcdBarrier& b) {
    asm volatile("s_waitcnt vmcnt(0)" ::: "memory");
    __syncthreads();
    if (threadIdx.x == 0) {
        unsigned* bar = b.bar;
        __builtin_amdgcn_s_waitcnt(0);
        unsigned nloc = b.st[0], nx = b.st[1];
        if (nloc == 0u) { xcd_barrier_complete(bar, b.x, nloc, nx); b.st[0] = nloc; b.st[1] = nx; }
        const unsigned old = xb_add(&bar[XB_XSUB(b.x)], 1u);
        const unsigned gen = old / nloc;
        if (old + 1u == (gen + 1u) * nloc) {
            __builtin_amdgcn_fence(__ATOMIC_RELEASE, "agent");
            asm volatile("s_waitcnt vmcnt(0)" ::: "memory");
            const unsigned og = xb_add(&bar[XB_TOP], 1u);
            const unsigned tg = og / nx;
            if (og + 1u == (tg + 1u) * nx) xb_add(&bar[XB_TOPGEN], 1u);
            else XB_SPIN(xb_ld(&bar[XB_TOPGEN]) == tg, bar);
            __builtin_amdgcn_fence(__ATOMIC_ACQUIRE, "agent");
            xb_add(&bar[XB_XGEN(b.x)], 1u);
            asm volatile("s_waitcnt vmcnt(0)" ::: "memory");
        } else {
            XB_SPIN(xb_ld(&bar[XB_XGEN(b.x)]) == gen, bar);
            __builtin_amdgcn_fence(__ATOMIC_ACQUIRE, "agent");
            asm volatile("s_waitcnt vmcnt(0)" ::: "memory");
        }
    }
    __syncthreads();
}

struct Args { const float* in[21]; float* out; unsigned char* ws; int ph_lo, ph_hi; };
enum { I_XP = 0, I_XS, I_CP, I_CS, I_ADAW, I_ADAB, I_NPRE, I_NPOST, I_F1G, I_F1U, I_F1D, I_WIN, I_SINK, I_WAB, I_POOLW, I_POOLS, I_WPB, I_WOUT, I_F2G, I_F2U, I_F2D };

__device__ __forceinline__ int map_row(int mode, int n0) {
    if (mode == 0) return n0;
    if (mode == 1) return 256 * (n0 >> 7) + (n0 & 127);
    if (mode == 2) return 256 * (n0 >> 7) + 128 + (n0 & 127);
    if (n0 < 512) { const int head = n0 >> 6, half = (n0 >> 5) & 1; return 256 * (head >> 2) + 128 * half + (head & 3) * 32; }
    if (n0 < 640) { const int kh = (n0 - 512) >> 6, half = (n0 >> 5) & 1; return 512 + 128 * half + kh * 32; }
    if (n0 < 768) { const int vv = n0 - 640; return 512 + 128 * (vv >> 6) + 64 + (vv & 63); }
    return n0;
}
__device__ __forceinline__ void transpose_item(const float* W, int K, int N, bf16_t* WT, int mode, LAS float* scr, int item, int lane) {
    const int nblk = N / 32, kb = item / nblk, nb = item % nblk, k0 = 64 * kb, n0 = 32 * nb;
#pragma unroll 8
    for (int i = 0; i < 32; ++i) { const int kk = 2 * i + (lane >> 5); scr[kk * 33 + (lane & 31)] = W[(size_t)(k0 + kk) * N + n0 + (lane & 31)]; }
    LDS_WAIT();
    const int rb = map_row(mode, n0);
    const int c = lane & 7;
#pragma unroll
    for (int j = 0; j < 4; ++j) { const int n = (lane >> 3) + 8 * j; const LAS float* s = scr + (8 * c) * 33 + n;
        u32x4 o; o.x = cvt_pk_bf16(s[0 * 33], s[1 * 33]); o.y = cvt_pk_bf16(s[2 * 33], s[3 * 33]); o.z = cvt_pk_bf16(s[4 * 33], s[5 * 33]); o.w = cvt_pk_bf16(s[6 * 33], s[7 * 33]);
        *(u32x4*)(WT + (size_t)(rb + n) * K + k0 + 8 * c) = o; }
    LDS_WAIT();
}

__device__ __forceinline__ void prep_phase(LAS unsigned char* lds, const Args& a, int G, int bid) {
    const int tid = threadIdx.x, lane = tid & 63, wid = tid >> 6;
    unsigned char* ws = a.ws;
    if (bid < 144) {
        LAS float* sc = (LAS float*)lds;
        LAS float* part = (LAS float*)(lds + 40960);
        for (int i = tid; i < NSEQ * D; i += 512) { const int b = i >> 10, k = i & 1023; const float c = (b < NPROMPT) ? a.in[I_CP][b * D + k] : a.in[I_CS][(b - NPROMPT) * D + k]; sc[i] = c / (1.0f + expf(-c)); }
        __syncthreads();
        float* mod = (float*)(ws + WS_MOD);
        for (int it = bid; it < 144; it += G) {
            const int j0 = it * 64;
            float acc[NSEQ];
#pragma unroll
            for (int b = 0; b < NSEQ; ++b) acc[b] = 0.f;
            const float* w = a.in[I_ADAW] + (size_t)(wid * 128) * NMOD + j0 + lane;
#pragma unroll 4
            for (int k = 0; k < 128; ++k) { const float wv = w[(size_t)k * NMOD];
#pragma unroll
                for (int b = 0; b < NSEQ; ++b) acc[b] += sc[b * D + wid * 128 + k] * wv; }
#pragma unroll
            for (int b = 0; b < NSEQ; ++b) part[(wid * NSEQ + b) * 64 + lane] = acc[b];
            __syncthreads();
            for (int i = tid; i < NSEQ * 64; i += 512) { const int b = i >> 6, l = i & 63; float s = a.in[I_ADAB][j0 + l];
#pragma unroll
                for (int w8 = 0; w8 < 8; ++w8) s += part[(w8 * NSEQ + b) * 64 + l];
                mod[b * NMOD + j0 + l] = s; }
            __syncthreads();
        }
    }
    __syncthreads();
    LAS float* scr = (LAS float*)(lds + wid * 16384);
    const int gw = bid * 8 + wid, NGW = G * 8;
    constexpr int I_GU = (D / 64) * (FF / 32), I_DN = (FF / 64) * (D / 32), I_IN = (D / 64) * (NIN / 32), I_AB = (512 / 64) * (D / 32), I_OUT = (D / 64) * (D / 32);
    constexpr int NITEMS = 4 * I_GU + 2 * I_DN + I_IN + I_AB + I_OUT;
    for (int it = gw; it < NITEMS; it += NGW) {
        int r = it;
        if (r < I_GU) { transpose_item(a.in[I_F1G], D, FF, (bf16_t*)(ws + WS_W1GU), 1, scr, r, lane); continue; } r -= I_GU;
        if (r < I_GU) { transpose_item(a.in[I_F1U], D, FF, (bf16_t*)(ws + WS_W1GU), 2, scr, r, lane); continue; } r -= I_GU;
        if (r < I_GU) { transpose_item(a.in[I_F2G], D, FF, (bf16_t*)(ws + WS_W2GU), 1, scr, r, lane); continue; } r -= I_GU;
        if (r < I_GU) { transpose_item(a.in[I_F2U], D, FF, (bf16_t*)(ws + WS_W2GU), 2, scr, r, lane); continue; } r -= I_GU;
        if (r < I_DN) { transpose_item(a.in[I_F1D], FF, D, (bf16_t*)(ws + WS_W1D), 0, scr, r, lane); continue; } r -= I_DN;
        if (r < I_DN) { transpose_item(a.in[I_F2D], FF, D, (bf16_t*)(ws + WS_W2D), 0, scr, r, lane); continue; } r -= I_DN;
        if (r < I_IN) { transpose_item(a.in[I_WIN], D, NIN, (bf16_t*)(ws + WS_WIN), 3, scr, r, lane); continue; } r -= I_IN;
        if (r < I_AB) { transpose_item(a.in[I_WAB], 512, D, (bf16_t*)(ws + WS_WAB), 0, scr, r, lane); continue; } r -= I_AB;
        transpose_item(a.in[I_WOUT], D, D, (bf16_t*)(ws + WS_WOUT), 0, scr, r, lane);
    }
    {
        const float* pw = a.in[I_POOLW]; const float* ps = a.in[I_POOLS]; const float* wpb = a.in[I_WPB]; bf16_t* o = (bf16_t*)(ws + WS_WPB);
        for (int it = gw; it < 2048; it += NGW) {
            const int nq = it & 3, c = (it >> 2) & 127, g = it >> 9;
            scr[lane] = pw[(g * 128 + c) * 128 + lane] * ps[g * 128 + lane];
            scr[lane + 64] = pw[(g * 128 + c) * 128 + lane + 64] * ps[g * 128 + lane + 64];
            LDS_WAIT();
            for (int nc = 0; nc < 4; ++nc) { const int n = nq * 256 + nc * 64 + lane; float s = 0.f; const float* wp = wpb + (size_t)(g * 128) * D + n;
#pragma unroll 8
                for (int d = 0; d < 128; ++d) s += scr[d] * wp[(size_t)d * D];
                o[(size_t)n * 512 + g * 128 + c] = (bf16_t)(cvt_pk_bf16(s, 0.f) & 0xffffu); }
            LDS_WAIT();
        }
    }
    {
        float* ct = (float*)(ws + WS_CT); float* st = (float*)(ws + WS_ST);
        for (int i = bid * 512 + tid; i < SEQ * 32; i += G * 512) { const int pos = i >> 5, f = i & 31;
            const float inv = exp2f(-(float)f * (13.287712379549449f / 32.0f));
            const float ang = (float)pos * inv;
            const double ad = (double)ang; const double kk = rint(ad * 0.15915494309189535);
            double r = fma(-kk, 6.283185307179586, ad); r = fma(-kk, 2.4492935982947064e-16, r);
            const float rf = (float)r;
            ct[i] = cosf(rf); st[i] = sinf(rf); }
    }
}

__device__ __forceinline__ const float* xrow_in(const Args& a, int row) { return row < NPROMPT * SEQ ? a.in[I_XP] + (size_t)row * D : a.in[I_XS] + (size_t)(row - NPROMPT * SEQ) * D; }

template <int MODE> __device__ __forceinline__ void norm_phase(const Args& a, int j, float rw, int G, int bid) {
    const int tid = threadIdx.x, lane = tid & 63, wid = tid >> 6;
    const int gw = bid * 8 + wid, NGW = G * 8;
    const float* mod = (const float*)(a.ws + WS_MOD);
    const bf16_t* Y = (const bf16_t*)(a.ws + WS_Y); bf16_t* H = (bf16_t*)(a.ws + WS_H);
    const int rpw = (((T + NGW - 1) / NGW) + 3) & ~3;
    const int r0 = gw * rpw, r1 = (r0 + rpw) < T ? (r0 + rpw) : T;
    int cur_b = -1;
    f32x4 pA[4], pB[4], pC[4];
#pragma unroll
    for (int q = 0; q < 4; ++q) { pA[q] = (f32x4){0.f, 0.f, 0.f, 0.f}; pB[q] = pA[q]; pC[q] = pA[q]; }
    for (int r = r0; r < r1; r += 4) {
        const int b = r >> 13;
        if (b != cur_b) { cur_b = b;
            if (MODE != 0) { const f32x4* gp = (const f32x4*)(a.in[I_NPOST] + j * D) + lane; const f32x4* gt = (const f32x4*)(mod + (size_t)b * NMOD + j * 3 * D + 2 * D) + lane;
#pragma unroll
                for (int q = 0; q < 4; ++q) pA[q] = gp[64 * q] * (gt[64 * q] * rw); }
            if (MODE != 2) { const int jn = (MODE == 0) ? j : j + 1;
                const f32x4* gp = (const f32x4*)(a.in[I_NPRE] + jn * D) + lane; const f32x4* sh = (const f32x4*)(mod + (size_t)b * NMOD + jn * 3 * D) + lane; const f32x4* sc = sh + D / 4;
#pragma unroll
                for (int q = 0; q < 4; ++q) { pB[q] = gp[64 * q] * (sc[64 * q] + 1.0f); pC[q] = sh[64 * q]; } }
        }
        f32x4 x[4][4]; u32x2 yw[4][4];
#pragma unroll
        for (int i = 0; i < 4; ++i) { const int row = (r + i) < r1 ? (r + i) : (r1 - 1);
            const f32x4* xr = (MODE == 0 || j == 0) ? (const f32x4*)xrow_in(a, row) + lane : (const f32x4*)(a.out + (size_t)row * D) + lane;
#pragma unroll
            for (int q = 0; q < 4; ++q) x[i][q] = xr[64 * q];
            if (MODE != 0) { const u32x2* yr = (const u32x2*)(Y + (size_t)row * D) + lane;
#pragma unroll
                for (int q = 0; q < 4; ++q) yw[i][q] = yr[64 * q]; }
        }
#pragma unroll
        for (int i = 0; i < 4; ++i) { const int row = r + i; const bool live = row < r1;
            if (MODE != 0) {
                f32x4 y[4]; float ss = 0.f;
#pragma unroll
                for (int q = 0; q < 4; ++q) { const u32x2 w = yw[i][q]; y[q] = (f32x4){bf_lo(w.x), bf_hi(w.x), bf_lo(w.y), bf_hi(w.y)};
                    ss += (y[q][0] * y[q][0] + y[q][1] * y[q][1]) + (y[q][2] * y[q][2] + y[q][3] * y[q][3]); }
                const float rstd = rsqrtf(wave_sum(ss) * (1.0f / D) + EPS);
                f32x4* xo = (f32x4*)(a.out + (size_t)row * D) + lane;
#pragma unroll
                for (int q = 0; q < 4; ++q) { x[i][q] = x[i][q] + (y[q] * rstd) * pA[q]; if (live) xo[64 * q] = x[i][q]; }
            }
            if (MODE != 2) {
                float ss = 0.f;
#pragma unroll
                for (int q = 0; q < 4; ++q) ss += (x[i][q][0] * x[i][q][0] + x[i][q][1] * x[i][q][1]) + (x[i][q][2] * x[i][q][2] + x[i][q][3] * x[i][q][3]);
                const float rstd = rsqrtf(wave_sum(ss) * (1.0f / D) + EPS);
                u32x2* ho = (u32x2*)(H + (size_t)row * D) + lane;
#pragma unroll
                for (int q = 0; q < 4; ++q) { const f32x4 h = (x[i][q] * rstd) * pB[q] + pC[q];
                    u32x2 w; w.x = cvt_pk_bf16(h[0], h[1]); w.y = cvt_pk_bf16(h[2], h[3]); if (live) ho[64 * q] = w; }
            }
        }
    }
}

namespace att {
constexpr int KSTR = 144;
constexpr int VSTR = 784;
constexpr int K_OFF = 0, V_OFF = 384 * KSTR, BYTES = V_OFF + 64 * VSTR;
static_assert(BYTES <= 131072, "attention LDS");
}
__device__ __forceinline__ void attn_phase(LAS unsigned char* lds, const bf16_t* Q, const bf16_t* K, const bf16_t* V, bf16_t* O, const float* sink, int G, int bid) {
    using namespace att;
    const int tid = threadIdx.x, lane = tid & 63, wid = tid >> 6, fr = lane & 15, fq = lane >> 4;
    for (int unit = bid; unit < NSEQ * 64 * 2; unit += G) {
        const int kvh = unit & 1, blk = (unit >> 1) & 63, b = unit >> 7;
        const size_t seq0 = (size_t)b * SEQ;
        const int kp0 = (blk - 1) * 128;
        __syncthreads();
#pragma unroll
        for (int it = 0; it < 6; ++it) {
            const int id = tid + 512 * it, row = id >> 3, ch = id & 7; const int kpos = kp0 + row;
            u32x4 kv = {0u, 0u, 0u, 0u}, vv = {0u, 0u, 0u, 0u};
            if (kpos >= 0 && kpos < SEQ) { const size_t off = (seq0 + kpos) * 128 + kvh * 64 + ch * 8; kv = *(const u32x4*)(K + off); vv = *(const u32x4*)(V + off); }
            *(LAS u32x4*)(lds + K_OFF + row * KSTR + ch * 16) = kv;
            LAS unsigned short* vt = (LAS unsigned short*)(lds + V_OFF + (ch * 8) * VSTR + row * 2);
            vt[0 * (VSTR / 2)] = (unsigned short)(vv.x & 0xffffu); vt[1 * (VSTR / 2)] = (unsigned short)(vv.x >> 16);
            vt[2 * (VSTR / 2)] = (unsigned short)(vv.y & 0xffffu); vt[3 * (VSTR / 2)] = (unsigned short)(vv.y >> 16);
            vt[4 * (VSTR / 2)] = (unsigned short)(vv.z & 0xffffu); vt[5 * (VSTR / 2)] = (unsigned short)(vv.z >> 16);
            vt[6 * (VSTR / 2)] = (unsigned short)(vv.w & 0xffffu); vt[7 * (VSTR / 2)] = (unsigned short)(vv.w >> 16);
        }
        __syncthreads();
        const int qg = wid;
        const int jt0 = qg < 6 ? qg : 6;
        const int r = qg * 16 + fr;
        const size_t qrow = seq0 + (size_t)blk * 128 + r;
        for (int h4 = 0; h4 < 4; ++h4) {
            const int head = kvh * 4 + h4;
            const bf16x8 qf0 = *(const bf16x8*)(Q + qrow * 512 + head * 64 + fq * 8);
            const bf16x8 qf1 = *(const bf16x8*)(Q + qrow * 512 + head * 64 + 32 + fq * 8);
            f32x4 s[18];
            const LAS unsigned char* kb = lds + K_OFF + (jt0 * 16 + fr) * KSTR + fq * 16;
#pragma unroll
            for (int t = 0; t < 18; ++t) {
                const bf16x8 k0 = *(const LAS bf16x8*)(kb + t * 16 * KSTR), k1 = *(const LAS bf16x8*)(kb + t * 16 * KSTR + 64);
                f32x4 c = {0.f, 0.f, 0.f, 0.f};
                c = __builtin_amdgcn_mfma_f32_16x16x32_bf16(k0, qf0, c, 0, 0, 0);
                c = __builtin_amdgcn_mfma_f32_16x16x32_bf16(k1, qf1, c, 0, 0, 0);
                s[t] = c;
            }
            const float sk = sink[head];
            float mx = sk;
            int jlo = r > -kp0 ? r : -kp0, jhi = (r + 256) < (SEQ - 1 - kp0) ? (r + 256) : (SEQ - 1 - kp0);
            int d0 = jt0 * 16 + fq * 4 - jlo; unsigned span = (unsigned)(jhi - jlo);
            asm volatile("" : "+v"(d0), "+v"(span));
#pragma unroll
            for (int t = 0; t < 18; ++t)
#pragma unroll
                for (int e = 0; e < 4; ++e) { const bool valid = (unsigned)(d0 + t * 16 + e) <= span;
                    const float v = valid ? s[t][e] : -1e30f; s[t][e] = v; mx = fmaxf(mx, v); }
            mx = fmaxf(mx, __shfl_xor(mx, 16)); mx = fmaxf(mx, __shfl_xor(mx, 32));
            float l = 0.f;
#pragma unroll
            for (int t = 0; t < 18; ++t)
#pragma unroll
                for (int e = 0; e < 4; ++e) { const float p = __builtin_amdgcn_exp2f((s[t][e] - mx) * LOG2E); s[t][e] = p; l += p; }
            l += __shfl_xor(l, 16); l += __shfl_xor(l, 32);
            l += __builtin_amdgcn_exp2f((sk - mx) * LOG2E);
            const float inv = 1.0f / l;
            f32x4 o[4];
#pragma unroll
            for (int dt = 0; dt < 4; ++dt) o[dt] = (f32x4){0.f, 0.f, 0.f, 0.f};
#pragma unroll
            for (int pp = 0; pp < 9; ++pp) {
                u32x4 pw; pw.x = cvt_pk_bf16(s[2 * pp][0], s[2 * pp][1]); pw.y = cvt_pk_bf16(s[2 * pp][2], s[2 * pp][3]);
                pw.z = cvt_pk_bf16(s[2 * pp + 1][0], s[2 * pp + 1][1]); pw.w = cvt_pk_bf16(s[2 * pp + 1][2], s[2 * pp + 1][3]);
                const bf16x8 pf = __builtin_bit_cast(bf16x8, pw);
#pragma unroll
                for (int dt = 0; dt < 4; ++dt) {
                    const LAS unsigned char* vb = lds + V_OFF + (dt * 16 + fr) * VSTR + ((jt0 + 2 * pp) * 16 + fq * 4) * 2;
                    const u32x2 va = *(const LAS u32x2*)vb, vc = *(const LAS u32x2*)(vb + 32);
                    u32x4 vw; vw.x = va.x; vw.y = va.y; vw.z = vc.x; vw.w = vc.y;
                    o[dt] = __builtin_amdgcn_mfma_f32_16x16x32_bf16(__builtin_bit_cast(bf16x8, vw), pf, o[dt], 0, 0, 0);
                }
            }
            bf16_t* op = O + qrow * 512 + head * 64 + fq * 4;
#pragma unroll
            for (int dt = 0; dt < 4; ++dt) { u32x2 w; w.x = cvt_pk_bf16(o[dt][0] * inv, o[dt][1] * inv); w.y = cvt_pk_bf16(o[dt][2] * inv, o[dt][3] * inv); *(u32x2*)(op + dt * 16) = w; }
        }
    }
}
__device__ __forceinline__ void pool_phase(LAS unsigned char* lds, const bf16_t* U, bf16_t* P, int G, int bid) {
    constexpr int RS = 1040;
    const int tid = threadIdx.x, c = tid & 63, sub = tid >> 6, g = c >> 4, hw = 1 << g;
    for (int unit = bid; unit < NSEQ * 128; unit += G) {
        const int b = unit >> 7, s0 = (unit & 127) * 64; const size_t seqrow = (size_t)b * SEQ;
        __syncthreads();
#pragma unroll
        for (int it = 0; it < 10; ++it) { const int id = tid + 512 * it, row = id >> 6, ch = id & 63, sp = s0 - 8 + row;
            u32x4 v = {0u, 0u, 0u, 0u}; if (sp >= 0 && sp < SEQ) v = *(const u32x4*)(U + (seqrow + sp) * 512 + ch * 8);
            *(LAS u32x4*)(lds + row * RS + ch * 16) = v; }
        __syncthreads();
        const int rbase = sub * 8 + 8;
        const LAS unsigned char* col = lds + c * 16;
        float S[8];
#pragma unroll
        for (int e = 0; e < 8; ++e) S[e] = 0.f;
#pragma unroll
        for (int k = 0; k < 16; ++k) if (k < 2 * hw) { const u32x4 w = *(const LAS u32x4*)(col + (rbase - hw + k) * RS);
            S[0] += bf_lo(w.x); S[1] += bf_hi(w.x); S[2] += bf_lo(w.y); S[3] += bf_hi(w.y); S[4] += bf_lo(w.z); S[5] += bf_hi(w.z); S[6] += bf_lo(w.w); S[7] += bf_hi(w.w); }
#pragma unroll
        for (int k = 0; k < 8; ++k) { const int sp = s0 + sub * 8 + k; const int lo = (sp - hw) < 0 ? 0 : (sp - hw), hi = (sp + hw) > SEQ ? SEQ : (sp + hw);
            const float ic = 1.0f / (float)(hi - lo);
            const u32x4 w = *(const LAS u32x4*)(col + (rbase + k) * RS);
            u32x4 o; o.x = cvt_pk_bf16(S[0] * ic - bf_lo(w.x), S[1] * ic - bf_hi(w.x)); o.y = cvt_pk_bf16(S[2] * ic - bf_lo(w.y), S[3] * ic - bf_hi(w.y));
            o.z = cvt_pk_bf16(S[4] * ic - bf_lo(w.z), S[5] * ic - bf_hi(w.z)); o.w = cvt_pk_bf16(S[6] * ic - bf_lo(w.w), S[7] * ic - bf_hi(w.w));
            *(u32x4*)(P + (seqrow + sp) * 512 + c * 8) = o;
            if (k < 7) { const u32x4 wa = *(const LAS u32x4*)(col + (rbase + k + hw) * RS), wd = *(const LAS u32x4*)(col + (rbase + k - hw) * RS);
                S[0] += bf_lo(wa.x) - bf_lo(wd.x); S[1] += bf_hi(wa.x) - bf_hi(wd.x); S[2] += bf_lo(wa.y) - bf_lo(wd.y); S[3] += bf_hi(wa.y) - bf_hi(wd.y);
                S[4] += bf_lo(wa.z) - bf_lo(wd.z); S[5] += bf_hi(wa.z) - bf_hi(wd.z); S[6] += bf_lo(wa.w) - bf_lo(wd.w); S[7] += bf_hi(wa.w) - bf_hi(wd.w); }
        }
    }
}

__global__ void __launch_bounds__(512, 2) mega_fwd(Args a) {
    extern __shared__ __attribute__((aligned(16))) unsigned char lds_raw[];
    LAS unsigned char* lds = (LAS unsigned char*)lds_raw;
    const int G = gridDim.x, bid = blockIdx.x;
    unsigned char* ws = a.ws;
#define IN(k) (a.ph_lo <= (k) && (k) < a.ph_hi)
    volatile LAS unsigned* bst = (volatile LAS unsigned*)(lds + 131072);
    if (threadIdx.x < 2) bst[threadIdx.x] = 0u;
    __syncthreads();
    XcdBarrier xbar = xcd_barrier_post((unsigned*)(ws + WS_CTL), bst);
    if (a.ph_hi > 1000) cg::this_grid().sync();
#define SEAM(k) do { if (IN(k) && IN((k) + 1)) { xcd_barrier(xbar); } } while (0)
    typedef pg8::StaticOrder SO;
    bf16_t* H = (bf16_t*)(ws + WS_H); bf16_t* Y = (bf16_t*)(ws + WS_Y); bf16_t* ACT = (bf16_t*)(ws + WS_BIG);

    if (IN(0)) { prep_phase(lds, a, G, bid); if (MK_DUP == 0) { __syncthreads(); prep_phase(lds, a, G, bid); } }
    SEAM(0);
    if (IN(1)) { norm_phase<0>(a, 0, 0.f, G, bid); if (MK_DUP == 1) norm_phase<0>(a, 0, 0.f, G, bid); }
    SEAM(1);
    if (IN(2)) for (int rep = 0; rep < MK_GEMM_REP; ++rep) { pg8::Gemm g{H, (const bf16_t*)(ws + WS_W1GU), T, 2 * FF, D}; SO S; S.init(T, 2 * FF, G, bid); pg8::EpiSwiGLU E{ACT, FF};
        pg8::gemm_phase<pg8::EpiSwiGLU, SO, true, true>(lds, g, S, E); }
    SEAM(2);
    if (IN(3)) for (int rep = 0; rep < MK_GEMM_REP; ++rep) { pg8::Gemm g{ACT, (const bf16_t*)(ws + WS_W1D), T, D, FF}; SO S; S.init(T, D, G, bid); pg8::EpiBf16 E{Y, D};
        pg8::gemm_phase<pg8::EpiBf16, SO, true, true>(lds, g, S, E); }
    SEAM(3);
    if (IN(4)) norm_phase<1>(a, 0, 0.5f, G, bid);
    SEAM(4);
    if (IN(5)) for (int rep = 0; rep < MK_GEMM_REP; ++rep) { pg8::Gemm g{H, (const bf16_t*)(ws + WS_WIN), T, NIN, D}; SO S; S.init(T, NIN, G, bid);
        pg8::EpiProj E{(bf16_t*)(ws + WS_Q), (bf16_t*)(ws + WS_K), (bf16_t*)(ws + WS_V), (bf16_t*)(ws + WS_U), (bf16_t*)(ws + WS_GA), (bf16_t*)(ws + WS_GB), (const float*)(ws + WS_CT), (const float*)(ws + WS_ST)};
        pg8::gemm_phase<pg8::EpiProj, SO, true, true>(lds, g, S, E); }
    SEAM(5);
    if (IN(6)) {
        attn_phase(lds, (const bf16_t*)(ws + WS_Q), (const bf16_t*)(ws + WS_K), (const bf16_t*)(ws + WS_V), Y, a.in[I_SINK], G, bid);
        pool_phase(lds, (const bf16_t*)(ws + WS_U), Y + (size_t)T * 512, G, bid);
        __syncthreads();
        if (MK_DUP == 6) {
            attn_phase(lds, (const bf16_t*)(ws + WS_Q), (const bf16_t*)(ws + WS_K), (const bf16_t*)(ws + WS_V), Y, a.in[I_SINK], G, bid);
            pool_phase(lds, (const bf16_t*)(ws + WS_U), Y + (size_t)T * 512, G, bid);
            __syncthreads();
        }
    }
    SEAM(6);
    if (IN(7)) for (int rep = 0; rep < MK_GEMM_REP; ++rep) {
        { pg8::Gemm g{Y, (const bf16_t*)(ws + WS_WAB), T, D, 512}; SO S; S.init(T, D, G, bid); pg8::EpiGate<0> E{H, (const bf16_t*)(ws + WS_GA)};
          pg8::gemm_phase<pg8::EpiGate<0>, SO, true, true>(lds, g, S, E); }
        { pg8::Gemm g{Y + (size_t)T * 512, (const bf16_t*)(ws + WS_WPB), T, D, 512}; SO S; S.init(T, D, G, bid); pg8::EpiGate<1> E{H, (const bf16_t*)(ws + WS_GB)};
          pg8::gemm_phase<pg8::EpiGate<1>, SO, true, true>(lds, g, S, E); }
    }
    SEAM(7);
    if (IN(8)) for (int rep = 0; rep < MK_GEMM_REP; ++rep) { pg8::Gemm g{H, (const bf16_t*)(ws + WS_WOUT), T, D, D}; SO S; S.init(T, D, G, bid); pg8::EpiBf16 E{Y, D};
        pg8::gemm_phase<pg8::EpiBf16, SO, true, true>(lds, g, S, E); }
    SEAM(8);
    if (IN(9)) norm_phase<1>(a, 1, 1.0f, G, bid);
    SEAM(9);
    if (IN(10)) for (int rep = 0; rep < MK_GEMM_REP; ++rep) { pg8::Gemm g{H, (const bf16_t*)(ws + WS_W2GU), T, 2 * FF, D}; SO S; S.init(T, 2 * FF, G, bid); pg8::EpiSwiGLU E{ACT, FF};
        pg8::gemm_phase<pg8::EpiSwiGLU, SO, true, true>(lds, g, S, E); }
    SEAM(10);
    if (IN(11)) for (int rep = 0; rep < MK_GEMM_REP; ++rep) { pg8::Gemm g{ACT, (const bf16_t*)(ws + WS_W2D), T, D, FF}; SO S; S.init(T, D, G, bid); pg8::EpiBf16 E{Y, D};
        pg8::gemm_phase<pg8::EpiBf16, SO, true, true>(lds, g, S, E); }
    SEAM(11);
    if (IN(12)) norm_phase<2>(a, 2, 0.5f, G, bid);
#undef IN
#undef SEAM
}

__global__ void chk_kernel(const unsigned* p, size_t nwords, unsigned long long* dst) {
    unsigned long long s = 0;
    for (size_t i = (size_t)blockIdx.x * blockDim.x + threadIdx.x; i < nwords; i += (size_t)gridDim.x * blockDim.x) s += p[i];
    atomicAdd(dst, s);
}
__global__ void verdict_kernel(const unsigned long long* chk, float* out, size_t n) {
    int code = 0;
    for (int p = 0; p < 6; ++p) if (chk[p] != chk[16 + p]) code |= 1 << p;
    for (size_t i = (size_t)blockIdx.x * blockDim.x + threadIdx.x; i < n; i += (size_t)gridDim.x * blockDim.x) out[i] = (float)code;
}
constexpr int NPHASE = 13;
extern "C" void kernel_launch(void* const* d_in, const int* in_sizes, int n_in, void* d_out, int out_size, void* d_ws, size_t ws_size, hipStream_t stream) {
    static int grid = 0;
    if (grid == 0) {
        if (n_in != 21 || out_size != T * D || ws_size < WS_END) { fprintf(stderr, "kernel_launch: unexpected shapes: n_in %d out %d ws %zu (need %zu)\n", n_in, out_size, ws_size, (size_t)WS_END); grid = -1; return; }
        int dev = 0, cus = 0, per_cu = 0;
        if (hipGetDevice(&dev) != hipSuccess || hipDeviceGetAttribute(&cus, hipDeviceAttributeMultiprocessorCount, dev) != hipSuccess) { grid = -1; return; }
        if (hipFuncSetAttribute((const void*)mega_fwd, hipFuncAttributeMaxDynamicSharedMemorySize, LDS_BYTES) != hipSuccess) { fprintf(stderr, "kernel_launch: hipFuncSetAttribute failed\n"); grid = -1; return; }
        if (hipOccupancyMaxActiveBlocksPerMultiprocessor(&per_cu, (const void*)mega_fwd, 512, LDS_BYTES) != hipSuccess || per_cu < 1) { fprintf(stderr, "kernel_launch: occupancy query says %d\n", per_cu); per_cu = 1; }
        (void)hipGetLastError();
        grid = cus * 1;
    }
    if (grid < 0) return;
    (void)hipMemsetAsync((unsigned char*)d_ws + WS_CTL, 0, CTL_BYTES, stream);
    Args a{};
    for (int i = 0; i < 21; ++i) a.in[i] = (const float*)d_in[i];
    a.out = (float*)d_out; a.ws = (unsigned char*)d_ws;
#if MK_MULTI_LAUNCH == 2
    {
        unsigned char* ws = (unsigned char*)d_ws; unsigned long long* chk = (unsigned long long*)(ws + 900 * MiB);
        (void)hipMemsetAsync(chk, 0, 4096, stream);
        const size_t offs[7] = {WS_Q, WS_K, WS_V, WS_U, WS_GA, WS_GB, WS_END};
        for (int run = 0; run < 2; ++run) {
            for (int p = 0; p < 6; ++p) { a.ph_lo = p; a.ph_hi = p + 1; hipLaunchKernelGGL(mega_fwd, dim3(grid), dim3(512), LDS_BYTES, stream, a); }
            for (int i = 0; i < 6; ++i) hipLaunchKernelGGL(chk_kernel, dim3(2048), dim3(256), 0, stream, (const unsigned*)(ws + offs[i]), (offs[i + 1] - offs[i]) / 4, chk + run * 16 + i);
        }
        hipLaunchKernelGGL(verdict_kernel, dim3(2048), dim3(256), 0, stream, (const unsigned long long*)chk, (float*)d_out, (size_t)T * D);
    }
#elif MK_MULTI_LAUNCH
    for (int p = 0; p < NPHASE; ++p) { const bool is_gemm = (p == 2 || p == 3 || p == 5 || p == 7 || p == 8 || p == 10 || p == 11);
        const int reps = (MK_MULTI_LAUNCH == 3 && is_gemm) ? 2 : ((MK_MULTI_LAUNCH == 4 && !is_gemm && p != 9 && p != 12) ? 2 : 1);
        for (int rep = 0; rep < reps; ++rep) { a.ph_lo = p; a.ph_hi = p + 1; hipLaunchKernelGGL(mega_fwd, dim3(grid), dim3(512), LDS_BYTES, stream, a); } }
#else
    a.ph_lo = 0; a.ph_hi = NPHASE;
    void* args[] = {&a};
    hipError_t e = hipLaunchCooperativeKernel((const void*)mega_fwd, dim3(grid), dim3(512), args, LDS_BYTES, stream);
    if (e != hipSuccess) fprintf(stderr, "kernel_launch: cooperative launch failed: %s (grid %d)\n", hipGetErrorString(e), grid);
#endif
}
```

```cpp
#include <hip/hip_runtime.h>
#include <hip/hip_cooperative_groups.h>
#include <cstdio>
#include <cstdint>
namespace cg = cooperative_groups;

#ifndef MK_MULTI_LAUNCH
#define MK_MULTI_LAUNCH 0
#endif
#ifndef MK_GEMM_REP
#define MK_GEMM_REP 1
#endif
#ifndef MK_DUP
#define MK_DUP -1
#endif

#define LAS __attribute__((address_space(3)))
typedef unsigned short bf16_t;
typedef short bf16x8 __attribute__((ext_vector_type(8)));
typedef float f32x4 __attribute__((ext_vector_type(4)));
typedef float f32x2 __attribute__((ext_vector_type(2)));
typedef unsigned u32x4 __attribute__((ext_vector_type(4)));
typedef unsigned u32x2 __attribute__((ext_vector_type(2)));
typedef short s16x4 __attribute__((ext_vector_type(4)));

constexpr int D = 1024, SEQ = 8192, NSEQ = 10, NPROMPT = 8, T = NSEQ * SEQ, FF = 2816, NIN = 3328;
constexpr int NMOD = 9 * D;
constexpr float EPS = 1e-6f;
constexpr float LOG2E = 1.4426950408889634f;

constexpr size_t MiB = 1u << 20;
constexpr size_t WS_MOD = 0;
constexpr size_t WS_CTL = 384 * 1024, CTL_BYTES = 16 * 1024;
constexpr size_t WS_CT = 1 * MiB, WS_ST = 2 * MiB;
constexpr size_t WS_W1GU = 3 * MiB;
constexpr size_t WS_W1D = 14 * MiB;
constexpr size_t WS_W2GU = 20 * MiB;
constexpr size_t WS_W2D = 31 * MiB;
constexpr size_t WS_WIN = 37 * MiB;
constexpr size_t WS_WAB = 44 * MiB;
constexpr size_t WS_WPB = 45 * MiB;
constexpr size_t WS_WOUT = 46 * MiB;
constexpr size_t WS_H = 48 * MiB;
constexpr size_t WS_Y = 208 * MiB;
constexpr size_t WS_BIG = 368 * MiB;
constexpr size_t WS_Q = WS_BIG, WS_K = WS_Q + 80 * MiB, WS_V = WS_K + 20 * MiB, WS_U = WS_V + 20 * MiB, WS_GA = WS_U + 80 * MiB, WS_GB = WS_GA + 160 * MiB;
constexpr size_t WS_END = WS_GB + 160 * MiB;
static_assert((size_t)T * D * 2 == 160 * MiB && (size_t)T * FF * 2 == 440 * MiB && (size_t)T * 512 * 2 == 80 * MiB && (size_t)T * 128 * 2 == 20 * MiB, "ws map");

constexpr int LDS_BYTES = 135168;

typedef __bf16 bf16x2v __attribute__((ext_vector_type(2)));
__device__ __forceinline__ unsigned cvt_pk_bf16(float lo, float hi) { const f32x2 v = {lo, hi}; return __builtin_bit_cast(unsigned, __builtin_convertvector(v, bf16x2v)); }
__device__ __forceinline__ float bf_lo(unsigned w) { return __builtin_bit_cast(float, w << 16); }
__device__ __forceinline__ float bf_hi(unsigned w) { return __builtin_bit_cast(float, w & 0xffff0000u); }
__device__ __forceinline__ float fast_sigmoid(float x) { return __builtin_amdgcn_rcpf(1.0f + __builtin_amdgcn_exp2f(-x * LOG2E)); }
__device__ __forceinline__ float fast_silu(float x) { return x * fast_sigmoid(x); }
__device__ __forceinline__ f32x2 sigmoid2(f32x2 x) { const f32x2 t = x * (-LOG2E); f32x2 e; e.x = __builtin_amdgcn_exp2f(t.x); e.y = __builtin_amdgcn_exp2f(t.y);
    const f32x2 d = e + 1.0f; f32x2 r; r.x = __builtin_amdgcn_rcpf(d.x); r.y = __builtin_amdgcn_rcpf(d.y); return r; }
__device__ __forceinline__ unsigned swiglu_pk(float g0, float g1, float u0, float u1) { const f32x2 g = {g0, g1}, u = {u0, u1}; const f32x2 o = (g * u) * sigmoid2(g); return cvt_pk_bf16(o.x, o.y); }
__device__ __forceinline__ unsigned sigmoid_pk(float a, float b) { const f32x2 r = sigmoid2((f32x2){a, b}); return cvt_pk_bf16(r.x, r.y); }
__device__ __forceinline__ float wave_sum(float v) {
#pragma unroll
    for (int o = 1; o < 64; o <<= 1) v += __shfl_xor(v, o);
    return v;
}
#define LDS_WAIT() asm volatile("s_waitcnt lgkmcnt(0)" ::: "memory")
__device__ __forceinline__ size_t blk_off(int row, int col, int KB) { return ((size_t)(row >> 8) * KB + (col >> 6)) * 16384 + (size_t)(((row & 255) << 6) + (col & 63)); }

namespace pg8 {
constexpr int BM = 256, BK = 64, HALF = 128, HTB = HALF * BK * 2, STAGE_BYTES = 8 * HTB, NXCD = 8, WGM = 8;
__host__ __device__ __forceinline__ int lds_byte(int r, int c) { const int st = (r >> 4) * 2 + (c >> 5), rr = r & 15, cc = c & 31, ob = rr * 64 + cc * 2; return st * 1024 + (ob ^ (((ob >> 9) & 1) << 5)); }
__host__ __device__ __forceinline__ void stage_rc(int b, int& R, int& C) { const int st = b / 1024, sb = b % 1024, swz = sb ^ (((sb >> 9) & 1) << 5); R = (st >> 1) * 16 + swz / 64; C = (st & 1) * 32 + (swz % 64) / 2; }
__host__ __device__ __forceinline__ int perm32(int rho) { const int n = rho >> 4, i = rho & 15; return 8 * (i >> 2) + 4 * n + (i & 3); }

struct Unit { int pm, pn; };
struct Gemm { const bf16_t* A; const bf16_t* Bt; int M, N, K; };

struct StaticOrder {
    int nM, nN, nwg, G, c, rev;
    __device__ void init(int M, int N, int G_, int c_, int rev_ = 0) { nM = M / BM; nN = N / BM; nwg = nM * nN; G = G_; c = c_; rev = rev_; }
    __device__ bool next(int i, Unit& u) const {
        const long L = (long)i * G + c; if (L >= nwg) return false;
        int wgid = (int)L; { const int q = nwg / NXCD, r = nwg % NXCD, xcd = wgid % NXCD, off = wgid / NXCD; wgid = (xcd < r ? xcd * (q + 1) : r * (q + 1) + (xcd - r) * q) + off; }
        const int nig = WGM * nN, gid = wgid / nig, fm = gid * WGM, gsz = (nM - fm) < WGM ? (nM - fm) : WGM;
        const int pm = fm + ((wgid % nig) % gsz); u.pm = rev ? (nM - 1 - pm) : pm; u.pn = (wgid % nig) / gsz; return true;
    }
    __device__ __forceinline__ void a_ready(const Unit&) const {}
    __device__ __forceinline__ void done(const Unit&) const {}
};

typedef f32x4 Acc[2][2][4][2];

struct EpiBf16 {
    static constexpr bool PERM = true, AFTER_DRAIN = false, HAS_MID = false;
    bf16_t* O; int ldc;
    __device__ __forceinline__ void operator()(const Acc& acc, const Unit& u, int wr, int wc, int fr, int fq) const {
        const int row0 = u.pm * BM + wr * 64 + fr, col0 = u.pn * BM + wc * 32 + 8 * fq;
#pragma unroll
        for (int ai = 0; ai < 2; ++ai)
#pragma unroll
            for (int m = 0; m < 4; ++m) { bf16_t* rowp = O + (size_t)(row0 + ai * HALF + m * 16) * ldc + col0;
#pragma unroll
                for (int bj = 0; bj < 2; ++bj) { const f32x4 v0 = acc[ai][bj][m][0], v1 = acc[ai][bj][m][1];
                    u32x4 w; w.x = cvt_pk_bf16(v0[0], v0[1]); w.y = cvt_pk_bf16(v0[2], v0[3]); w.z = cvt_pk_bf16(v1[0], v1[1]); w.w = cvt_pk_bf16(v1[2], v1[3]);
                    *(u32x4*)(rowp + bj * HALF) = w; } }
    }
};

struct EpiSwiGLU {
    static constexpr bool PERM = true, AFTER_DRAIN = false, HAS_MID = false;
    bf16_t* O; int ldc;
    __device__ __forceinline__ void operator()(const Acc& acc, const Unit& u, int wr, int wc, int fr, int fq) const {
        const int row0 = u.pm * BM + wr * 64 + fr, col0 = u.pn * HALF + wc * 32 + 8 * fq;
#pragma unroll
        for (int ai = 0; ai < 2; ++ai)
#pragma unroll
            for (int m = 0; m < 4; ++m) { bf16_t* rowp = O + blk_off(row0 + ai * HALF + m * 16, col0, ldc / 64);
                const f32x4 g0 = acc[ai][0][m][0], g1 = acc[ai][0][m][1], u0 = acc[ai][1][m][0], u1 = acc[ai][1][m][1];
                u32x4 w;
                w.x = swiglu_pk(g0[0], g0[1], u0[0], u0[1]); w.y = swiglu_pk(g0[2], g0[3], u0[2], u0[3]);
                w.z = swiglu_pk(g1[0], g1[1], u1[0], u1[1]); w.w = swiglu_pk(g1[2], g1[3], u1[2], u1[3]);
                *(u32x4*)rowp = w; }
    }
};

struct EpiProj {
    static constexpr bool PERM = true, AFTER_DRAIN = false, HAS_MID = false;
    bf16_t *Q, *K, *V, *U, *GA, *GB; const float *ct, *st;
    __device__ __forceinline__ void rope_store(const Acc& acc, int row0, bf16_t* base, int ld, int colbase, int fq, float sc) const {
#pragma unroll
        for (int ai = 0; ai < 2; ++ai)
#pragma unroll
            for (int m = 0; m < 4; ++m) { const int row = row0 + ai * HALF + m * 16; const int pos = row & (SEQ - 1);
                const float* cp = ct + pos * 32 + 8 * fq; const float* sp = st + pos * 32 + 8 * fq;
                const f32x4 c0 = *(const f32x4*)cp, c1 = *(const f32x4*)(cp + 4), s0 = *(const f32x4*)sp, s1 = *(const f32x4*)(sp + 4);
                const f32x4 a0 = acc[ai][0][m][0] * sc, a1 = acc[ai][0][m][1] * sc, b0 = acc[ai][1][m][0] * sc, b1 = acc[ai][1][m][1] * sc;
                const f32x4 lo0 = a0 * c0 - b0 * s0, lo1 = a1 * c1 - b1 * s1, hi0 = b0 * c0 + a0 * s0, hi1 = b1 * c1 + a1 * s1;
                bf16_t* p = base + (size_t)row * ld + colbase + 8 * fq;
                u32x4 w; w.x = cvt_pk_bf16(lo0[0], lo0[1]); w.y = cvt_pk_bf16(lo0[2], lo0[3]); w.z = cvt_pk_bf16(lo1[0], lo1[1]); w.w = cvt_pk_bf16(lo1[2], lo1[3]);
                *(u32x4*)p = w;
                w.x = cvt_pk_bf16(hi0[0], hi0[1]); w.y = cvt_pk_bf16(hi0[2], hi0[3]); w.z = cvt_pk_bf16(hi1[0], hi1[1]); w.w = cvt_pk_bf16(hi1[2], hi1[3]);
                *(u32x4*)(p + 32) = w;
                if (m & 1) asm volatile("" ::: "memory"); }
    }
    template <int ACT> __device__ __forceinline__ void plain_store(const Acc& acc, int row0, bf16_t* base, int ld, int col0) const {
#pragma unroll
        for (int ai = 0; ai < 2; ++ai)
#pragma unroll
            for (int m = 0; m < 4; ++m) { bf16_t* rowp = base + (size_t)(row0 + ai * HALF + m * 16) * ld + col0;
#pragma unroll
                for (int bj = 0; bj < 2; ++bj) { const f32x4 v0 = acc[ai][bj][m][0], v1 = acc[ai][bj][m][1];
                    u32x4 w;
                    if (ACT == 1) { w.x = sigmoid_pk(v0[0], v0[1]); w.y = sigmoid_pk(v0[2], v0[3]); w.z = sigmoid_pk(v1[0], v1[1]); w.w = sigmoid_pk(v1[2], v1[3]); }
                    else { w.x = cvt_pk_bf16(v0[0], v0[1]); w.y = cvt_pk_bf16(v0[2], v0[3]); w.z = cvt_pk_bf16(v1[0], v1[1]); w.w = cvt_pk_bf16(v1[2], v1[3]); }
                    *(u32x4*)(rowp + bj * HALF) = w; }
                asm volatile("" ::: "memory"); }
    }
    __device__ __forceinline__ void operator()(const Acc& acc, const Unit& u, int wr, int wc, int fr, int fq) const {
        int row0 = u.pm * BM + wr * 64 + fr; const int pn = u.pn;
#define OPAQUE_ROW() asm volatile("" : "+v"(row0))
        if (pn < 2) { OPAQUE_ROW(); rope_store(acc, row0, Q, 512, (4 * pn + wc) * 64, fq, 0.125f * LOG2E); }
        else if (pn == 2) {
            if (wc < 2) { OPAQUE_ROW(); rope_store(acc, row0, K, 128, wc * 64, fq, 1.0f); }
            else { OPAQUE_ROW();
#pragma unroll
                for (int ai = 0; ai < 2; ++ai)
#pragma unroll
                    for (int m = 0; m < 4; ++m) { bf16_t* rowp = V + (size_t)(row0 + ai * HALF + m * 16) * 128 + (wc - 2) * 32 + 8 * fq;
#pragma unroll
                        for (int bj = 0; bj < 2; ++bj) { const f32x4 v0 = acc[ai][bj][m][0], v1 = acc[ai][bj][m][1];
                            u32x4 w; w.x = cvt_pk_bf16(v0[0], v0[1]); w.y = cvt_pk_bf16(v0[2], v0[3]); w.z = cvt_pk_bf16(v1[0], v1[1]); w.w = cvt_pk_bf16(v1[2], v1[3]);
                            *(u32x4*)(rowp + bj * 64) = w; } }
            }
        }
        else if (pn < 5) { OPAQUE_ROW(); plain_store<0>(acc, row0, U, 512, (pn - 3) * BM + wc * 32 + 8 * fq); }
        else { OPAQUE_ROW(); bf16_t* gbase = pn < 9 ? GA : GB; const int gt = pn < 9 ? pn - 5 : pn - 9; plain_store<1>(acc, row0, gbase, D, gt * BM + wc * 32 + 8 * fq); }
#undef OPAQUE_ROW
    }
};

struct EpiMerge {
    static constexpr bool PERM = true, AFTER_DRAIN = false, HAS_MID = true;
    bf16_t* O; const bf16_t* Ga; const bf16_t* Gb;
    __device__ __forceinline__ void mid(Acc& acc, const Unit& u, int wr, int wc, int fr, int fq) const {
        int row0 = u.pm * BM + wr * 64 + fr, col0 = u.pn * BM + wc * 32 + 8 * fq; asm volatile("" : "+v"(row0), "+v"(col0));
#pragma unroll
        for (int ai = 0; ai < 2; ++ai)
#pragma unroll
            for (int m = 0; m < 4; ++m) { const size_t offg = (size_t)(row0 + ai * HALF + m * 16) * D + col0;
#pragma unroll
                for (int bj = 0; bj < 2; ++bj) {
                    const u32x4 a = *(const u32x4*)(Ga + offg + bj * HALF), b = *(const u32x4*)(Gb + offg + bj * HALF);
                    const float r0 = bf_lo(a.x) * __builtin_amdgcn_rcpf(fmaxf(bf_lo(b.x), 1e-30f)), r1 = bf_hi(a.x) * __builtin_amdgcn_rcpf(fmaxf(bf_hi(b.x), 1e-30f));
                    const float r2 = bf_lo(a.y) * __builtin_amdgcn_rcpf(fmaxf(bf_lo(b.y), 1e-30f)), r3 = bf_hi(a.y) * __builtin_amdgcn_rcpf(fmaxf(bf_hi(b.y), 1e-30f));
                    acc[ai][bj][m][0] = acc[ai][bj][m][0] * (f32x4){r0, r1, r2, r3};
                    const float r4 = bf_lo(a.z) * __builtin_amdgcn_rcpf(fmaxf(bf_lo(b.z), 1e-30f)), r5 = bf_hi(a.z) * __builtin_amdgcn_rcpf(fmaxf(bf_hi(b.z), 1e-30f));
                    const float r6 = bf_lo(a.w) * __builtin_amdgcn_rcpf(fmaxf(bf_lo(b.w), 1e-30f)), r7 = bf_hi(a.w) * __builtin_amdgcn_rcpf(fmaxf(bf_hi(b.w), 1e-30f));
                    acc[ai][bj][m][1] = acc[ai][bj][m][1] * (f32x4){r4, r5, r6, r7}; }
                if (m & 1) asm volatile("" ::: "memory"); }
    }
    __device__ __forceinline__ void operator()(const Acc& acc, const Unit& u, int wr, int wc, int fr, int fq) const {
        int row0 = u.pm * BM + wr * 64 + fr, col0 = u.pn * BM + wc * 32 + 8 * fq; asm volatile("" : "+v"(row0), "+v"(col0));
#pragma unroll
        for (int ai = 0; ai < 2; ++ai)
#pragma unroll
            for (int m = 0; m < 4; ++m) { const size_t offg = (size_t)(row0 + ai * HALF + m * 16) * D + col0;
#pragma unroll
                for (int bj = 0; bj < 2; ++bj) { const f32x4 v0 = acc[ai][bj][m][0], v1 = acc[ai][bj][m][1];
                    const u32x4 g = *(const u32x4*)(Gb + offg + bj * HALF);
                    const float q0 = fmaxf(bf_lo(g.x), 1e-30f), q1 = fmaxf(bf_hi(g.x), 1e-30f), q2 = fmaxf(bf_lo(g.y), 1e-30f), q3 = fmaxf(bf_hi(g.y), 1e-30f);
                    const float q4 = fmaxf(bf_lo(g.z), 1e-30f), q5 = fmaxf(bf_hi(g.z), 1e-30f), q6 = fmaxf(bf_lo(g.w), 1e-30f), q7 = fmaxf(bf_hi(g.w), 1e-30f);
                    u32x4 w; w.x = cvt_pk_bf16(v0[0] * q0, v0[1] * q1); w.y = cvt_pk_bf16(v0[2] * q2, v0[3] * q3); w.z = cvt_pk_bf16(v1[0] * q4, v1[1] * q5); w.w = cvt_pk_bf16(v1[2] * q6, v1[3] * q7);
                    *(u32x4*)(O + blk_off(row0 + ai * HALF + m * 16, col0 + bj * HALF, D / 64)) = w; }
                if (m & 1) asm volatile("" ::: "memory"); }
    }
};

template <class Epi, class Sched, bool ALIGN_EPI = false, bool SP2 = false>
__device__ __forceinline__ void gemm_phase(LAS unsigned char* lds, const Gemm g, const Sched& S, const Epi& E) {
    const int tid = threadIdx.x, wid = __builtin_amdgcn_readfirstlane(tid >> 6), lane = tid & 63, wr = wid >> 2, wc = wid & 3, fr = lane & 15, fq = lane >> 4;
    const int K = g.K, nt = K / BK;
    unsigned voffA[2], voffB[2];
#pragma unroll
    for (int i = 0; i < 2; ++i) { int R, C; stage_rc(tid * 16 + i * 8192, R, C); const int Rb = Epi::PERM ? ((R & ~31) + perm32(R & 31)) : R;
        voffA[i] = (unsigned)(R * 64 + C) * 2u; voffB[i] = (unsigned)(Rb * 64 + C) * 2u; }
    const size_t kstep = (size_t)BM * BK * 2;
    const size_t hstep = (size_t)HALF * BK * 2;
    const size_t tstep = (size_t)nt * kstep;
    const unsigned ldsw = (unsigned)wid * 1024u;
    const int aoff = lds_byte(wr * 64 + fr, fq * 8), boff = lds_byte(wc * 32 + fr, fq * 8);
#define PG8_SA(b, h) (((b) * 2 + (h)) * HTB)
#define PG8_SB(b, h) ((4 + (b) * 2 + (h)) * HTB)
#define PG8_STAGE(bufoff, gbase, voff) do { _Pragma("unroll") for (int _i = 0; _i < 2; ++_i) \
        __builtin_amdgcn_global_load_lds((const unsigned*)((const char*)(gbase) + (voff)[_i]), (LAS unsigned*)(lds + (bufoff) + ldsw + _i * 8192), 16, 0, 0); } while (0)
#define PG8_LDA(dst, b, h) do { _Pragma("unroll") for (int m = 0; m < 4; ++m) _Pragma("unroll") for (int k = 0; k < 2; ++k) dst[m][k] = *(const LAS bf16x8*)(lds + PG8_SA(b, h) + aoff + m * 2048 + k * 1024); } while (0)
#define PG8_LDB(dst, b, h) do { _Pragma("unroll") for (int n = 0; n < 2; ++n) _Pragma("unroll") for (int k = 0; k < 2; ++k) dst[n][k] = *(const LAS bf16x8*)(lds + PG8_SB(b, h) + boff + n * 2048 + k * 1024); } while (0)
#define PG8_MMA(ai, bj, At, Bt) do { __builtin_amdgcn_s_setprio(1); _Pragma("unroll") for (int m = 0; m < 4; ++m) _Pragma("unroll") for (int n = 0; n < 2; ++n) _Pragma("unroll") for (int k = 0; k < 2; ++k) \
        acc[ai][bj][m][n] = __builtin_amdgcn_mfma_f32_16x16x32_bf16(Bt[n][k], At[m][k], acc[ai][bj][m][n], 0, 0, 0); __builtin_amdgcn_s_setprio(0); } while (0)
#define PG8_WAIT_V(n) asm volatile("s_waitcnt vmcnt(" #n ")" ::: "memory")
#define PG8_WAIT_V8_UNLESS(f) asm volatile("s_cmp_lg_u32 %0, 0\n\ts_cbranch_scc1 .Lpg8skip%=\n\ts_waitcnt vmcnt(8)\n.Lpg8skip%=:" :: "s"(f) : "scc", "memory")
#define PG8_WAIT_L(n) asm volatile("s_waitcnt lgkmcnt(" #n ")" ::: "memory")
#define PG8_BAR __builtin_amdgcn_s_barrier()
#define PG8_SCHED __builtin_amdgcn_sched_barrier(0)
    Unit cur, nxt; int ui = 0;
    if (!S.next(0, cur)) return;
    f32x4 acc[2][2][4][2];
#pragma unroll
    for (int a = 0; a < 2; ++a)
#pragma unroll
        for (int b = 0; b < 2; ++b)
#pragma unroll
            for (int m = 0; m < 4; ++m)
#pragma unroll
                for (int n = 0; n < 2; ++n) acc[a][b][m][n] = (f32x4){0.f, 0.f, 0.f, 0.f};
    bf16x8 At[4][2], B0[2][2], B1[2][2];
    const char* cA = (const char*)g.A + (size_t)cur.pm * tstep; const char* cB = (const char*)g.Bt + (size_t)cur.pn * tstep;
    S.a_ready(cur);
    if constexpr (SP2) {
        PG8_STAGE(PG8_SB(0, 0), cB, voffB); PG8_STAGE(PG8_SB(0, 1), cB + hstep, voffB); PG8_STAGE(PG8_SA(0, 0), cA, voffA); PG8_STAGE(PG8_SA(0, 1), cA + hstep, voffA);
        if (wr == 1) PG8_BAR;
        PG8_WAIT_V(2); PG8_BAR;
        PG8_STAGE(PG8_SB(1, 0), cB + kstep, voffB); PG8_STAGE(PG8_SA(1, 0), cA + kstep, voffA); PG8_STAGE(PG8_SB(1, 1), cB + hstep + kstep, voffB);
        PG8_WAIT_V(6); PG8_BAR;
    } else {
        PG8_STAGE(PG8_SB(0, 0), cB, voffB); PG8_STAGE(PG8_SA(0, 0), cA, voffA); PG8_STAGE(PG8_SB(0, 1), cB + hstep, voffB); PG8_STAGE(PG8_SA(0, 1), cA + hstep, voffA);
        if (wr == 1) PG8_BAR;
        PG8_WAIT_V(4); PG8_BAR;
        PG8_STAGE(PG8_SB(1, 0), cB + kstep, voffB); PG8_STAGE(PG8_SA(1, 0), cA + kstep, voffA); PG8_STAGE(PG8_SB(1, 1), cB + hstep + kstep, voffB);
        PG8_WAIT_V(6); PG8_BAR;
    }
    for (;;) {
        const bool has_next = S.next(ui + 1, nxt);
        const char* nA = has_next ? (const char*)g.A + (size_t)nxt.pm * tstep : cA; const char* nB = has_next ? (const char*)g.Bt + (size_t)nxt.pn * tstep : cB;
        for (int t = 0; t < nt; t += 2) {
            const bool last = (t == nt - 2);
            const char* a1 = cA + (size_t)(t + 1) * kstep;
            const char* a2 = last ? nA : cA + (size_t)(t + 2) * kstep; const char* b2 = last ? nB : cB + (size_t)(t + 2) * kstep;
            const char* a3 = a2 + kstep; const char* b3 = b2 + kstep;
            if (last && has_next) S.a_ready(nxt);
            if constexpr (SP2) {
            if constexpr (Epi::HAS_MID) { if (t == nt / 2) E.mid(acc, cur, wr, wc, fr, fq); }
            const int fresh = __builtin_amdgcn_readfirstlane(((t == 0) && (ui > 0)) ? 1 : 0);
            PG8_LDB(B0, 0, 0); PG8_LDB(B1, 0, 1); PG8_SCHED; PG8_LDA(At, 0, 0); PG8_STAGE(PG8_SA(1, 1), a1 + hstep, voffA);
            PG8_WAIT_V8_UNLESS(fresh); PG8_WAIT_L(0); PG8_BAR; PG8_MMA(0, 0, At, B0); PG8_MMA(0, 1, At, B1); PG8_BAR; PG8_SCHED;
            PG8_LDA(At, 0, 1); PG8_STAGE(PG8_SB(0, 0), b2, voffB); PG8_STAGE(PG8_SB(0, 1), b2 + hstep, voffB); PG8_STAGE(PG8_SA(0, 0), a2, voffA);
            PG8_WAIT_V8_UNLESS(fresh); PG8_WAIT_L(0); PG8_BAR; PG8_MMA(1, 0, At, B0); PG8_MMA(1, 1, At, B1); PG8_BAR; PG8_SCHED;
            PG8_LDB(B0, 1, 0); PG8_LDB(B1, 1, 1); PG8_SCHED; PG8_LDA(At, 1, 0); PG8_STAGE(PG8_SA(0, 1), a2 + hstep, voffA);
            PG8_WAIT_V(8); PG8_WAIT_L(0); PG8_BAR; PG8_MMA(0, 0, At, B0); PG8_MMA(0, 1, At, B1); PG8_BAR; PG8_SCHED;
            PG8_LDA(At, 1, 1); PG8_STAGE(PG8_SB(1, 0), b3, voffB); PG8_STAGE(PG8_SB(1, 1), b3 + hstep, voffB); PG8_STAGE(PG8_SA(1, 0), a3, voffA);
            PG8_WAIT_V(8); PG8_WAIT_L(0); PG8_BAR; PG8_MMA(1, 0, At, B0); PG8_MMA(1, 1, At, B1); PG8_BAR; PG8_SCHED;
            } else {
            PG8_LDB(B0, 0, 0); PG8_SCHED; PG8_LDA(At, 0, 0); PG8_STAGE(PG8_SA(1, 1), a1 + hstep, voffA);
            PG8_WAIT_L(8); PG8_BAR; PG8_WAIT_L(0); PG8_MMA(0, 0, At, B0); PG8_BAR; PG8_SCHED;
            PG8_LDB(B1, 0, 1); PG8_STAGE(PG8_SB(0, 0), b2, voffB);
            PG8_BAR; PG8_WAIT_L(0); PG8_MMA(0, 1, At, B1); PG8_BAR;
            PG8_LDA(At, 0, 1); PG8_STAGE(PG8_SA(0, 0), a2, voffA);
            PG8_BAR; PG8_WAIT_L(0); PG8_MMA(1, 0, At, B0); PG8_BAR; PG8_SCHED;
            PG8_STAGE(PG8_SB(0, 1), b2 + hstep, voffB);
            PG8_WAIT_V(6); PG8_BAR; PG8_MMA(1, 1, At, B1); PG8_BAR;
            PG8_LDB(B0, 1, 0); PG8_SCHED; PG8_LDA(At, 1, 0); PG8_STAGE(PG8_SA(0, 1), a2 + hstep, voffA);
            PG8_WAIT_L(8); PG8_BAR; PG8_WAIT_L(0); PG8_MMA(0, 0, At, B0); PG8_BAR; PG8_SCHED;
            PG8_LDB(B1, 1, 1); PG8_STAGE(PG8_SB(1, 0), b3, voffB);
            PG8_BAR; PG8_WAIT_L(0); PG8_MMA(0, 1, At, B1); PG8_BAR;
            PG8_LDA(At, 1, 1); PG8_STAGE(PG8_SA(1, 0), a3, voffA);
            PG8_BAR; PG8_WAIT_L(0); PG8_MMA(1, 0, At, B0); PG8_BAR; PG8_SCHED;
            PG8_STAGE(PG8_SB(1, 1), b3 + hstep, voffB);
            PG8_WAIT_V(6); PG8_BAR; PG8_MMA(1, 1, At, B1); PG8_BAR;
            }
        }
        if constexpr (ALIGN_EPI) { if (wr == 0) PG8_BAR; }
        if constexpr (SP2) PG8_WAIT_V(0);
        if constexpr (!Epi::AFTER_DRAIN) { E(acc, cur, wr, wc, fr, fq); S.done(cur); }
        if (!has_next) break;
#pragma unroll
        for (int a = 0; a < 2; ++a)
#pragma unroll
            for (int b = 0; b < 2; ++b)
#pragma unroll
                for (int m = 0; m < 4; ++m)
#pragma unroll
                    for (int n = 0; n < 2; ++n) acc[a][b][m][n] = (f32x4){0.f, 0.f, 0.f, 0.f};
        cur = nxt; cA = nA; cB = nB; ++ui;
        if constexpr (ALIGN_EPI) { if (wr == 1) PG8_BAR; }
    }
    PG8_WAIT_V(0);
    if constexpr (!ALIGN_EPI) { if (wr == 0) PG8_BAR; }
    PG8_BAR;
#undef PG8_SA
#undef PG8_SB
#undef PG8_STAGE
#undef PG8_LDA
#undef PG8_LDB
#undef PG8_MMA
#undef PG8_WAIT_V
#undef PG8_WAIT_V8_UNLESS
#undef PG8_WAIT_L
#undef PG8_BAR
#undef PG8_SCHED
}
}

#define XB_TMO      128
#define XB_XCNT(j)  (256  + 64 * (j))
#define XB_XSUB(j)  (1280 + 64 * (j))
#define XB_XGEN(j)  (2304 + 64 * (j))
#define XB_TOP      3328
#define XB_TOPGEN   3392
#define XCD_BAR_WORDS 3456
#define XB_SPIN_CAP (1u << 22)
__device__ __forceinline__ unsigned xb_ld(unsigned* p)              { return __hip_atomic_load(p, __ATOMIC_RELAXED, __HIP_MEMORY_SCOPE_AGENT); }
__device__ __forceinline__ unsigned xb_add(unsigned* p, unsigned v) { return __hip_atomic_fetch_add(p, v, __ATOMIC_RELAXED, __HIP_MEMORY_SCOPE_AGENT); }
__device__ __forceinline__ unsigned xb_xcc_id() { return (unsigned)__builtin_amdgcn_s_getreg((3 << 11) | 20) & 0xFu; }
#define XB_SPIN(cond, bar) do { unsigned _sp = 0; while (cond) { __builtin_amdgcn_s_sleep(1); \
    if ((++_sp & 255u) == 0u) { if (xb_ld(&(bar)[XB_TMO])) break; if (_sp > XB_SPIN_CAP) { atomicAdd(&(bar)[XB_TMO], 1u); break; } } } } while (0)
struct XcdBarrier { unsigned* bar; unsigned x; volatile LAS unsigned* st; };
__device__ __forceinline__ XcdBarrier xcd_barrier_post(unsigned* bar, volatile LAS unsigned* st) {
    XcdBarrier b; b.bar = bar; b.x = xb_xcc_id(); b.st = st;
    if (threadIdx.x == 0) st[2] = xb_add(&bar[XB_XCNT(b.x)], 1u);
    return b;
}
__device__ __forceinline__ void xcd_barrier_complete(unsigned* bar, unsigned x, unsigned& nloc, unsigned& nx) {
    const unsigned G = gridDim.x * gridDim.y * gridDim.z;
    unsigned sum, cnt, mine, sp = 0u;
    for (;;) {
        sum = 0u; cnt = 0u; mine = 0u;
#pragma unroll
        for (unsigned j = 0; j < 16; ++j) { const unsigned c = xb_ld(&bar[XB_XCNT(j)]); sum += c; cnt += (c > 0u) ? 1u : 0u; mine = (j == x) ? c : mine; }
        if (sum == G) break;
        __builtin_amdgcn_s_sleep(1);
        if ((++sp & 255u) == 0u) { if (xb_ld(&bar[XB_TMO])) break; if (sp > XB_SPIN_CAP) { atomicAdd(&bar[XB_TMO], 1u); break; } }
    }
    nloc = mine > 0u ? mine : 1u; nx = cnt > 0u ? cnt : 1u;
}
__device__ __forceinline__ void xcd_barrier(const XcdBarrier& b) {
    asm volatile("s_waitcnt vmcnt(0)" ::: "memory");
    __syncthreads();
    if (threadIdx.x == 0) {
        unsigned* bar = b.bar;
        __builtin_amdgcn_s_waitcnt(0);
        unsigned nloc = b.st[0], nx = b.st[1];
        if (nloc == 0u) { xcd_barrier_complete(bar, b.x, nloc, nx); b.st[0] = nloc; b.st[1] = nx; }
        const unsigned old = xb_add(&bar[XB_XSUB(b.x)], 1u);
        const unsigned gen = old / nloc;
        if (old + 1u == (gen + 1u) * nloc) {
            __builtin_amdgcn_fence(__ATOMIC_RELEASE, "agent");
            asm volatile("s_waitcnt vmcnt(0)" ::: "memory");
            const unsigned og = xb_add(&bar[XB_TOP], 1u);
            const unsigned tg = og / nx;
            if (og + 1u == (tg + 1u) * nx) xb_add(&bar[XB_TOPGEN], 1u);
            else XB_SPIN(xb_ld(&bar[XB_TOPGEN]) == tg, bar);
            __builtin_amdgcn_fence(__ATOMIC_ACQUIRE, "agent");
            xb_add(&bar[XB_XGEN(b.x)], 1u);
            asm volatile("s_waitcnt vmcnt(0)" ::: "memory");
        } else {
            XB_SPIN(xb_ld(&bar[XB_XGEN(b.x)]) == gen, bar);
            __builtin_amdgcn_fence(__ATOMIC_ACQUIRE, "agent");
            asm volatile("s_waitcnt vmcnt(0)" ::: "memory");
        }
    }
    __syncthreads();
}

struct Args { const float* in[21]; float* out; unsigned char* ws; int ph_lo, ph_hi; };
enum { I_XP = 0, I_XS, I_CP, I_CS, I_ADAW, I_ADAB, I_NPRE, I_NPOST, I_F1G, I_F1U, I_F1D, I_WIN, I_SINK, I_WAB, I_POOLW, I_POOLS, I_WPB, I_WOUT, I_F2G, I_F2U, I_F2D };

__device__ __forceinline__ int map_row(int mode, int n0) {
    if (mode == 0) return n0;
    if (mode == 1) return 256 * (n0 >> 7) + (n0 & 127);
    if (mode == 2) return 256 * (n0 >> 7) + 128 + (n0 & 127);
    if (n0 < 512) { const int head = n0 >> 6, half = (n0 >> 5) & 1; return 256 * (head >> 2) + 128 * half + (head & 3) * 32; }
    if (n0 < 640) { const int kh = (n0 - 512) >> 6, half = (n0 >> 5) & 1; return 512 + 128 * half + kh * 32; }
    if (n0 < 768) { const int vv = n0 - 640; return 512 + 128 * (vv >> 6) + 64 + (vv & 63); }
    return n0;
}
__device__ __forceinline__ void transpose_item(const float* W, int K, int N, bf16_t* WT, int KB, int mode, LAS float* scr, int item, int lane) {
    const int nblk = N / 32, kb = item / nblk, nb = item % nblk, k0 = 64 * kb, n0 = 32 * nb;
#pragma unroll 8
    for (int i = 0; i < 32; ++i) { const int kk = 2 * i + (lane >> 5); scr[kk * 33 + (lane & 31)] = W[(size_t)(k0 + kk) * N + n0 + (lane & 31)]; }
    LDS_WAIT();
    const int rb = map_row(mode, n0);
    const int c = lane & 7;
#pragma unroll
    for (int j = 0; j < 4; ++j) { const int n = (lane >> 3) + 8 * j; const LAS float* s = scr + (8 * c) * 33 + n;
        u32x4 o; o.x = cvt_pk_bf16(s[0 * 33], s[1 * 33]); o.y = cvt_pk_bf16(s[2 * 33], s[3 * 33]); o.z = cvt_pk_bf16(s[4 * 33], s[5 * 33]); o.w = cvt_pk_bf16(s[6 * 33], s[7 * 33]);
        *(u32x4*)(WT + blk_off(rb + n, k0 + 8 * c, KB)) = o; }
    LDS_WAIT();
}

__device__ __forceinline__ void mod_phase(LAS unsigned char* lds, const Args& a, int G, int bid) {
    const int tid = threadIdx.x, lane = tid & 63, wid = tid >> 6;
    LAS float* sc = (LAS float*)lds;
    LAS float* part = (LAS float*)(lds + 40960);
    for (int i = tid; i < NSEQ * D; i += 512) { const int b = i >> 10, k = i & 1023; const float c = (b < NPROMPT) ? a.in[I_CP][b * D + k] : a.in[I_CS][(b - NPROMPT) * D + k]; sc[i] = c / (1.0f + expf(-c)); }
    __syncthreads();
    float* mod = (float*)(a.ws + WS_MOD);
    for (int it = bid; it < NMOD / 36; it += G) {
        const int j0 = it * 36; const int ln = lane < 36 ? lane : 35;
        float acc[NSEQ];
#pragma unroll
        for (int b = 0; b < NSEQ; ++b) acc[b] = 0.f;
        const float* w = a.in[I_ADAW] + (size_t)(wid * 128) * NMOD + j0 + ln;
#pragma unroll 16
        for (int k = 0; k < 128; ++k) { const float wv = w[(size_t)k * NMOD];
#pragma unroll
            for (int b = 0; b < NSEQ; ++b) acc[b] += sc[b * D + wid * 128 + k] * wv; }
#pragma unroll
        for (int b = 0; b < NSEQ; ++b) part[(wid * NSEQ + b) * 64 + lane] = acc[b];
        __syncthreads();
        for (int i = tid; i < NSEQ * 36; i += 512) { const int b = i / 36, l = i - b * 36; float s = a.in[I_ADAB][j0 + l];
#pragma unroll
            for (int w8 = 0; w8 < 8; ++w8) s += part[(w8 * NSEQ + b) * 64 + l];
            mod[b * NMOD + j0 + l] = s; }
        __syncthreads();
    }
}

__device__ __forceinline__ void prep_phase(LAS unsigned char* lds, const Args& a, int G, int bid) {
    const int tid = threadIdx.x, lane = tid & 63, wid = tid >> 6;
    unsigned char* ws = a.ws;
    LAS float* scr = (LAS float*)(lds + wid * 16384);
    const int gw = bid * 8 + wid, NGW = G * 8;
    constexpr int I_GU = (D / 64) * (FF / 32), I_DN = (FF / 64) * (D / 32), I_IN = (D / 64) * (NIN / 32), I_AB = (512 / 64) * (D / 32), I_OUT = (D / 64) * (D / 32);
    constexpr int NITEMS = 4 * I_GU + 2 * I_DN + I_IN + I_AB + I_OUT;
    for (int it = gw; it < NITEMS; it += NGW) {
        int r = it;
        if (r < I_GU) { transpose_item(a.in[I_F1G], D, FF, (bf16_t*)(ws + WS_W1GU), D / 64, 1, scr, r, lane); continue; } r -= I_GU;
        if (r < I_GU) { transpose_item(a.in[I_F1U], D, FF, (bf16_t*)(ws + WS_W1GU), D / 64, 2, scr, r, lane); continue; } r -= I_GU;
        if (r < I_GU) { transpose_item(a.in[I_F2G], D, FF, (bf16_t*)(ws + WS_W2GU), D / 64, 1, scr, r, lane); continue; } r -= I_GU;
        if (r < I_GU) { transpose_item(a.in[I_F2U], D, FF, (bf16_t*)(ws + WS_W2GU), D / 64, 2, scr, r, lane); continue; } r -= I_GU;
        if (r < I_DN) { transpose_item(a.in[I_F1D], FF, D, (bf16_t*)(ws + WS_W1D), FF / 64, 0, scr, r, lane); continue; } r -= I_DN;
        if (r < I_DN) { transpose_item(a.in[I_F2D], FF, D, (bf16_t*)(ws + WS_W2D), FF / 64, 0, scr, r, lane); continue; } r -= I_DN;
        if (r < I_IN) { transpose_item(a.in[I_WIN], D, NIN, (bf16_t*)(ws + WS_WIN), D / 64, 3, scr, r, lane); continue; } r -= I_IN;
        if (r < I_AB) { transpose_item(a.in[I_WAB], 512, D, (bf16_t*)(ws + WS_WAB), D / 64, 0, scr, r, lane); continue; } r -= I_AB;
        transpose_item(a.in[I_WOUT], D, D, (bf16_t*)(ws + WS_WOUT), D / 64, 0, scr, r, lane);
    }
    {
        const float* pw = a.in[I_POOLW]; const float* ps = a.in[I_POOLS]; const float* wpb = a.in[I_WPB]; bf16_t* o = (bf16_t*)(ws + WS_WAB);
        for (int it = gw; it < 2048; it += NGW) {
            const int nq = it & 3, c = (it >> 2) & 127, g = it >> 9;
            scr[lane] = pw[(g * 128 + c) * 128 + lane] * ps[g * 128 + lane];
            scr[lane + 64] = pw[(g * 128 + c) * 128 + lane + 64] * ps[g * 128 + lane + 64];
            LDS_WAIT();
            for (int nc = 0; nc < 4; ++nc) { const int n = nq * 256 + nc * 64 + lane; float s = 0.f; const float* wp = wpb + (size_t)(g * 128) * D + n;
#pragma unroll 8
                for (int d = 0; d < 128; ++d) s += scr[d] * wp[(size_t)d * D];
                o[blk_off(n, 512 + g * 128 + c, 16)] = (bf16_t)(cvt_pk_bf16(s, 0.f) & 0xffffu); }
            LDS_WAIT();
        }
    }
    {
        float* ct = (float*)(ws + WS_CT); float* st = (float*)(ws + WS_ST);
        for (int i = bid * 512 + tid; i < SEQ * 32; i += G * 512) { const int pos = i >> 5, f = i & 31;
            const float inv = exp2f(-(float)f * (13.287712379549449f / 32.0f));
            const float ang = (float)pos * inv;
            const double ad = (double)ang; const double kk = rint(ad * 0.15915494309189535);
            double r = fma(-kk, 6.283185307179586, ad); r = fma(-kk, 2.4492935982947064e-16, r);
            const float rf = (float)r;
            ct[i] = cosf(rf); st[i] = sinf(rf); }
    }
}

__device__ __forceinline__ const float* xrow_in(const Args& a, int row) { return row < NPROMPT * SEQ ? a.in[I_XP] + (size_t)row * D : a.in[I_XS] + (size_t)(row - NPROMPT * SEQ) * D; }

template <int MODE, bool XF32> __device__ __forceinline__ void norm_phase(const Args& a, int j, float rw, int G, int bid, const bf16_t* Xin, const bf16_t* Yin, bf16_t* Xout) {
    const int tid = threadIdx.x, lane = tid & 63, wid = tid >> 6;
    const int gw = bid * 8 + wid, NGW = G * 8;
    const float* mod = (const float*)(a.ws + WS_MOD);
    bf16_t* H = (bf16_t*)(a.ws + WS_H);
    const int rpw = (((T + NGW - 1) / NGW) + 3) & ~3;
    const int r0 = gw * rpw, r1 = (r0 + rpw) < T ? (r0 + rpw) : T;
    int cur_b = -1;
    f32x4 pA[4], pB[4], pC[4];
#pragma unroll
    for (int q = 0; q < 4; ++q) { pA[q] = (f32x4){0.f, 0.f, 0.f, 0.f}; pB[q] = pA[q]; pC[q] = pA[q]; }
    for (int r = r0; r < r1; r += 4) {
        const int b = r >> 13;
        if (b != cur_b) { cur_b = b;
            if (MODE != 0) { const f32x4* gp = (const f32x4*)(a.in[I_NPOST] + j * D) + lane; const f32x4* gt = (const f32x4*)(mod + (size_t)b * NMOD + j * 3 * D + 2 * D) + lane;
#pragma unroll
                for (int q = 0; q < 4; ++q) pA[q] = gp[64 * q] * (gt[64 * q] * rw); }
            if (MODE != 2) { const int jn = (MODE == 0) ? j : j + 1;
                const f32x4* gp = (const f32x4*)(a.in[I_NPRE] + jn * D) + lane; const f32x4* sh = (const f32x4*)(mod + (size_t)b * NMOD + jn * 3 * D) + lane; const f32x4* sc = sh + D / 4;
#pragma unroll
                for (int q = 0; q < 4; ++q) { pB[q] = gp[64 * q] * (sc[64 * q] + 1.0f); pC[q] = sh[64 * q]; } }
        }
        f32x4 x[4][4]; u32x2 yw[4][4];
#pragma unroll
        for (int i = 0; i < 4; ++i) { const int row = (r + i) < r1 ? (r + i) : (r1 - 1);
            if (XF32) { const f32x4* xr = (const f32x4*)xrow_in(a, row) + lane;
#pragma unroll
                for (int q = 0; q < 4; ++q) x[i][q] = xr[64 * q]; }
            else { const u32x2* xr = (const u32x2*)(Xin + (size_t)row * D) + lane;
#pragma unroll
                for (int q = 0; q < 4; ++q) { const u32x2 w = xr[64 * q]; x[i][q] = (f32x4){bf_lo(w.x), bf_hi(w.x), bf_lo(w.y), bf_hi(w.y)}; } }
            if (MODE != 0) { const u32x2* yr = (const u32x2*)(Yin + (size_t)row * D) + lane;
#pragma unroll
                for (int q = 0; q < 4; ++q) yw[i][q] = yr[64 * q]; }
        }
#pragma unroll
        for (int i = 0; i < 4; ++i) { const int row = r + i; const bool live = row < r1;
            if (MODE != 0) {
                f32x4 y[4]; float ss = 0.f;
#pragma unroll
                for (int q = 0; q < 4; ++q) { const u32x2 w = yw[i][q]; y[q] = (f32x4){bf_lo(w.x), bf_hi(w.x), bf_lo(w.y), bf_hi(w.y)};
                    ss += (y[q][0] * y[q][0] + y[q][1] * y[q][1]) + (y[q][2] * y[q][2] + y[q][3] * y[q][3]); }
                const float rstd = rsqrtf(wave_sum(ss) * (1.0f / D) + EPS);
#pragma unroll
                for (int q = 0; q < 4; ++q) x[i][q] = x[i][q] + (y[q] * rstd) * pA[q];
                if (MODE == 2) { f32x4* xo = (f32x4*)(a.out + (size_t)row * D) + lane;
#pragma unroll
                    for (int q = 0; q < 4; ++q) if (live) xo[64 * q] = x[i][q]; }
                else { u32x2* xo = (u32x2*)(Xout + (size_t)row * D) + lane;
#pragma unroll
                    for (int q = 0; q < 4; ++q) { u32x2 w; w.x = cvt_pk_bf16(x[i][q][0], x[i][q][1]); w.y = cvt_pk_bf16(x[i][q][2], x[i][q][3]); if (live) xo[64 * q] = w; } }
            }
            if (MODE != 2) {
                float ss = 0.f;
#pragma unroll
                for (int q = 0; q < 4; ++q) ss += (x[i][q][0] * x[i][q][0] + x[i][q][1] * x[i][q][1]) + (x[i][q][2] * x[i][q][2] + x[i][q][3] * x[i][q][3]);
                const float rstd = rsqrtf(wave_sum(ss) * (1.0f / D) + EPS);
#pragma unroll
                for (int q = 0; q < 4; ++q) { const f32x4 h = (x[i][q] * rstd) * pB[q] + pC[q];
                    u32x2 w; w.x = cvt_pk_bf16(h[0], h[1]); w.y = cvt_pk_bf16(h[2], h[3]); if (live) *(u32x2*)(H + blk_off(row, 4 * lane + 256 * q, D / 64)) = w; }
            }
        }
    }
}

namespace att {
constexpr int KSTR = 144;
constexpr int VSTR = 784;
constexpr int K_OFF = 0, V_OFF = 384 * KSTR, BYTES = V_OFF + 64 * VSTR;
static_assert(BYTES <= 131072, "attention LDS");
}
__device__ __forceinline__ void attn_phase(LAS unsigned char* lds, const bf16_t* Q, const bf16_t* K, const bf16_t* V, bf16_t* O, const float* sink, int G, int bid) {
    using namespace att;
    const int tid = threadIdx.x, lane = tid & 63, wid = tid >> 6, fr = lane & 15, fq = lane >> 4;
    for (int ui = bid; ui < NSEQ * 64 * 2; ui += G) {
        const int unit = NSEQ * 64 * 2 - 1 - ui;
        const int kvh = unit & 1, blk = (unit >> 1) & 63, b = unit >> 7;
        const size_t seq0 = (size_t)b * SEQ;
        const int kp0 = (blk - 1) * 128;
        __syncthreads();
#pragma unroll
        for (int it = 0; it < 6; ++it) {
            const int id = tid + 512 * it, row = id >> 3, ch = id & 7; const int kpos = kp0 + row;
            u32x4 kv = {0u, 0u, 0u, 0u}, vv = {0u, 0u, 0u, 0u};
            if (kpos >= 0 && kpos < SEQ) { const size_t off = (seq0 + kpos) * 128 + kvh * 64 + ch * 8; kv = *(const u32x4*)(K + off); vv = *(const u32x4*)(V + off); }
            *(LAS u32x4*)(lds + K_OFF + row * KSTR + ch * 16) = kv;
            LAS unsigned short* vt = (LAS unsigned short*)(lds + V_OFF + (ch * 8) * VSTR + row * 2);
            vt[0 * (VSTR / 2)] = (unsigned short)(vv.x & 0xffffu); vt[1 * (VSTR / 2)] = (unsigned short)(vv.x >> 16);
            vt[2 * (VSTR / 2)] = (unsigned short)(vv.y & 0xffffu); vt[3 * (VSTR / 2)] = (unsigned short)(vv.y >> 16);
            vt[4 * (VSTR / 2)] = (unsigned short)(vv.z & 0xffffu); vt[5 * (VSTR / 2)] = (unsigned short)(vv.z >> 16);
            vt[6 * (VSTR / 2)] = (unsigned short)(vv.w & 0xffffu); vt[7 * (VSTR / 2)] = (unsigned short)(vv.w >> 16);
        }
        __syncthreads();
        const int qg = __builtin_amdgcn_readfirstlane(wid);
        const int r = qg * 16 + fr;
        const size_t qrow = seq0 + (size_t)blk * 128 + r;
        const bool edge = (blk == 0) || (blk == 63);
#pragma unroll 1
        for (int h4 = 0; h4 < 4; ++h4) {
            const int head = kvh * 4 + h4;
            const bf16x8 qf0 = *(const bf16x8*)(Q + qrow * 512 + head * 64 + fq * 8);
            const bf16x8 qf1 = *(const bf16x8*)(Q + qrow * 512 + head * 64 + 32 + fq * 8);
            f32x4 s[17];
            int lofs = 0; asm volatile("" : "+v"(lofs));
            const LAS unsigned char* kb = lds + K_OFF + (qg * 16 + fr) * KSTR + fq * 16 + lofs;
#pragma unroll
            for (int t = 0; t < 17; ++t) {
                const bf16x8 k0 = *(const LAS bf16x8*)(kb + t * 16 * KSTR), k1 = *(const LAS bf16x8*)(kb + t * 16 * KSTR + 64);
                f32x4 c = {0.f, 0.f, 0.f, 0.f};
                c = __builtin_amdgcn_mfma_f32_16x16x32_bf16(k0, qf0, c, 0, 0, 0);
                c = __builtin_amdgcn_mfma_f32_16x16x32_bf16(k1, qf1, c, 0, 0, 0);
                s[t] = c;
            }
#pragma unroll
            for (int e = 0; e < 4; ++e) { if (fq * 4 + e < fr) s[0][e] = -1e30f; if (fq * 4 + e > fr) s[16][e] = -1e30f; }
            if (edge) {
#pragma unroll
                for (int t = 0; t < 17; ++t) { const int jt = qg + t; if ((blk == 0 && jt < 8) || (blk == 63 && jt >= 16)) s[t] = (f32x4){-1e30f, -1e30f, -1e30f, -1e30f}; }
            }
            const float skl = sink[head] * LOG2E;
            float mx = skl;
#pragma unroll
            for (int t = 0; t < 17; ++t) mx = fmaxf(mx, fmaxf(fmaxf(s[t][0], s[t][1]), fmaxf(s[t][2], s[t][3])));
            mx = fmaxf(mx, __shfl_xor(mx, 16)); mx = fmaxf(mx, __shfl_xor(mx, 32));
            f32x4 lv = {0.f, 0.f, 0.f, 0.f};
#pragma unroll
            for (int t = 0; t < 17; ++t) { const f32x4 d = s[t] - mx; f32x4 p;
                p[0] = __builtin_amdgcn_exp2f(d[0]); p[1] = __builtin_amdgcn_exp2f(d[1]); p[2] = __builtin_amdgcn_exp2f(d[2]); p[3] = __builtin_amdgcn_exp2f(d[3]);
                s[t] = p; lv += p; }
            float l = (lv[0] + lv[1]) + (lv[2] + lv[3]);
            l += __shfl_xor(l, 16); l += __shfl_xor(l, 32);
            l += __builtin_amdgcn_exp2f(skl - mx);
            const float inv = 1.0f / l;
            f32x4 o[4];
#pragma unroll
            for (int dt = 0; dt < 4; ++dt) o[dt] = (f32x4){0.f, 0.f, 0.f, 0.f};
#pragma unroll
            for (int pp = 0; pp < 8; ++pp) {
                u32x4 pw; pw.x = cvt_pk_bf16(s[2 * pp][0], s[2 * pp][1]); pw.y = cvt_pk_bf16(s[2 * pp][2], s[2 * pp][3]);
                pw.z = cvt_pk_bf16(s[2 * pp + 1][0], s[2 * pp + 1][1]); pw.w = cvt_pk_bf16(s[2 * pp + 1][2], s[2 * pp + 1][3]);
                const bf16x8 pf = __builtin_bit_cast(bf16x8, pw);
#pragma unroll
                for (int dt = 0; dt < 4; ++dt) {
                    const LAS unsigned char* vb = lds + V_OFF + (dt * 16 + fr) * VSTR + ((qg + 2 * pp) * 16 + fq * 4) * 2 + lofs;
                    const u32x2 va = *(const LAS u32x2*)vb, vc = *(const LAS u32x2*)(vb + 32);
                    u32x4 vw; vw.x = va.x; vw.y = va.y; vw.z = vc.x; vw.w = vc.y;
                    o[dt] = __builtin_amdgcn_mfma_f32_16x16x32_bf16(__builtin_bit_cast(bf16x8, vw), pf, o[dt], 0, 0, 0);
                }
            }
            {
                u32x2 pw; pw.x = cvt_pk_bf16(s[16][0], s[16][1]); pw.y = cvt_pk_bf16(s[16][2], s[16][3]);
                const s16x4 pf = __builtin_bit_cast(s16x4, pw);
#pragma unroll
                for (int dt = 0; dt < 4; ++dt) {
                    const LAS unsigned char* vb = lds + V_OFF + (dt * 16 + fr) * VSTR + ((qg + 16) * 16 + fq * 4) * 2 + lofs;
                    const u32x2 va = *(const LAS u32x2*)vb;
                    o[dt] = __builtin_amdgcn_mfma_f32_16x16x16bf16_1k(__builtin_bit_cast(s16x4, va), pf, o[dt], 0, 0, 0);
                }
            }
            bf16_t* op = O + blk_off((int)qrow, head * 64 + fq * 4, 16);
#pragma unroll
            for (int dt = 0; dt < 4; ++dt) { u32x2 w; w.x = cvt_pk_bf16(o[dt][0] * inv, o[dt][1] * inv); w.y = cvt_pk_bf16(o[dt][2] * inv, o[dt][3] * inv); *(u32x2*)(op + dt * 16) = w; }
        }
    }
}
__device__ __forceinline__ void pool_phase(LAS unsigned char* lds, const bf16_t* U, bf16_t* P, int G, int bid) {
    constexpr int RS = 1040;
    const int tid = threadIdx.x, c = tid & 63, sub = tid >> 6, g = c >> 4, hw = 1 << g;
    for (int ui = bid; ui < NSEQ * 128; ui += G) {
        const int unit = NSEQ * 128 - 1 - ui;
        const int b = unit >> 7, s0 = (unit & 127) * 64; const size_t seqrow = (size_t)b * SEQ;
        __syncthreads();
#pragma unroll
        for (int it = 0; it < 10; ++it) { const int id = tid + 512 * it, row = id >> 6, ch = id & 63, sp = s0 - 8 + row;
            u32x4 v = {0u, 0u, 0u, 0u}; if (sp >= 0 && sp < SEQ) v = *(const u32x4*)(U + (seqrow + sp) * 512 + ch * 8);
            *(LAS u32x4*)(lds + row * RS + ch * 16) = v; }
        __syncthreads();
        const int rbase = sub * 8 + 8;
        const LAS unsigned char* col = lds + c * 16;
        float S[8];
#pragma unroll
        for (int e = 0; e < 8; ++e) S[e] = 0.f;
#pragma unroll
        for (int k = 0; k < 16; ++k) if (k < 2 * hw) { const u32x4 w = *(const LAS u32x4*)(col + (rbase - hw + k) * RS);
            S[0] += bf_lo(w.x); S[1] += bf_hi(w.x); S[2] += bf_lo(w.y); S[3] += bf_hi(w.y); S[4] += bf_lo(w.z); S[5] += bf_hi(w.z); S[6] += bf_lo(w.w); S[7] += bf_hi(w.w); }
#pragma unroll
        for (int k = 0; k < 8; ++k) { const int sp = s0 + sub * 8 + k; const int lo = (sp - hw) < 0 ? 0 : (sp - hw), hi = (sp + hw) > SEQ ? SEQ : (sp + hw);
            const float ic = 1.0f / (float)(hi - lo);
            const u32x4 w = *(const LAS u32x4*)(col + (rbase + k) * RS);
            u32x4 o; o.x = cvt_pk_bf16(S[0] * ic - bf_lo(w.x), S[1] * ic - bf_hi(w.x)); o.y = cvt_pk_bf16(S[2] * ic - bf_lo(w.y), S[3] * ic - bf_hi(w.y));
            o.z = cvt_pk_bf16(S[4] * ic - bf_lo(w.z), S[5] * ic - bf_hi(w.z)); o.w = cvt_pk_bf16(S[6] * ic - bf_lo(w.w), S[7] * ic - bf_hi(w.w));
            *(u32x4*)(P + blk_off((int)(seqrow + sp), 512 + c * 8, 16)) = o;
            if (k < 7) { const u32x4 wa = *(const LAS u32x4*)(col + (rbase + k + hw) * RS), wd = *(const LAS u32x4*)(col + (rbase + k - hw) * RS);
                S[0] += bf_lo(wa.x) - bf_lo(wd.x); S[1] += bf_hi(wa.x) - bf_hi(wd.x); S[2] += bf_lo(wa.y) - bf_lo(wd.y); S[3] += bf_hi(wa.y) - bf_hi(wd.y);
                S[4] += bf_lo(wa.z) - bf_lo(wd.z); S[5] += bf_hi(wa.z) - bf_hi(wd.z); S[6] += bf_lo(wa.w) - bf_lo(wd.w); S[7] += bf_hi(wa.w) - bf_hi(wd.w); }
        }
    }
}

__global__ void __launch_bounds__(512, 2) mega_fwd(Args a) {
    extern __shared__ __attribute__((aligned(16))) unsigned char lds_raw[];
    LAS unsigned char* lds = (LAS unsigned char*)lds_raw;
    const int G = gridDim.x, bid = blockIdx.x;
    unsigned char* ws = a.ws;
#define IN(k) (a.ph_lo <= (k) && (k) < a.ph_hi)
    volatile LAS unsigned* bst = (volatile LAS unsigned*)(lds + 131072);
    if (threadIdx.x < 4) bst[threadIdx.x] = (threadIdx.x == 3) ? (unsigned)blockIdx.x : 0u;
    __syncthreads();
    XcdBarrier xbar = xcd_barrier_post((unsigned*)(ws + WS_CTL), bst);
    if (a.ph_hi > 1000) cg::this_grid().sync();
#define SEAM(k) do { if (IN(k) && IN((k) + 1)) { xcd_barrier(xbar); } } while (0)
    typedef pg8::StaticOrder SO;
    bf16_t* H = (bf16_t*)(ws + WS_H); bf16_t* Y = (bf16_t*)(ws + WS_Y); bf16_t* ACT = (bf16_t*)(ws + WS_BIG); bf16_t* X1 = (bf16_t*)a.out;

    if (IN(0)) mod_phase(lds, a, G, bid);
    SEAM(0);
    if (IN(0) && IN(1)) {
        if (threadIdx.x == 0) { unsigned* bar = (unsigned*)(ws + WS_CTL); bool ok = (G % 8) == 0;
            for (unsigned jx = 0; jx < 16; ++jx) { const unsigned cx = xb_ld(&bar[XB_XCNT(jx)]); ok = ok && (jx < 8 ? cx == (unsigned)(G / 8) : cx == 0u); }
            if (ok) bst[3] = bst[2] * 8u + xbar.x; }
        __syncthreads();
    }
#define VCU() __builtin_amdgcn_readfirstlane((int)bst[3])
    if (IN(1)) { prep_phase(lds, a, G, bid); norm_phase<0, true>(a, 0, 0.f, G, bid, nullptr, nullptr, nullptr); }
    SEAM(1);
    if (IN(2)) for (int rep = 0; rep < MK_GEMM_REP; ++rep) { pg8::Gemm g{H, (const bf16_t*)(ws + WS_W1GU), T, 2 * FF, D}; SO S; S.init(T, 2 * FF, G, VCU()); pg8::EpiSwiGLU E{ACT, FF};
        pg8::gemm_phase<pg8::EpiSwiGLU, SO, true, true>(lds, g, S, E); }
    SEAM(2);
    if (IN(3)) for (int rep = 0; rep < MK_GEMM_REP; ++rep) { pg8::Gemm g{ACT, (const bf16_t*)(ws + WS_W1D), T, D, FF}; SO S; S.init(T, D, G, VCU(), 1); pg8::EpiBf16 E{Y, D};
        pg8::gemm_phase<pg8::EpiBf16, SO, true, true>(lds, g, S, E); }
    SEAM(3);
    if (IN(4)) norm_phase<1, true>(a, 0, 0.5f, G, bid, nullptr, Y, X1);
    SEAM(4);
    if (IN(5)) for (int rep = 0; rep < MK_GEMM_REP; ++rep) { pg8::Gemm g{H, (const bf16_t*)(ws + WS_WIN), T, NIN, D}; SO S; S.init(T, NIN, G, VCU());
        pg8::EpiProj E{(bf16_t*)(ws + WS_Q), (bf16_t*)(ws + WS_K), (bf16_t*)(ws + WS_V), (bf16_t*)(ws + WS_U), (bf16_t*)(ws + WS_GA), (bf16_t*)(ws + WS_GB), (const float*)(ws + WS_CT), (const float*)(ws + WS_ST)};
        pg8::gemm_phase<pg8::EpiProj, SO, true, true>(lds, g, S, E); }
    SEAM(5);
    if (IN(6)) {
        attn_phase(lds, (const bf16_t*)(ws + WS_Q), (const bf16_t*)(ws + WS_K), (const bf16_t*)(ws + WS_V), Y, a.in[I_SINK], G, bid);
        pool_phase(lds, (const bf16_t*)(ws + WS_U), Y, G, bid);
        __syncthreads();
        if (MK_DUP == 6) {
            attn_phase(lds, (const bf16_t*)(ws + WS_Q), (const bf16_t*)(ws + WS_K), (const bf16_t*)(ws + WS_V), Y, a.in[I_SINK], G, bid);
            pool_phase(lds, (const bf16_t*)(ws + WS_U), Y, G, bid);
            __syncthreads();
        }
    }
    SEAM(6);
    if (IN(7)) for (int rep = 0; rep < MK_GEMM_REP; ++rep) { pg8::Gemm g{Y, (const bf16_t*)(ws + WS_WAB), T, D, D}; SO S; S.init(T, D, G, VCU());
        pg8::EpiMerge E{H, (const bf16_t*)(ws + WS_GA), (const bf16_t*)(ws + WS_GB)};
        pg8::gemm_phase<pg8::EpiMerge, SO, true, true>(lds, g, S, E); }
    SEAM(7);
    if (IN(8)) for (int rep = 0; rep < MK_GEMM_REP; ++rep) { pg8::Gemm g{H, (const bf16_t*)(ws + WS_WOUT), T, D, D}; SO S; S.init(T, D, G, VCU(), 1); pg8::EpiBf16 E{Y, D};
        pg8::gemm_phase<pg8::EpiBf16, SO, true, true>(lds, g, S, E); }
    SEAM(8);
    if (IN(9)) norm_phase<1, false>(a, 1, 1.0f, G, bid, X1, Y, Y);
    SEAM(9);
    if (IN(10)) for (int rep = 0; rep < MK_GEMM_REP; ++rep) { pg8::Gemm g{H, (const bf16_t*)(ws + WS_W2GU), T, 2 * FF, D}; SO S; S.init(T, 2 * FF, G, VCU()); pg8::EpiSwiGLU E{ACT, FF};
        pg8::gemm_phase<pg8::EpiSwiGLU, SO, true, true>(lds, g, S, E); }
    SEAM(10);
    if (IN(11)) for (int rep = 0; rep < MK_GEMM_REP; ++rep) { pg8::Gemm g{ACT, (const bf16_t*)(ws + WS_W2D), T, D, FF}; SO S; S.init(T, D, G, VCU(), 1); pg8::EpiBf16 E{H, D};
        pg8::gemm_phase<pg8::EpiBf16, SO, true, true>(lds, g, S, E); }
    SEAM(11);
    if (IN(12)) norm_phase<2, false>(a, 2, 0.5f, G, bid, Y, H, nullptr);
#undef IN
#undef SEAM
}

__global__ void chk_kernel(const unsigned* p, size_t nwords, unsigned long long* dst) {
    unsigned long long s = 0;
    for (size_t i = (size_t)blockIdx.x * blockDim.x + threadIdx.x; i < nwords; i += (size_t)gridDim.x * blockDim.x) s += p[i];
    atomicAdd(dst, s);
}
__global__ void verdict_kernel(const unsigned long long* chk, float* out, size_t n) {
    int code = 0;
    for (int p = 0; p < 6; ++p) if (chk[p] != chk[16 + p]) code |= 1 << p;
    for (size_t i = (size_t)blockIdx.x * blockDim.x + threadIdx.x; i < n; i += (size_t)gridDim.x * blockDim.x) out[i] = (float)code;
}
constexpr int NPHASE = 13;
extern "C" void kernel_launch(void* const* d_in, const int* in_sizes, int n_in, void* d_out, int out_size, void* d_ws, size_t ws_size, hipStream_t stream) {
    static int grid = 0;
    if (grid == 0) {
        if (n_in != 21 || out_size != T * D || ws_size < WS_END) { fprintf(stderr, "kernel_launch: unexpected shapes: n_in %d out %d ws %zu (need %zu)\n", n_in, out_size, ws_size, (size_t)WS_END); grid = -1; return; }
        int dev = 0, cus = 0, per_cu = 0;
        if (hipGetDevice(&dev) != hipSuccess || hipDeviceGetAttribute(&cus, hipDeviceAttributeMultiprocessorCount, dev) != hipSuccess) { grid = -1; return; }
        if (hipFuncSetAttribute((const void*)mega_fwd, hipFuncAttributeMaxDynamicSharedMemorySize, LDS_BYTES) != hipSuccess) { fprintf(stderr, "kernel_launch: hipFuncSetAttribute failed\n"); grid = -1; return; }
        if (hipOccupancyMaxActiveBlocksPerMultiprocessor(&per_cu, (const void*)mega_fwd, 512, LDS_BYTES) != hipSuccess || per_cu < 1) { fprintf(stderr, "kernel_launch: occupancy query says %d\n", per_cu); per_cu = 1; }
        (void)hipGetLastError();
        grid = cus * 1;
    }
    if (grid < 0) return;
    (void)hipMemsetAsync((unsigned char*)d_ws + WS_CTL, 0, CTL_BYTES, stream);
    Args a{};
    for (int i = 0; i < 21; ++i) a.in[i] = (const float*)d_in[i];
    a.out = (float*)d_out; a.ws = (unsigned char*)d_ws;
#if MK_MULTI_LAUNCH == 2
    {
        unsigned char* ws = (unsigned char*)d_ws; unsigned long long* chk = (unsigned long long*)(ws + 900 * MiB);
        (void)hipMemsetAsync(chk, 0, 4096, stream);
        const size_t offs[7] = {WS_Q, WS_K, WS_V, WS_U, WS_GA, WS_GB, WS_END};
        for (int run = 0; run < 2; ++run) {
            for (int p = 0; p < 6; ++p) { a.ph_lo = p; a.ph_hi = p + 1; hipLaunchKernelGGL(mega_fwd, dim3(grid), dim3(512), LDS_BYTES, stream, a); }
            for (int i = 0; i < 6; ++i) hipLaunchKernelGGL(chk_kernel, dim3(2048), dim3(256), 0, stream, (const unsigned*)(ws + offs[i]), (offs[i + 1] - offs[i]) / 4, chk + run * 16 + i);
        }
        hipLaunchKernelGGL(verdict_kernel, dim3(2048), dim3(256), 0, stream, (const unsigned long long*)chk, (float*)d_out, (size_t)T * D);
    }
#elif MK_MULTI_LAUNCH
    for (int p = 0; p < NPHASE; ++p) { const bool is_gemm = (p == 2 || p == 3 || p == 5 || p == 7 || p == 8 || p == 10 || p == 11);
        const int reps = (MK_MULTI_LAUNCH == 3 && is_gemm) ? 2 : ((MK_MULTI_LAUNCH == 4 && !is_gemm && p != 9 && p != 12) ? 2 : 1);
        for (int rep = 0; rep < reps; ++rep) { a.ph_lo = p; a.ph_hi = p + 1; hipLaunchKernelGGL(mega_fwd, dim3(grid), dim3(512), LDS_BYTES, stream, a); } }
#else
    a.ph_lo = 0; a.ph_hi = NPHASE;
    void* args[] = {&a};
    hipError_t e = hipLaunchCooperativeKernel((const void*)mega_fwd, dim3(grid), dim3(512), args, LDS_BYTES, stream);
    if (e != hipSuccess) fprintf(stderr, "kernel_launch: cooperative launch failed: %s (grid %d)\n", hipGetErrorString(e), grid);
#endif
}
```

```cpp
#include <hip/hip_runtime.h>
#include <hip/hip_cooperative_groups.h>
#include <cstdio>
#include <cstdint>
namespace cg = cooperative_groups;

#ifndef MK_MULTI_LAUNCH
#define MK_MULTI_LAUNCH 0
#endif
#ifndef MK_GEMM_REP
#define MK_GEMM_REP 1
#endif
#ifndef MK_DUP
#define MK_DUP -1
#endif

#define LAS __attribute__((address_space(3)))
typedef unsigned short bf16_t;
typedef short bf16x8 __attribute__((ext_vector_type(8)));
typedef float f32x4 __attribute__((ext_vector_type(4)));
typedef float f32x2 __attribute__((ext_vector_type(2)));
typedef unsigned u32x4 __attribute__((ext_vector_type(4)));
typedef unsigned u32x2 __attribute__((ext_vector_type(2)));
typedef short s16x4 __attribute__((ext_vector_type(4)));

constexpr int D = 1024, SEQ = 8192, NSEQ = 10, NPROMPT = 8, T = NSEQ * SEQ, FF = 2816, NIN = 3328;
constexpr int NMOD = 9 * D;
constexpr float EPS = 1e-6f;
constexpr float LOG2E = 1.4426950408889634f;

constexpr size_t MiB = 1u << 20;
constexpr size_t WS_MOD = 0;
constexpr size_t WS_CTL = 384 * 1024, CTL_BYTES = 16 * 1024;
constexpr size_t WS_CT = 1 * MiB, WS_ST = 2 * MiB;
constexpr size_t WS_W1GU = 3 * MiB;
constexpr size_t WS_W1D = 14 * MiB;
constexpr size_t WS_W2GU = 20 * MiB;
constexpr size_t WS_W2D = 31 * MiB;
constexpr size_t WS_WIN = 37 * MiB;
constexpr size_t WS_WAB = 44 * MiB;
constexpr size_t WS_WPB = 45 * MiB;
constexpr size_t WS_WOUT = 46 * MiB;
constexpr size_t WS_H = 48 * MiB;
constexpr size_t WS_Y = 208 * MiB;
constexpr size_t WS_BIG = 368 * MiB;
constexpr size_t WS_Q = WS_BIG, WS_K = WS_Q + 80 * MiB, WS_V = WS_K + 20 * MiB, WS_U = WS_V + 20 * MiB, WS_GA = WS_U + 80 * MiB, WS_GB = WS_GA + 160 * MiB;
constexpr size_t WS_END = WS_GB + 160 * MiB;
static_assert((size_t)T * D * 2 == 160 * MiB && (size_t)T * FF * 2 == 440 * MiB && (size_t)T * 512 * 2 == 80 * MiB && (size_t)T * 128 * 2 == 20 * MiB, "ws map");

constexpr int LDS_BYTES = 135168;

typedef __bf16 bf16x2v __attribute__((ext_vector_type(2)));
__device__ __forceinline__ unsigned cvt_pk_bf16(float lo, float hi) { const f32x2 v = {lo, hi}; return __builtin_bit_cast(unsigned, __builtin_convertvector(v, bf16x2v)); }
__device__ __forceinline__ float bf_lo(unsigned w) { return __builtin_bit_cast(float, w << 16); }
__device__ __forceinline__ float bf_hi(unsigned w) { return __builtin_bit_cast(float, w & 0xffff0000u); }
__device__ __forceinline__ float fast_sigmoid(float x) { return __builtin_amdgcn_rcpf(1.0f + __builtin_amdgcn_exp2f(-x * LOG2E)); }
__device__ __forceinline__ float fast_silu(float x) { return x * fast_sigmoid(x); }
__device__ __forceinline__ f32x2 sigmoid2(f32x2 x) { const f32x2 t = x * (-LOG2E); f32x2 e; e.x = __builtin_amdgcn_exp2f(t.x); e.y = __builtin_amdgcn_exp2f(t.y);
    const f32x2 d = e + 1.0f; f32x2 r; r.x = __builtin_amdgcn_rcpf(d.x); r.y = __builtin_amdgcn_rcpf(d.y); return r; }
__device__ __forceinline__ unsigned swiglu_pk(float g0, float g1, float u0, float u1) { const f32x2 g = {g0, g1}, u = {u0, u1}; const f32x2 o = (g * u) * sigmoid2(g); return cvt_pk_bf16(o.x, o.y); }
__device__ __forceinline__ unsigned sigmoid_pk(float a, float b) { const f32x2 r = sigmoid2((f32x2){a, b}); return cvt_pk_bf16(r.x, r.y); }
__device__ __forceinline__ float wave_sum(float v) {
#pragma unroll
    for (int o = 1; o < 64; o <<= 1) v += __shfl_xor(v, o);
    return v;
}
#define LDS_WAIT() asm volatile("s_waitcnt lgkmcnt(0)" ::: "memory")
__device__ __forceinline__ size_t blk_off(int row, int col, int KB) { return ((size_t)(row >> 8) * KB + (col >> 6)) * 16384 + (size_t)(((row & 255) << 6) + (col & 63)); }

namespace pg8 {
constexpr int BM = 256, BK = 64, HALF = 128, HTB = HALF * BK * 2, STAGE_BYTES = 8 * HTB, NXCD = 8, WGM = 8;
__host__ __device__ __forceinline__ int lds_byte(int r, int c) { const int st = (r >> 4) * 2 + (c >> 5), rr = r & 15, cc = c & 31, ob = rr * 64 + cc * 2; return st * 1024 + (ob ^ (((ob >> 9) & 1) << 5)); }
__host__ __device__ __forceinline__ void stage_rc(int b, int& R, int& C) { const int st = b / 1024, sb = b % 1024, swz = sb ^ (((sb >> 9) & 1) << 5); R = (st >> 1) * 16 + swz / 64; C = (st & 1) * 32 + (swz % 64) / 2; }
__host__ __device__ __forceinline__ int perm32(int rho) { const int n = rho >> 4, i = rho & 15; return 8 * (i >> 2) + 4 * n + (i & 3); }

struct Unit { int pm, pn; };
struct Gemm { const bf16_t* A; const bf16_t* Bt; int M, N, K; };

struct StaticOrder {
    int nM, nN, nwg, G, c;
    __device__ void init(int M, int N, int G_, int c_) { nM = M / BM; nN = N / BM; nwg = nM * nN; G = G_; c = c_; }
    __device__ bool next(int i, Unit& u) const {
        const long L = (long)i * G + c; if (L >= nwg) return false;
        int wgid = (int)L; { const int q = nwg / NXCD, r = nwg % NXCD, xcd = wgid % NXCD, off = wgid / NXCD; wgid = (xcd < r ? xcd * (q + 1) : r * (q + 1) + (xcd - r) * q) + off; }
        const int nig = WGM * nN, gid = wgid / nig, fm = gid * WGM, gsz = (nM - fm) < WGM ? (nM - fm) : WGM;
        u.pm = fm + ((wgid % nig) % gsz); u.pn = (wgid % nig) / gsz; return true;
    }
    __device__ __forceinline__ void a_ready(const Unit&) const {}
    __device__ __forceinline__ void done(const Unit&) const {}
};

typedef f32x4 Acc[2][2][4][2];

struct EpiBf16 {
    static constexpr bool PERM = true, AFTER_DRAIN = false, HAS_MID = false;
    bf16_t* O; int ldc;
    __device__ __forceinline__ void operator()(const Acc& acc, const Unit& u, int wr, int wc, int fr, int fq) const {
        const int row0 = u.pm * BM + wr * 64 + fr, col0 = u.pn * BM + wc * 32 + 8 * fq;
#pragma unroll
        for (int ai = 0; ai < 2; ++ai)
#pragma unroll
            for (int m = 0; m < 4; ++m) { bf16_t* rowp = O + (size_t)(row0 + ai * HALF + m * 16) * ldc + col0;
#pragma unroll
                for (int bj = 0; bj < 2; ++bj) { const f32x4 v0 = acc[ai][bj][m][0], v1 = acc[ai][bj][m][1];
                    u32x4 w; w.x = cvt_pk_bf16(v0[0], v0[1]); w.y = cvt_pk_bf16(v0[2], v0[3]); w.z = cvt_pk_bf16(v1[0], v1[1]); w.w = cvt_pk_bf16(v1[2], v1[3]);
                    *(u32x4*)(rowp + bj * HALF) = w; } }
    }
};

struct EpiSwiGLU {
    static constexpr bool PERM = true, AFTER_DRAIN = false, HAS_MID = false;
    bf16_t* O; int ldc;
    __device__ __forceinline__ void operator()(const Acc& acc, const Unit& u, int wr, int wc, int fr, int fq) const {
        const int row0 = u.pm * BM + wr * 64 + fr, col0 = u.pn * HALF + wc * 32 + 8 * fq;
#pragma unroll
        for (int ai = 0; ai < 2; ++ai)
#pragma unroll
            for (int m = 0; m < 4; ++m) { bf16_t* rowp = O + blk_off(row0 + ai * HALF + m * 16, col0, ldc / 64);
                const f32x4 g0 = acc[ai][0][m][0], g1 = acc[ai][0][m][1], u0 = acc[ai][1][m][0], u1 = acc[ai][1][m][1];
                u32x4 w;
                w.x = swiglu_pk(g0[0], g0[1], u0[0], u0[1]); w.y = swiglu_pk(g0[2], g0[3], u0[2], u0[3]);
                w.z = swiglu_pk(g1[0], g1[1], u1[0], u1[1]); w.w = swiglu_pk(g1[2], g1[3], u1[2], u1[3]);
                *(u32x4*)rowp = w; }
    }
};

struct EpiProj {
    static constexpr bool PERM = true, AFTER_DRAIN = false, HAS_MID = false;
    bf16_t *Q, *K, *V, *U, *GA, *GB; const float *ct, *st;
    __device__ __forceinline__ void rope_store(const Acc& acc, int row0, bf16_t* base, int ld, int colbase, int fq, float sc) const {
#pragma unroll
        for (int ai = 0; ai < 2; ++ai)
#pragma unroll
            for (int m = 0; m < 4; ++m) { const int row = row0 + ai * HALF + m * 16; const int pos = row & (SEQ - 1);
                const float* cp = ct + pos * 32 + 8 * fq; const float* sp = st + pos * 32 + 8 * fq;
                const f32x4 c0 = *(const f32x4*)cp, c1 = *(const f32x4*)(cp + 4), s0 = *(const f32x4*)sp, s1 = *(const f32x4*)(sp + 4);
                const f32x4 a0 = acc[ai][0][m][0] * sc, a1 = acc[ai][0][m][1] * sc, b0 = acc[ai][1][m][0] * sc, b1 = acc[ai][1][m][1] * sc;
                const f32x4 lo0 = a0 * c0 - b0 * s0, lo1 = a1 * c1 - b1 * s1, hi0 = b0 * c0 + a0 * s0, hi1 = b1 * c1 + a1 * s1;
                bf16_t* p = base + (size_t)row * ld + colbase + 8 * fq;
                u32x4 w; w.x = cvt_pk_bf16(lo0[0], lo0[1]); w.y = cvt_pk_bf16(lo0[2], lo0[3]); w.z = cvt_pk_bf16(lo1[0], lo1[1]); w.w = cvt_pk_bf16(lo1[2], lo1[3]);
                *(u32x4*)p = w;
                w.x = cvt_pk_bf16(hi0[0], hi0[1]); w.y = cvt_pk_bf16(hi0[2], hi0[3]); w.z = cvt_pk_bf16(hi1[0], hi1[1]); w.w = cvt_pk_bf16(hi1[2], hi1[3]);
                *(u32x4*)(p + 32) = w;
                if (m & 1) asm volatile("" ::: "memory"); }
    }
    template <int ACT> __device__ __forceinline__ void plain_store(const Acc& acc, int row0, bf16_t* base, int ld, int col0) const {
#pragma unroll
        for (int ai = 0; ai < 2; ++ai)
#pragma unroll
            for (int m = 0; m < 4; ++m) { bf16_t* rowp = base + (size_t)(row0 + ai * HALF + m * 16) * ld + col0;
#pragma unroll
                for (int bj = 0; bj < 2; ++bj) { const f32x4 v0 = acc[ai][bj][m][0], v1 = acc[ai][bj][m][1];
                    u32x4 w;
                    if (ACT == 1) { w.x = sigmoid_pk(v0[0], v0[1]); w.y = sigmoid_pk(v0[2], v0[3]); w.z = sigmoid_pk(v1[0], v1[1]); w.w = sigmoid_pk(v1[2], v1[3]); }
                    else { w.x = cvt_pk_bf16(v0[0], v0[1]); w.y = cvt_pk_bf16(v0[2], v0[3]); w.z = cvt_pk_bf16(v1[0], v1[1]); w.w = cvt_pk_bf16(v1[2], v1[3]); }
                    *(u32x4*)(rowp + bj * HALF) = w; }
                asm volatile("" ::: "memory"); }
    }
    __device__ __forceinline__ void operator()(const Acc& acc, const Unit& u, int wr, int wc, int fr, int fq) const {
        int row0 = u.pm * BM + wr * 64 + fr; const int pn = u.pn;
#define OPAQUE_ROW() asm volatile("" : "+v"(row0))
        if (pn < 2) { OPAQUE_ROW(); rope_store(acc, row0, Q, 512, (4 * pn + wc) * 64, fq, 0.125f * LOG2E); }
        else if (pn == 2) {
            if (wc < 2) { OPAQUE_ROW(); rope_store(acc, row0, K, 128, wc * 64, fq, 1.0f); }
            else { OPAQUE_ROW();
#pragma unroll
                for (int ai = 0; ai < 2; ++ai)
#pragma unroll
                    for (int m = 0; m < 4; ++m) { bf16_t* rowp = V + (size_t)(row0 + ai * HALF + m * 16) * 128 + (wc - 2) * 32 + 8 * fq;
#pragma unroll
                        for (int bj = 0; bj < 2; ++bj) { const f32x4 v0 = acc[ai][bj][m][0], v1 = acc[ai][bj][m][1];
                            u32x4 w; w.x = cvt_pk_bf16(v0[0], v0[1]); w.y = cvt_pk_bf16(v0[2], v0[3]); w.z = cvt_pk_bf16(v1[0], v1[1]); w.w = cvt_pk_bf16(v1[2], v1[3]);
                            *(u32x4*)(rowp + bj * 64) = w; } }
            }
        }
        else if (pn < 5) { OPAQUE_ROW(); plain_store<0>(acc, row0, U, 512, (pn - 3) * BM + wc * 32 + 8 * fq); }
        else { OPAQUE_ROW(); bf16_t* gbase = pn < 9 ? GA : GB; const int gt = pn < 9 ? pn - 5 : pn - 9; plain_store<1>(acc, row0, gbase, D, gt * BM + wc * 32 + 8 * fq); }
#undef OPAQUE_ROW
    }
};

struct EpiMerge {
    static constexpr bool PERM = true, AFTER_DRAIN = false, HAS_MID = true;
    bf16_t* O; const bf16_t* Ga; const bf16_t* Gb;
    __device__ __forceinline__ void mid(Acc& acc, const Unit& u, int wr, int wc, int fr, int fq) const {
        int row0 = u.pm * BM + wr * 64 + fr, col0 = u.pn * BM + wc * 32 + 8 * fq; asm volatile("" : "+v"(row0), "+v"(col0));
#pragma unroll
        for (int ai = 0; ai < 2; ++ai)
#pragma unroll
            for (int m = 0; m < 4; ++m) { const size_t offg = (size_t)(row0 + ai * HALF + m * 16) * D + col0;
#pragma unroll
                for (int bj = 0; bj < 2; ++bj) {
                    const u32x4 a = *(const u32x4*)(Ga + offg + bj * HALF), b = *(const u32x4*)(Gb + offg + bj * HALF);
                    const float r0 = bf_lo(a.x) * __builtin_amdgcn_rcpf(fmaxf(bf_lo(b.x), 1e-30f)), r1 = bf_hi(a.x) * __builtin_amdgcn_rcpf(fmaxf(bf_hi(b.x), 1e-30f));
                    const float r2 = bf_lo(a.y) * __builtin_amdgcn_rcpf(fmaxf(bf_lo(b.y), 1e-30f)), r3 = bf_hi(a.y) * __builtin_amdgcn_rcpf(fmaxf(bf_hi(b.y), 1e-30f));
                    acc[ai][bj][m][0] = acc[ai][bj][m][0] * (f32x4){r0, r1, r2, r3};
                    const float r4 = bf_lo(a.z) * __builtin_amdgcn_rcpf(fmaxf(bf_lo(b.z), 1e-30f)), r5 = bf_hi(a.z) * __builtin_amdgcn_rcpf(fmaxf(bf_hi(b.z), 1e-30f));
                    const float r6 = bf_lo(a.w) * __builtin_amdgcn_rcpf(fmaxf(bf_lo(b.w), 1e-30f)), r7 = bf_hi(a.w) * __builtin_amdgcn_rcpf(fmaxf(bf_hi(b.w), 1e-30f));
                    acc[ai][bj][m][1] = acc[ai][bj][m][1] * (f32x4){r4, r5, r6, r7}; }
                if (m & 1) asm volatile("" ::: "memory"); }
    }
    __device__ __forceinline__ void operator()(const Acc& acc, const Unit& u, int wr, int wc, int fr, int fq) const {
        int row0 = u.pm * BM + wr * 64 + fr, col0 = u.pn * BM + wc * 32 + 8 * fq; asm volatile("" : "+v"(row0), "+v"(col0));
#pragma unroll
        for (int ai = 0; ai < 2; ++ai)
#pragma unroll
            for (int m = 0; m < 4; ++m) { const size_t offg = (size_t)(row0 + ai * HALF + m * 16) * D + col0;
#pragma unroll
                for (int bj = 0; bj < 2; ++bj) { const f32x4 v0 = acc[ai][bj][m][0], v1 = acc[ai][bj][m][1];
                    const u32x4 g = *(const u32x4*)(Gb + offg + bj * HALF);
                    const float q0 = fmaxf(bf_lo(g.x), 1e-30f), q1 = fmaxf(bf_hi(g.x), 1e-30f), q2 = fmaxf(bf_lo(g.y), 1e-30f), q3 = fmaxf(bf_hi(g.y), 1e-30f);
                    const float q4 = fmaxf(bf_lo(g.z), 1e-30f), q5 = fmaxf(bf_hi(g.z), 1e-30f), q6 = fmaxf(bf_lo(g.w), 1e-30f), q7 = fmaxf(bf_hi(g.w), 1e-30f);
                    u32x4 w; w.x = cvt_pk_bf16(v0[0] * q0, v0[1] * q1); w.y = cvt_pk_bf16(v0[2] * q2, v0[3] * q3); w.z = cvt_pk_bf16(v1[0] * q4, v1[1] * q5); w.w = cvt_pk_bf16(v1[2] * q6, v1[3] * q7);
                    *(u32x4*)(O + blk_off(row0 + ai * HALF + m * 16, col0 + bj * HALF, D / 64)) = w; }
                if (m & 1) asm volatile("" ::: "memory"); }
    }
};

template <class Epi, class Sched, bool ALIGN_EPI = false, bool SP2 = false>
__device__ __forceinline__ void gemm_phase(LAS unsigned char* lds, const Gemm g, const Sched& S, const Epi& E) {
    const int tid = threadIdx.x, wid = __builtin_amdgcn_readfirstlane(tid >> 6), lane = tid & 63, wr = wid >> 2, wc = wid & 3, fr = lane & 15, fq = lane >> 4;
    const int K = g.K, nt = K / BK;
    unsigned voffA[2], voffB[2];
#pragma unroll
    for (int i = 0; i < 2; ++i) { int R, C; stage_rc(tid * 16 + i * 8192, R, C); const int Rb = Epi::PERM ? ((R & ~31) + perm32(R & 31)) : R;
        voffA[i] = (unsigned)(R * 64 + C) * 2u; voffB[i] = (unsigned)(Rb * 64 + C) * 2u; }
    const size_t kstep = (size_t)BM * BK * 2;
    const size_t hstep = (size_t)HALF * BK * 2;
    const size_t tstep = (size_t)nt * kstep;
    const unsigned ldsw = (unsigned)wid * 1024u;
    const int aoff = lds_byte(wr * 64 + fr, fq * 8), boff = lds_byte(wc * 32 + fr, fq * 8);
#define PG8_SA(b, h) (((b) * 2 + (h)) * HTB)
#define PG8_SB(b, h) ((4 + (b) * 2 + (h)) * HTB)
#define PG8_STAGE(bufoff, gbase, voff) do { _Pragma("unroll") for (int _i = 0; _i < 2; ++_i) \
        __builtin_amdgcn_global_load_lds((const unsigned*)((const char*)(gbase) + (voff)[_i]), (LAS unsigned*)(lds + (bufoff) + ldsw + _i * 8192), 16, 0, 0); } while (0)
#define PG8_LDA(dst, b, h) do { _Pragma("unroll") for (int m = 0; m < 4; ++m) _Pragma("unroll") for (int k = 0; k < 2; ++k) dst[m][k] = *(const LAS bf16x8*)(lds + PG8_SA(b, h) + aoff + m * 2048 + k * 1024); } while (0)
#define PG8_LDB(dst, b, h) do { _Pragma("unroll") for (int n = 0; n < 2; ++n) _Pragma("unroll") for (int k = 0; k < 2; ++k) dst[n][k] = *(const LAS bf16x8*)(lds + PG8_SB(b, h) + boff + n * 2048 + k * 1024); } while (0)
#define PG8_MMA(ai, bj, At, Bt) do { __builtin_amdgcn_s_setprio(1); _Pragma("unroll") for (int m = 0; m < 4; ++m) _Pragma("unroll") for (int n = 0; n < 2; ++n) _Pragma("unroll") for (int k = 0; k < 2; ++k) \
        acc[ai][bj][m][n] = __builtin_amdgcn_mfma_f32_16x16x32_bf16(Bt[n][k], At[m][k], acc[ai][bj][m][n], 0, 0, 0); __builtin_amdgcn_s_setprio(0); } while (0)
#define PG8_WAIT_V(n) asm volatile("s_waitcnt vmcnt(" #n ")" ::: "memory")
#define PG8_WAIT_V8_UNLESS(f) asm volatile("s_cmp_lg_u32 %0, 0\n\ts_cbranch_scc1 .Lpg8skip%=\n\ts_waitcnt vmcnt(8)\n.Lpg8skip%=:" :: "s"(f) : "scc", "memory")
#define PG8_WAIT_L(n) asm volatile("s_waitcnt lgkmcnt(" #n ")" ::: "memory")
#define PG8_BAR __builtin_amdgcn_s_barrier()
#define PG8_SCHED __builtin_amdgcn_sched_barrier(0)
    Unit cur, nxt; int ui = 0;
    if (!S.next(0, cur)) return;
    f32x4 acc[2][2][4][2];
#pragma unroll
    for (int a = 0; a < 2; ++a)
#pragma unroll
        for (int b = 0; b < 2; ++b)
#pragma unroll
            for (int m = 0; m < 4; ++m)
#pragma unroll
                for (int n = 0; n < 2; ++n) acc[a][b][m][n] = (f32x4){0.f, 0.f, 0.f, 0.f};
    bf16x8 At[4][2], B0[2][2], B1[2][2];
    const char* cA = (const char*)g.A + (size_t)cur.pm * tstep; const char* cB = (const char*)g.Bt + (size_t)cur.pn * tstep;
    S.a_ready(cur);
    if constexpr (SP2) {
        PG8_STAGE(PG8_SB(0, 0), cB, voffB); PG8_STAGE(PG8_SB(0, 1), cB + hstep, voffB); PG8_STAGE(PG8_SA(0, 0), cA, voffA); PG8_STAGE(PG8_SA(0, 1), cA + hstep, voffA);
        if (wr == 1) PG8_BAR;
        PG8_WAIT_V(2); PG8_BAR;
        PG8_STAGE(PG8_SB(1, 0), cB + kstep, voffB); PG8_STAGE(PG8_SA(1, 0), cA + kstep, voffA); PG8_STAGE(PG8_SB(1, 1), cB + hstep + kstep, voffB);
        PG8_WAIT_V(6); PG8_BAR;
    } else {
        PG8_STAGE(PG8_SB(0, 0), cB, voffB); PG8_STAGE(PG8_SA(0, 0), cA, voffA); PG8_STAGE(PG8_SB(0, 1), cB + hstep, voffB); PG8_STAGE(PG8_SA(0, 1), cA + hstep, voffA);
        if (wr == 1) PG8_BAR;
        PG8_WAIT_V(4); PG8_BAR;
        PG8_STAGE(PG8_SB(1, 0), cB + kstep, voffB); PG8_STAGE(PG8_SA(1, 0), cA + kstep, voffA); PG8_STAGE(PG8_SB(1, 1), cB + hstep + kstep, voffB);
        PG8_WAIT_V(6); PG8_BAR;
    }
    for (;;) {
        const bool has_next = S.next(ui + 1, nxt);
        const char* nA = has_next ? (const char*)g.A + (size_t)nxt.pm * tstep : cA; const char* nB = has_next ? (const char*)g.Bt + (size_t)nxt.pn * tstep : cB;
        for (int t = 0; t < nt; t += 2) {
            const bool last = (t == nt - 2);
            const char* a1 = cA + (size_t)(t + 1) * kstep;
            const char* a2 = last ? nA : cA + (size_t)(t + 2) * kstep; const char* b2 = last ? nB : cB + (size_t)(t + 2) * kstep;
            const char* a3 = a2 + kstep; const char* b3 = b2 + kstep;
            if (last && has_next) S.a_ready(nxt);
            if constexpr (SP2) {
            if constexpr (Epi::HAS_MID) { if (t == nt / 2) E.mid(acc, cur, wr, wc, fr, fq); }
            const int fresh = __builtin_amdgcn_readfirstlane(((t == 0) && (ui > 0)) ? 1 : 0);
            PG8_LDB(B0, 0, 0); PG8_LDB(B1, 0, 1); PG8_SCHED; PG8_LDA(At, 0, 0); PG8_STAGE(PG8_SA(1, 1), a1 + hstep, voffA);
            PG8_WAIT_V8_UNLESS(fresh); PG8_WAIT_L(0); PG8_BAR; PG8_MMA(0, 0, At, B0); PG8_MMA(0, 1, At, B1); PG8_BAR; PG8_SCHED;
            PG8_LDA(At, 0, 1); PG8_STAGE(PG8_SB(0, 0), b2, voffB); PG8_STAGE(PG8_SB(0, 1), b2 + hstep, voffB); PG8_STAGE(PG8_SA(0, 0), a2, voffA);
            PG8_WAIT_V8_UNLESS(fresh); PG8_WAIT_L(0); PG8_BAR; PG8_MMA(1, 0, At, B0); PG8_MMA(1, 1, At, B1); PG8_BAR; PG8_SCHED;
            PG8_LDB(B0, 1, 0); PG8_LDB(B1, 1, 1); PG8_SCHED; PG8_LDA(At, 1, 0); PG8_STAGE(PG8_SA(0, 1), a2 + hstep, voffA);
            PG8_WAIT_V(8); PG8_WAIT_L(0); PG8_BAR; PG8_MMA(0, 0, At, B0); PG8_MMA(0, 1, At, B1); PG8_BAR; PG8_SCHED;
            PG8_LDA(At, 1, 1); PG8_STAGE(PG8_SB(1, 0), b3, voffB); PG8_STAGE(PG8_SB(1, 1), b3 + hstep, voffB); PG8_STAGE(PG8_SA(1, 0), a3, voffA);
            PG8_WAIT_V(8); PG8_WAIT_L(0); PG8_BAR; PG8_MMA(1, 0, At, B0); PG8_MMA(1, 1, At, B1); PG8_BAR; PG8_SCHED;
            } else {
            PG8_LDB(B0, 0, 0); PG8_SCHED; PG8_LDA(At, 0, 0); PG8_STAGE(PG8_SA(1, 1), a1 + hstep, voffA);
            PG8_WAIT_L(8); PG8_BAR; PG8_WAIT_L(0); PG8_MMA(0, 0, At, B0); PG8_BAR; PG8_SCHED;
            PG8_LDB(B1, 0, 1); PG8_STAGE(PG8_SB(0, 0), b2, voffB);
            PG8_BAR; PG8_WAIT_L(0); PG8_MMA(0, 1, At, B1); PG8_BAR;
            PG8_LDA(At, 0, 1); PG8_STAGE(PG8_SA(0, 0), a2, voffA);
            PG8_BAR; PG8_WAIT_L(0); PG8_MMA(1, 0, At, B0); PG8_BAR; PG8_SCHED;
            PG8_STAGE(PG8_SB(0, 1), b2 + hstep, voffB);
            PG8_WAIT_V(6); PG8_BAR; PG8_MMA(1, 1, At, B1); PG8_BAR;
            PG8_LDB(B0, 1, 0); PG8_SCHED; PG8_LDA(At, 1, 0); PG8_STAGE(PG8_SA(0, 1), a2 + hstep, voffA);
            PG8_WAIT_L(8); PG8_BAR; PG8_WAIT_L(0); PG8_MMA(0, 0, At, B0); PG8_BAR; PG8_SCHED;
            PG8_LDB(B1, 1, 1); PG8_STAGE(PG8_SB(1, 0), b3, voffB);
            PG8_BAR; PG8_WAIT_L(0); PG8_MMA(0, 1, At, B1); PG8_BAR;
            PG8_LDA(At, 1, 1); PG8_STAGE(PG8_SA(1, 0), a3, voffA);
            PG8_BAR; PG8_WAIT_L(0); PG8_MMA(1, 0, At, B0); PG8_BAR; PG8_SCHED;
            PG8_STAGE(PG8_SB(1, 1), b3 + hstep, voffB);
            PG8_WAIT_V(6); PG8_BAR; PG8_MMA(1, 1, At, B1); PG8_BAR;
            }
        }
        if constexpr (ALIGN_EPI) { if (wr == 0) PG8_BAR; }
        if constexpr (SP2) PG8_WAIT_V(0);
        if constexpr (!Epi::AFTER_DRAIN) { E(acc, cur, wr, wc, fr, fq); S.done(cur); }
        if (!has_next) break;
#pragma unroll
        for (int a = 0; a < 2; ++a)
#pragma unroll
            for (int b = 0; b < 2; ++b)
#pragma unroll
                for (int m = 0; m < 4; ++m)
#pragma unroll
                    for (int n = 0; n < 2; ++n) acc[a][b][m][n] = (f32x4){0.f, 0.f, 0.f, 0.f};
        cur = nxt; cA = nA; cB = nB; ++ui;
        if constexpr (ALIGN_EPI) { if (wr == 1) PG8_BAR; }
    }
    PG8_WAIT_V(0);
    if constexpr (!ALIGN_EPI) { if (wr == 0) PG8_BAR; }
    PG8_BAR;
#undef PG8_SA
#undef PG8_SB
#undef PG8_STAGE
#undef PG8_LDA
#undef PG8_LDB
#undef PG8_MMA
#undef PG8_WAIT_V
#undef PG8_WAIT_V8_UNLESS
#undef PG8_WAIT_L
#undef PG8_BAR
#undef PG8_SCHED
}
}

#define XB_TMO      128
#define XB_XCNT(j)  (256  + 64 * (j))
#define XB_XSUB(j)  (1280 + 64 * (j))
#define XB_XGEN(j)  (2304 + 64 * (j))
#define XB_TOP      3328
#define XB_TOPGEN   3392
#define XCD_BAR_WORDS 3456
#define XB_SPIN_CAP (1u << 22)
__device__ __forceinline__ unsigned xb_ld(unsigned* p)              { return __hip_atomic_load(p, __ATOMIC_RELAXED, __HIP_MEMORY_SCOPE_AGENT); }
__device__ __forceinline__ unsigned xb_add(unsigned* p, unsigned v) { return __hip_atomic_fetch_add(p, v, __ATOMIC_RELAXED, __HIP_MEMORY_SCOPE_AGENT); }
__device__ __forceinline__ unsigned xb_xcc_id() { return (unsigned)__builtin_amdgcn_s_getreg((3 << 11) | 20) & 0xFu; }
#define XB_SPIN(cond, bar) do { unsigned _sp = 0; while (cond) { __builtin_amdgcn_s_sleep(1); \
    if ((++_sp & 255u) == 0u) { if (xb_ld(&(bar)[XB_TMO])) break; if (_sp > XB_SPIN_CAP) { atomicAdd(&(bar)[XB_TMO], 1u); break; } } } } while (0)
struct XcdBarrier { unsigned* bar; unsigned x; volatile LAS unsigned* st; };
__device__ __forceinline__ XcdBarrier xcd_barrier_post(unsigned* bar, volatile LAS unsigned* st) {
    XcdBarrier b; b.bar = bar; b.x = xb_xcc_id(); b.st = st;
    if (threadIdx.x == 0) st[2] = xb_add(&bar[XB_XCNT(b.x)], 1u);
    return b;
}
__device__ __forceinline__ void xcd_barrier_complete(unsigned* bar, unsigned x, unsigned& nloc, unsigned& nx) {
    const unsigned G = gridDim.x * gridDim.y * gridDim.z;
    unsigned sum, cnt, mine, sp = 0u;
    for (;;) {
        sum = 0u; cnt = 0u; mine = 0u;
#pragma unroll
        for (unsigned j = 0; j < 16; ++j) { const unsigned c = xb_ld(&bar[XB_XCNT(j)]); sum += c; cnt += (c > 0u) ? 1u : 0u; mine = (j == x) ? c : mine; }
        if (sum == G) break;
        __builtin_amdgcn_s_sleep(1);
        if ((++sp & 255u) == 0u) { if (xb_ld(&bar[XB_TMO])) break; if (sp > XB_SPIN_CAP) { atomicAdd(&bar[XB_TMO], 1u); break; } }
    }
    nloc = mine > 0u ? mine : 1u; nx = cnt > 0u ? cnt : 1u;
}
__device__ __forceinline__ void xcd_barrier(const XcdBarrier& b) {
    asm volatile("s_waitcnt vmcnt(0)" ::: "memory");
    __syncthreads();
    if (threadIdx.x == 0) {
        unsigned* bar = b.bar;
        __builtin_amdgcn_s_waitcnt(0);
        unsigned nloc = b.st[0], nx = b.st[1];
        if (nloc == 0u) { xcd_barrier_complete(bar, b.x, nloc, nx); b.st[0] = nloc; b.st[1] = nx; }
        const unsigned old = xb_add(&bar[XB_XSUB(b.x)], 1u);
        const unsigned gen = old / nloc;
        if (old + 1u == (gen + 1u) * nloc) {
            __builtin_amdgcn_fence(__ATOMIC_RELEASE, "agent");
            asm volatile("s_waitcnt vmcnt(0)" ::: "memory");
            const unsigned og = xb_add(&bar[XB_TOP], 1u);
            const unsigned tg = og / nx;
            if (og + 1u == (tg + 1u) * nx) xb_add(&bar[XB_TOPGEN], 1u);
            else XB_SPIN(xb_ld(&bar[XB_TOPGEN]) == tg, bar);
            __builtin_amdgcn_fence(__ATOMIC_ACQUIRE, "agent");
            xb_add(&bar[XB_XGEN(b.x)], 1u);
            asm volatile("s_waitcnt vmcnt(0)" ::: "memory");
        } else {
            XB_SPIN(xb_ld(&bar[XB_XGEN(b.x)]) == gen, bar);
            __builtin_amdgcn_fence(__ATOMIC_ACQUIRE, "agent");
            asm volatile("s_waitcnt vmcnt(0)" ::: "memory");
        }
    }
    __syncthreads();
}

struct Args { const float* in[21]; float* out; unsigned char* ws; int ph_lo, ph_hi; };
enum { I_XP = 0, I_XS, I_CP, I_CS, I_ADAW, I_ADAB, I_NPRE, I_NPOST, I_F1G, I_F1U, I_F1D, I_WIN, I_SINK, I_WAB, I_POOLW, I_POOLS, I_WPB, I_WOUT, I_F2G, I_F2U, I_F2D };

__device__ __forceinline__ int map_row(int mode, int n0) {
    if (mode == 0) return n0;
    if (mode == 1) return 256 * (n0 >> 7) + (n0 & 127);
    if (mode == 2) return 256 * (n0 >> 7) + 128 + (n0 & 127);
    if (n0 < 512) { const int head = n0 >> 6, half = (n0 >> 5) & 1; return 256 * (head >> 2) + 128 * half + (head & 3) * 32; }
    if (n0 < 640) { const int kh = (n0 - 512) >> 6, half = (n0 >> 5) & 1; return 512 + 128 * half + kh * 32; }
    if (n0 < 768) { const int vv = n0 - 640; return 512 + 128 * (vv >> 6) + 64 + (vv & 63); }
    return n0;
}
__device__ __forceinline__ void transpose_item(const float* W, int K, int N, bf16_t* WT, int KB, int mode, LAS float* scr, int item, int lane) {
    const int nblk = N / 32, kb = item / nblk, nb = item % nblk, k0 = 64 * kb, n0 = 32 * nb;
#pragma unroll 8
    for (int i = 0; i < 32; ++i) { const int kk = 2 * i + (lane >> 5); scr[kk * 33 + (lane & 31)] = __builtin_nontemporal_load(W + (size_t)(k0 + kk) * N + n0 + (lane & 31)); }
    LDS_WAIT();
    const int rb = map_row(mode, n0);
    const int c = lane & 7;
#pragma unroll
    for (int j = 0; j < 4; ++j) { const int n = (lane >> 3) + 8 * j; const LAS float* s = scr + (8 * c) * 33 + n;
        u32x4 o; o.x = cvt_pk_bf16(s[0 * 33], s[1 * 33]); o.y = cvt_pk_bf16(s[2 * 33], s[3 * 33]); o.z = cvt_pk_bf16(s[4 * 33], s[5 * 33]); o.w = cvt_pk_bf16(s[6 * 33], s[7 * 33]);
        *(u32x4*)(WT + blk_off(rb + n, k0 + 8 * c, KB)) = o; }
    LDS_WAIT();
}

__device__ __forceinline__ void mod_phase(LAS unsigned char* lds, const Args& a, int G, int bid) {
    const int tid = threadIdx.x, lane = tid & 63, wid = tid >> 6;
    LAS float* sc = (LAS float*)lds;
    LAS float* part = (LAS float*)(lds + 40960);
    for (int i = tid; i < NSEQ * D; i += 512) { const int b = i >> 10, k = i & 1023; const float c = (b < NPROMPT) ? a.in[I_CP][b * D + k] : a.in[I_CS][(b - NPROMPT) * D + k]; sc[i] = c / (1.0f + expf(-c)); }
    __syncthreads();
    float* mod = (float*)(a.ws + WS_MOD);
    for (int it = bid; it < NMOD / 36; it += G) {
        const int j0 = it * 36; const int ln = lane < 36 ? lane : 35;
        float acc[NSEQ];
#pragma unroll
        for (int b = 0; b < NSEQ; ++b) acc[b] = 0.f;
        const float* w = a.in[I_ADAW] + (size_t)(wid * 128) * NMOD + j0 + ln;
#pragma unroll 16
        for (int k = 0; k < 128; ++k) { const float wv = w[(size_t)k * NMOD];
#pragma unroll
            for (int b = 0; b < NSEQ; ++b) acc[b] += sc[b * D + wid * 128 + k] * wv; }
#pragma unroll
        for (int b = 0; b < NSEQ; ++b) part[(wid * NSEQ + b) * 64 + lane] = acc[b];
        __syncthreads();
        for (int i = tid; i < NSEQ * 36; i += 512) { const int b = i / 36, l = i - b * 36; float s = a.in[I_ADAB][j0 + l];
#pragma unroll
            for (int w8 = 0; w8 < 8; ++w8) s += part[(w8 * NSEQ + b) * 64 + l];
            mod[b * NMOD + j0 + l] = s; }
        __syncthreads();
    }
}

__device__ __forceinline__ void prep_phase(LAS unsigned char* lds, const Args& a, int G, int bid) {
    const int tid = threadIdx.x, lane = tid & 63, wid = tid >> 6;
    unsigned char* ws = a.ws;
    LAS float* scr = (LAS float*)(lds + wid * 16384);
    const int gw = bid * 8 + wid, NGW = G * 8;
    constexpr int I_GU = (D / 64) * (FF / 32), I_DN = (FF / 64) * (D / 32), I_IN = (D / 64) * (NIN / 32), I_AB = (512 / 64) * (D / 32), I_OUT = (D / 64) * (D / 32);
    constexpr int NITEMS = 4 * I_GU + 2 * I_DN + I_IN + I_AB + I_OUT;
    for (int it = gw; it < NITEMS; it += NGW) {
        int r = it;
        if (r < I_GU) { transpose_item(a.in[I_F1G], D, FF, (bf16_t*)(ws + WS_W1GU), D / 64, 1, scr, r, lane); continue; } r -= I_GU;
        if (r < I_GU) { transpose_item(a.in[I_F1U], D, FF, (bf16_t*)(ws + WS_W1GU), D / 64, 2, scr, r, lane); continue; } r -= I_GU;
        if (r < I_GU) { transpose_item(a.in[I_F2G], D, FF, (bf16_t*)(ws + WS_W2GU), D / 64, 1, scr, r, lane); continue; } r -= I_GU;
        if (r < I_GU) { transpose_item(a.in[I_F2U], D, FF, (bf16_t*)(ws + WS_W2GU), D / 64, 2, scr, r, lane); continue; } r -= I_GU;
        if (r < I_DN) { transpose_item(a.in[I_F1D], FF, D, (bf16_t*)(ws + WS_W1D), FF / 64, 0, scr, r, lane); continue; } r -= I_DN;
        if (r < I_DN) { transpose_item(a.in[I_F2D], FF, D, (bf16_t*)(ws + WS_W2D), FF / 64, 0, scr, r, lane); continue; } r -= I_DN;
        if (r < I_IN) { transpose_item(a.in[I_WIN], D, NIN, (bf16_t*)(ws + WS_WIN), D / 64, 3, scr, r, lane); continue; } r -= I_IN;
        if (r < I_AB) { transpose_item(a.in[I_WAB], 512, D, (bf16_t*)(ws + WS_WAB), D / 64, 0, scr, r, lane); continue; } r -= I_AB;
        transpose_item(a.in[I_WOUT], D, D, (bf16_t*)(ws + WS_WOUT), D / 64, 0, scr, r, lane);
    }
    {
        const float* pw = a.in[I_POOLW]; const float* ps = a.in[I_POOLS]; const float* wpb = a.in[I_WPB]; bf16_t* o = (bf16_t*)(ws + WS_WAB);
        for (int it = gw; it < 2048; it += NGW) {
            const int nq = it & 3, c = (it >> 2) & 127, g = it >> 9;
            scr[lane] = pw[(g * 128 + c) * 128 + lane] * ps[g * 128 + lane];
            scr[lane + 64] = pw[(g * 128 + c) * 128 + lane + 64] * ps[g * 128 + lane + 64];
            LDS_WAIT();
            for (int nc = 0; nc < 4; ++nc) { const int n = nq * 256 + nc * 64 + lane; float s = 0.f; const float* wp = wpb + (size_t)(g * 128) * D + n;
#pragma unroll 8
                for (int d = 0; d < 128; ++d) s += scr[d] * wp[(size_t)d * D];
                o[blk_off(n, 512 + g * 128 + c, 16)] = (bf16_t)(cvt_pk_bf16(s, 0.f) & 0xffffu); }
            LDS_WAIT();
        }
    }
    {
        float* ct = (float*)(ws + WS_CT); float* st = (float*)(ws + WS_ST);
        for (int i = bid * 512 + tid; i < SEQ * 32; i += G * 512) { const int pos = i >> 5, f = i & 31;
            const float inv = exp2f(-(float)f * (13.287712379549449f / 32.0f));
            const float ang = (float)pos * inv;
            const double ad = (double)ang; const double kk = rint(ad * 0.15915494309189535);
            double r = fma(-kk, 6.283185307179586, ad); r = fma(-kk, 2.4492935982947064e-16, r);
            const float rf = (float)r;
            ct[i] = cosf(rf); st[i] = sinf(rf); }
    }
}

__device__ __forceinline__ const float* xrow_in(const Args& a, int row) { return row < NPROMPT * SEQ ? a.in[I_XP] + (size_t)row * D : a.in[I_XS] + (size_t)(row - NPROMPT * SEQ) * D; }

template <int MODE, bool XF32> __device__ __forceinline__ void norm_phase(const Args& a, int j, float rw, int G, int bid, const bf16_t* Xin, const bf16_t* Yin, bf16_t* Xout) {
    const int tid = threadIdx.x, lane = tid & 63, wid = tid >> 6;
    const int gw = bid * 8 + wid, NGW = G * 8;
    const float* mod = (const float*)(a.ws + WS_MOD);
    bf16_t* H = (bf16_t*)(a.ws + WS_H);
    const int rpw = (((T + NGW - 1) / NGW) + 3) & ~3;
    const int r0 = gw * rpw, r1 = (r0 + rpw) < T ? (r0 + rpw) : T;
    int cur_b = -1;
    f32x4 pA[4], pB[4], pC[4];
#pragma unroll
    for (int q = 0; q < 4; ++q) { pA[q] = (f32x4){0.f, 0.f, 0.f, 0.f}; pB[q] = pA[q]; pC[q] = pA[q]; }
    for (int r = r0; r < r1; r += 4) {
        const int b = r >> 13;
        if (b != cur_b) { cur_b = b;
            if (MODE != 0) { const f32x4* gp = (const f32x4*)(a.in[I_NPOST] + j * D) + lane; const f32x4* gt = (const f32x4*)(mod + (size_t)b * NMOD + j * 3 * D + 2 * D) + lane;
#pragma unroll
                for (int q = 0; q < 4; ++q) pA[q] = gp[64 * q] * (gt[64 * q] * rw); }
            if (MODE != 2) { const int jn = (MODE == 0) ? j : j + 1;
                const f32x4* gp = (const f32x4*)(a.in[I_NPRE] + jn * D) + lane; const f32x4* sh = (const f32x4*)(mod + (size_t)b * NMOD + jn * 3 * D) + lane; const f32x4* sc = sh + D / 4;
#pragma unroll
                for (int q = 0; q < 4; ++q) { pB[q] = gp[64 * q] * (sc[64 * q] + 1.0f); pC[q] = sh[64 * q]; } }
        }
        f32x4 x[4][4]; u32x2 yw[4][4];
#pragma unroll
        for (int i = 0; i < 4; ++i) { const int row = (r + i) < r1 ? (r + i) : (r1 - 1);
            if (XF32) { const f32x4* xr = (const f32x4*)xrow_in(a, row) + lane;
#pragma unroll
                for (int q = 0; q < 4; ++q) x[i][q] = __builtin_nontemporal_load(xr + 64 * q); }
            else { const u32x2* xr = (const u32x2*)(Xin + (size_t)row * D) + lane;
#pragma unroll
                for (int q = 0; q < 4; ++q) { const u32x2 w = xr[64 * q]; x[i][q] = (f32x4){bf_lo(w.x), bf_hi(w.x), bf_lo(w.y), bf_hi(w.y)}; } }
            if (MODE != 0) { const u32x2* yr = (const u32x2*)(Yin + (size_t)row * D) + lane;
#pragma unroll
                for (int q = 0; q < 4; ++q) yw[i][q] = yr[64 * q]; }
        }
#pragma unroll
        for (int i = 0; i < 4; ++i) { const int row = r + i; const bool live = row < r1;
            if (MODE != 0) {
                f32x4 y[4]; float ss = 0.f;
#pragma unroll
                for (int q = 0; q < 4; ++q) { const u32x2 w = yw[i][q]; y[q] = (f32x4){bf_lo(w.x), bf_hi(w.x), bf_lo(w.y), bf_hi(w.y)};
                    ss += (y[q][0] * y[q][0] + y[q][1] * y[q][1]) + (y[q][2] * y[q][2] + y[q][3] * y[q][3]); }
                const float rstd = rsqrtf(wave_sum(ss) * (1.0f / D) + EPS);
#pragma unroll
                for (int q = 0; q < 4; ++q) x[i][q] = x[i][q] + (y[q] * rstd) * pA[q];
                if (MODE == 2) { f32x4* xo = (f32x4*)(a.out + (size_t)row * D) + lane;
#pragma unroll
                    for (int q = 0; q < 4; ++q) if (live) __builtin_nontemporal_store(x[i][q], xo + 64 * q); }
                else { u32x2* xo = (u32x2*)(Xout + (size_t)row * D) + lane;
#pragma unroll
                    for (int q = 0; q < 4; ++q) { u32x2 w; w.x = cvt_pk_bf16(x[i][q][0], x[i][q][1]); w.y = cvt_pk_bf16(x[i][q][2], x[i][q][3]); if (live) xo[64 * q] = w; } }
            }
            if (MODE != 2) {
                float ss = 0.f;
#pragma unroll
                for (int q = 0; q < 4; ++q) ss += (x[i][q][0] * x[i][q][0] + x[i][q][1] * x[i][q][1]) + (x[i][q][2] * x[i][q][2] + x[i][q][3] * x[i][q][3]);
                const float rstd = rsqrtf(wave_sum(ss) * (1.0f / D) + EPS);
#pragma unroll
                for (int q = 0; q < 4; ++q) { const f32x4 h = (x[i][q] * rstd) * pB[q] + pC[q];
                    u32x2 w; w.x = cvt_pk_bf16(h[0], h[1]); w.y = cvt_pk_bf16(h[2], h[3]); if (live) *(u32x2*)(H + blk_off(row, 4 * lane + 256 * q, D / 64)) = w; }
            }
        }
    }
}

namespace att {
constexpr int KSTR = 144;
constexpr int VSTR = 784;
constexpr int K_OFF = 0, V_OFF = 384 * KSTR, BYTES = V_OFF + 64 * VSTR;
static_assert(BYTES <= 131072, "attention LDS");
}
__device__ __forceinline__ void attn_phase(LAS unsigned char* lds, const bf16_t* Q, const bf16_t* K, const bf16_t* V, bf16_t* O, const float* sink, int G, int bid) {
    using namespace att;
    const int tid = threadIdx.x, lane = tid & 63, wid = tid >> 6, fr = lane & 15, fq = lane >> 4;
    for (int unit = bid; unit < NSEQ * 64 * 2; unit += G) {
        const int kvh = unit & 1, blk = (unit >> 1) & 63, b = unit >> 7;
        const size_t seq0 = (size_t)b * SEQ;
        const int kp0 = (blk - 1) * 128;
        __syncthreads();
#pragma unroll
        for (int it = 0; it < 6; ++it) {
            const int id = tid + 512 * it, row = id >> 3, ch = id & 7; const int kpos = kp0 + row;
            u32x4 kv = {0u, 0u, 0u, 0u}, vv = {0u, 0u, 0u, 0u};
            if (kpos >= 0 && kpos < SEQ) { const size_t off = (seq0 + kpos) * 128 + kvh * 64 + ch * 8; kv = *(const u32x4*)(K + off); vv = *(const u32x4*)(V + off); }
            *(LAS u32x4*)(lds + K_OFF + row * KSTR + ch * 16) = kv;
            LAS unsigned short* vt = (LAS unsigned short*)(lds + V_OFF + (ch * 8) * VSTR + row * 2);
            vt[0 * (VSTR / 2)] = (unsigned short)(vv.x & 0xffffu); vt[1 * (VSTR / 2)] = (unsigned short)(vv.x >> 16);
            vt[2 * (VSTR / 2)] = (unsigned short)(vv.y & 0xffffu); vt[3 * (VSTR / 2)] = (unsigned short)(vv.y >> 16);
            vt[4 * (VSTR / 2)] = (unsigned short)(vv.z & 0xffffu); vt[5 * (VSTR / 2)] = (unsigned short)(vv.z >> 16);
            vt[6 * (VSTR / 2)] = (unsigned short)(vv.w & 0xffffu); vt[7 * (VSTR / 2)] = (unsigned short)(vv.w >> 16);
        }
        __syncthreads();
        const int qg = __builtin_amdgcn_readfirstlane(wid);
        const int r = qg * 16 + fr;
        const size_t qrow = seq0 + (size_t)blk * 128 + r;
        const bool edge = (blk == 0) || (blk == 63);
#pragma unroll 1
        for (int h4 = 0; h4 < 4; ++h4) {
            const int head = kvh * 4 + h4;
            const bf16x8 qf0 = *(const bf16x8*)(Q + qrow * 512 + head * 64 + fq * 8);
            const bf16x8 qf1 = *(const bf16x8*)(Q + qrow * 512 + head * 64 + 32 + fq * 8);
            f32x4 s[17];
            int lofs = 0; asm volatile("" : "+v"(lofs));
            const LAS unsigned char* kb = lds + K_OFF + (qg * 16 + fr) * KSTR + fq * 16 + lofs;
#pragma unroll
            for (int t = 0; t < 17; ++t) {
                const bf16x8 k0 = *(const LAS bf16x8*)(kb + t * 16 * KSTR), k1 = *(const LAS bf16x8*)(kb + t * 16 * KSTR + 64);
                f32x4 c = {0.f, 0.f, 0.f, 0.f};
                c = __builtin_amdgcn_mfma_f32_16x16x32_bf16(k0, qf0, c, 0, 0, 0);
                c = __builtin_amdgcn_mfma_f32_16x16x32_bf16(k1, qf1, c, 0, 0, 0);
                s[t] = c;
            }
#pragma unroll
            for (int e = 0; e < 4; ++e) { if (fq * 4 + e < fr) s[0][e] = -1e30f; if (fq * 4 + e > fr) s[16][e] = -1e30f; }
            if (edge) {
#pragma unroll
                for (int t = 0; t < 17; ++t) { const int jt = qg + t; if ((blk == 0 && jt < 8) || (blk == 63 && jt >= 16)) s[t] = (f32x4){-1e30f, -1e30f, -1e30f, -1e30f}; }
            }
            const float skl = sink[head] * LOG2E;
            float mx = skl;
#pragma unroll
            for (int t = 0; t < 17; ++t) mx = fmaxf(mx, fmaxf(fmaxf(s[t][0], s[t][1]), fmaxf(s[t][2], s[t][3])));
            mx = fmaxf(mx, __shfl_xor(mx, 16)); mx = fmaxf(mx, __shfl_xor(mx, 32));
            f32x4 lv = {0.f, 0.f, 0.f, 0.f};
#pragma unroll
            for (int t = 0; t < 17; ++t) { const f32x4 d = s[t] - mx; f32x4 p;
                p[0] = __builtin_amdgcn_exp2f(d[0]); p[1] = __builtin_amdgcn_exp2f(d[1]); p[2] = __builtin_amdgcn_exp2f(d[2]); p[3] = __builtin_amdgcn_exp2f(d[3]);
                s[t] = p; lv += p; }
            float l = (lv[0] + lv[1]) + (lv[2] + lv[3]);
            l += __shfl_xor(l, 16); l += __shfl_xor(l, 32);
            l += __builtin_amdgcn_exp2f(skl - mx);
            const float inv = 1.0f / l;
            f32x4 o[4];
#pragma unroll
            for (int dt = 0; dt < 4; ++dt) o[dt] = (f32x4){0.f, 0.f, 0.f, 0.f};
#pragma unroll
            for (int pp = 0; pp < 8; ++pp) {
                u32x4 pw; pw.x = cvt_pk_bf16(s[2 * pp][0], s[2 * pp][1]); pw.y = cvt_pk_bf16(s[2 * pp][2], s[2 * pp][3]);
                pw.z = cvt_pk_bf16(s[2 * pp + 1][0], s[2 * pp + 1][1]); pw.w = cvt_pk_bf16(s[2 * pp + 1][2], s[2 * pp + 1][3]);
                const bf16x8 pf = __builtin_bit_cast(bf16x8, pw);
#pragma unroll
                for (int dt = 0; dt < 4; ++dt) {
                    const LAS unsigned char* vb = lds + V_OFF + (dt * 16 + fr) * VSTR + ((qg + 2 * pp) * 16 + fq * 4) * 2 + lofs;
                    const u32x2 va = *(const LAS u32x2*)vb, vc = *(const LAS u32x2*)(vb + 32);
                    u32x4 vw; vw.x = va.x; vw.y = va.y; vw.z = vc.x; vw.w = vc.y;
                    o[dt] = __builtin_amdgcn_mfma_f32_16x16x32_bf16(__builtin_bit_cast(bf16x8, vw), pf, o[dt], 0, 0, 0);
                }
            }
            {
                u32x2 pw; pw.x = cvt_pk_bf16(s[16][0], s[16][1]); pw.y = cvt_pk_bf16(s[16][2], s[16][3]);
                const s16x4 pf = __builtin_bit_cast(s16x4, pw);
#pragma unroll
                for (int dt = 0; dt < 4; ++dt) {
                    const LAS unsigned char* vb = lds + V_OFF + (dt * 16 + fr) * VSTR + ((qg + 16) * 16 + fq * 4) * 2 + lofs;
                    const u32x2 va = *(const LAS u32x2*)vb;
                    o[dt] = __builtin_amdgcn_mfma_f32_16x16x16bf16_1k(__builtin_bit_cast(s16x4, va), pf, o[dt], 0, 0, 0);
                }
            }
            bf16_t* op = O + blk_off((int)qrow, head * 64 + fq * 4, 16);
#pragma unroll
            for (int dt = 0; dt < 4; ++dt) { u32x2 w; w.x = cvt_pk_bf16(o[dt][0] * inv, o[dt][1] * inv); w.y = cvt_pk_bf16(o[dt][2] * inv, o[dt][3] * inv); *(u32x2*)(op + dt * 16) = w; }
        }
    }
}
__device__ __forceinline__ void pool_phase(LAS unsigned char* lds, const bf16_t* U, bf16_t* P, int G, int bid) {
    constexpr int RS = 1040;
    const int tid = threadIdx.x, c = tid & 63, sub = tid >> 6, g = c >> 4, hw = 1 << g;
    for (int unit = bid; unit < NSEQ * 128; unit += G) {
        const int b = unit >> 7, s0 = (unit & 127) * 64; const size_t seqrow = (size_t)b * SEQ;
        __syncthreads();
#pragma unroll
        for (int it = 0; it < 10; ++it) { const int id = tid + 512 * it, row = id >> 6, ch = id & 63, sp = s0 - 8 + row;
            u32x4 v = {0u, 0u, 0u, 0u}; if (sp >= 0 && sp < SEQ) v = *(const u32x4*)(U + (seqrow + sp) * 512 + ch * 8);
            *(LAS u32x4*)(lds + row * RS + ch * 16) = v; }
        __syncthreads();
        const int rbase = sub * 8 + 8;
        const LAS unsigned char* col = lds + c * 16;
        float S[8];
#pragma unroll
        for (int e = 0; e < 8; ++e) S[e] = 0.f;
#pragma unroll
        for (int k = 0; k < 16; ++k) if (k < 2 * hw) { const u32x4 w = *(const LAS u32x4*)(col + (rbase - hw + k) * RS);
            S[0] += bf_lo(w.x); S[1] += bf_hi(w.x); S[2] += bf_lo(w.y); S[3] += bf_hi(w.y); S[4] += bf_lo(w.z); S[5] += bf_hi(w.z); S[6] += bf_lo(w.w); S[7] += bf_hi(w.w); }
#pragma unroll
        for (int k = 0; k < 8; ++k) { const int sp = s0 + sub * 8 + k; const int lo = (sp - hw) < 0 ? 0 : (sp - hw), hi = (sp + hw) > SEQ ? SEQ : (sp + hw);
            const float ic = 1.0f / (float)(hi - lo);
            const u32x4 w = *(const LAS u32x4*)(col + (rbase + k) * RS);
            u32x4 o; o.x = cvt_pk_bf16(S[0] * ic - bf_lo(w.x), S[1] * ic - bf_hi(w.x)); o.y = cvt_pk_bf16(S[2] * ic - bf_lo(w.y), S[3] * ic - bf_hi(w.y));
            o.z = cvt_pk_bf16(S[4] * ic - bf_lo(w.z), S[5] * ic - bf_hi(w.z)); o.w = cvt_pk_bf16(S[6] * ic - bf_lo(w.w), S[7] * ic - bf_hi(w.w));
            *(u32x4*)(P + blk_off((int)(seqrow + sp), 512 + c * 8, 16)) = o;
            if (k < 7) { const u32x4 wa = *(const LAS u32x4*)(col + (rbase + k + hw) * RS), wd = *(const LAS u32x4*)(col + (rbase + k - hw) * RS);
                S[0] += bf_lo(wa.x) - bf_lo(wd.x); S[1] += bf_hi(wa.x) - bf_hi(wd.x); S[2] += bf_lo(wa.y) - bf_lo(wd.y); S[3] += bf_hi(wa.y) - bf_hi(wd.y);
                S[4] += bf_lo(wa.z) - bf_lo(wd.z); S[5] += bf_hi(wa.z) - bf_hi(wd.z); S[6] += bf_lo(wa.w) - bf_lo(wd.w); S[7] += bf_hi(wa.w) - bf_hi(wd.w); }
        }
    }
}

__global__ void __launch_bounds__(512, 2) mega_fwd(Args a) {
    extern __shared__ __attribute__((aligned(16))) unsigned char lds_raw[];
    LAS unsigned char* lds = (LAS unsigned char*)lds_raw;
    const int G = gridDim.x, bid = blockIdx.x;
    unsigned char* ws = a.ws;
#define IN(k) (a.ph_lo <= (k) && (k) < a.ph_hi)
    volatile LAS unsigned* bst = (volatile LAS unsigned*)(lds + 131072);
    if (threadIdx.x < 4) bst[threadIdx.x] = (threadIdx.x == 3) ? (unsigned)blockIdx.x : 0u;
    __syncthreads();
    XcdBarrier xbar = xcd_barrier_post((unsigned*)(ws + WS_CTL), bst);
    if (a.ph_hi > 1000) cg::this_grid().sync();
#define SEAM(k) do { if (IN(k) && IN((k) + 1)) { xcd_barrier(xbar); } } while (0)
    typedef pg8::StaticOrder SO;
    bf16_t* H = (bf16_t*)(ws + WS_H); bf16_t* Y = (bf16_t*)(ws + WS_Y); bf16_t* ACT = (bf16_t*)(ws + WS_BIG); bf16_t* X1 = (bf16_t*)a.out;

    if (IN(0)) mod_phase(lds, a, G, bid);
    SEAM(0);
    if (IN(0) && IN(1)) {
        if (threadIdx.x == 0) { unsigned* bar = (unsigned*)(ws + WS_CTL); bool ok = (G % 8) == 0;
            for (unsigned jx = 0; jx < 16; ++jx) { const unsigned cx = xb_ld(&bar[XB_XCNT(jx)]); ok = ok && (jx < 8 ? cx == (unsigned)(G / 8) : cx == 0u); }
            if (ok) bst[3] = bst[2] * 8u + xbar.x; }
        __syncthreads();
    }
#define VCU() __builtin_amdgcn_readfirstlane((int)bst[3])
    if (IN(1)) { prep_phase(lds, a, G, bid); norm_phase<0, true>(a, 0, 0.f, G, bid, nullptr, nullptr, nullptr); }
    SEAM(1);
    if (IN(2)) for (int rep = 0; rep < MK_GEMM_REP; ++rep) { pg8::Gemm g{H, (const bf16_t*)(ws + WS_W1GU), T, 2 * FF, D}; SO S; S.init(T, 2 * FF, G, VCU()); pg8::EpiSwiGLU E{ACT, FF};
        pg8::gemm_phase<pg8::EpiSwiGLU, SO, true, true>(lds, g, S, E); }
    SEAM(2);
    if (IN(3)) for (int rep = 0; rep < MK_GEMM_REP; ++rep) { pg8::Gemm g{ACT, (const bf16_t*)(ws + WS_W1D), T, D, FF}; SO S; S.init(T, D, G, VCU()); pg8::EpiBf16 E{Y, D};
        pg8::gemm_phase<pg8::EpiBf16, SO, true, true>(lds, g, S, E); }
    SEAM(3);
    if (IN(4)) norm_phase<1, true>(a, 0, 0.5f, G, bid, nullptr, Y, X1);
    SEAM(4);
    if (IN(5)) for (int rep = 0; rep < MK_GEMM_REP; ++rep) { pg8::Gemm g{H, (const bf16_t*)(ws + WS_WIN), T, NIN, D}; SO S; S.init(T, NIN, G, VCU());
        pg8::EpiProj E{(bf16_t*)(ws + WS_Q), (bf16_t*)(ws + WS_K), (bf16_t*)(ws + WS_V), (bf16_t*)(ws + WS_U), (bf16_t*)(ws + WS_GA), (bf16_t*)(ws + WS_GB), (const float*)(ws + WS_CT), (const float*)(ws + WS_ST)};
        pg8::gemm_phase<pg8::EpiProj, SO, true, true>(lds, g, S, E); }
    SEAM(5);
    if (IN(6)) {
        attn_phase(lds, (const bf16_t*)(ws + WS_Q), (const bf16_t*)(ws + WS_K), (const bf16_t*)(ws + WS_V), Y, a.in[I_SINK], G, bid);
        pool_phase(lds, (const bf16_t*)(ws + WS_U), Y, G, bid);
        __syncthreads();
        if (MK_DUP == 6) {
            attn_phase(lds, (const bf16_t*)(ws + WS_Q), (const bf16_t*)(ws + WS_K), (const bf16_t*)(ws + WS_V), Y, a.in[I_SINK], G, bid);
            pool_phase(lds, (const bf16_t*)(ws + WS_U), Y, G, bid);
            __syncthreads();
        }
    }
    SEAM(6);
    if (IN(7)) for (int rep = 0; rep < MK_GEMM_REP; ++rep) { pg8::Gemm g{Y, (const bf16_t*)(ws + WS_WAB), T, D, D}; SO S; S.init(T, D, G, VCU());
        pg8::EpiMerge E{H, (const bf16_t*)(ws + WS_GA), (const bf16_t*)(ws + WS_GB)};
        pg8::gemm_phase<pg8::EpiMerge, SO, true, true>(lds, g, S, E); }
    SEAM(7);
    if (IN(8)) for (int rep = 0; rep < MK_GEMM_REP; ++rep) { pg8::Gemm g{H, (const bf16_t*)(ws + WS_WOUT), T, D, D}; SO S; S.init(T, D, G, VCU()); pg8::EpiBf16 E{Y, D};
        pg8::gemm_phase<pg8::EpiBf16, SO, true, true>(lds, g, S, E); }
    SEAM(8);
    if (IN(9)) norm_phase<1, false>(a, 1, 1.0f, G, bid, X1, Y, Y);
    SEAM(9);
    if (IN(10)) for (int rep = 0; rep < MK_GEMM_REP; ++rep) { pg8::Gemm g{H, (const bf16_t*)(ws + WS_W2GU), T, 2 * FF, D}; SO S; S.init(T, 2 * FF, G, VCU()); pg8::EpiSwiGLU E{ACT, FF};
        pg8::gemm_phase<pg8::EpiSwiGLU, SO, true, true>(lds, g, S, E); }
    SEAM(10);
    if (IN(11)) for (int rep = 0; rep < MK_GEMM_REP; ++rep) { pg8::Gemm g{ACT, (const bf16_t*)(ws + WS_W2D), T, D, FF}; SO S; S.init(T, D, G, VCU()); pg8::EpiBf16 E{H, D};
        pg8::gemm_phase<pg8::EpiBf16, SO, true, true>(lds, g, S, E); }
    SEAM(11);
    if (IN(12)) norm_phase<2, false>(a, 2, 0.5f, G, bid, Y, H, nullptr);
#undef IN
#undef SEAM
}

__global__ void chk_kernel(const unsigned* p, size_t nwords, unsigned long long* dst) {
    unsigned long long s = 0;
    for (size_t i = (size_t)blockIdx.x * blockDim.x + threadIdx.x; i < nwords; i += (size_t)gridDim.x * blockDim.x) s += p[i];
    atomicAdd(dst, s);
}
__global__ void verdict_kernel(const unsigned long long* chk, float* out, size_t n) {
    int code = 0;
    for (int p = 0; p < 6; ++p) if (chk[p] != chk[16 + p]) code |= 1 << p;
    for (size_t i = (size_t)blockIdx.x * blockDim.x + threadIdx.x; i < n; i += (size_t)gridDim.x * blockDim.x) out[i] = (float)code;
}
constexpr int NPHASE = 13;
extern "C" void kernel_launch(void* const* d_in, const int* in_sizes, int n_in, void* d_out, int out_size, void* d_ws, size_t ws_size, hipStream_t stream) {
    static int grid = 0;
    if (grid == 0) {
        if (n_in != 21 || out_size != T * D || ws_size < WS_END) { fprintf(stderr, "kernel_launch: unexpected shapes: n_in %d out %d ws %zu (need %zu)\n", n_in, out_size, ws_size, (size_t)WS_END); grid = -1; return; }
        int dev = 0, cus = 0, per_cu = 0;
        if (hipGetDevice(&dev) != hipSuccess || hipDeviceGetAttribute(&cus, hipDeviceAttributeMultiprocessorCount, dev) != hipSuccess) { grid = -1; return; }
        if (hipFuncSetAttribute((const void*)mega_fwd, hipFuncAttributeMaxDynamicSharedMemorySize, LDS_BYTES) != hipSuccess) { fprintf(stderr, "kernel_launch: hipFuncSetAttribute failed\n"); grid = -1; return; }
        if (hipOccupancyMaxActiveBlocksPerMultiprocessor(&per_cu, (const void*)mega_fwd, 512, LDS_BYTES) != hipSuccess || per_cu < 1) { fprintf(stderr, "kernel_launch: occupancy query says %d\n", per_cu); per_cu = 1; }
        (void)hipGetLastError();
        grid = cus * 1;
    }
    if (grid < 0) return;
    (void)hipMemsetAsync((unsigned char*)d_ws + WS_CTL, 0, CTL_BYTES, stream);
    Args a{};
    for (int i = 0; i < 21; ++i) a.in[i] = (const float*)d_in[i];
    a.out = (float*)d_out; a.ws = (unsigned char*)d_ws;
#if MK_MULTI_LAUNCH == 2
    {
        unsigned char* ws = (unsigned char*)d_ws; unsigned long long* chk = (unsigned long long*)(ws + 900 * MiB);
        (void)hipMemsetAsync(chk, 0, 4096, stream);
        const size_t offs[7] = {WS_Q, WS_K, WS_V, WS_U, WS_GA, WS_GB, WS_END};
        for (int run = 0; run < 2; ++run) {
            for (int p = 0; p < 6; ++p) { a.ph_lo = p; a.ph_hi = p + 1; hipLaunchKernelGGL(mega_fwd, dim3(grid), dim3(512), LDS_BYTES, stream, a); }
            for (int i = 0; i < 6; ++i) hipLaunchKernelGGL(chk_kernel, dim3(2048), dim3(256), 0, stream, (const unsigned*)(ws + offs[i]), (offs[i + 1] - offs[i]) / 4, chk + run * 16 + i);
        }
        hipLaunchKernelGGL(verdict_kernel, dim3(2048), dim3(256), 0, stream, (const unsigned long long*)chk, (float*)d_out, (size_t)T * D);
    }
#elif MK_MULTI_LAUNCH
    for (int p = 0; p < NPHASE; ++p) { const bool is_gemm = (p == 2 || p == 3 || p == 5 || p == 7 || p == 8 || p == 10 || p == 11);
        const int reps = (MK_MULTI_LAUNCH == 3 && is_gemm) ? 2 : ((MK_MULTI_LAUNCH == 4 && !is_gemm && p != 9 && p != 12) ? 2 : 1);
        for (int rep = 0; rep < reps; ++rep) { a.ph_lo = p; a.ph_hi = p + 1; hipLaunchKernelGGL(mega_fwd, dim3(grid), dim3(512), LDS_BYTES, stream, a); } }
#else
    a.ph_lo = 0; a.ph_hi = NPHASE;
    void* args[] = {&a};
    hipError_t e = hipLaunchCooperativeKernel((const void*)mega_fwd, dim3(grid), dim3(512), args, LDS_BYTES, stream);
    if (e != hipSuccess) fprintf(stderr, "kernel_launch: cooperative launch failed: %s (grid %d)\n", hipGetErrorString(e), grid);
#endif
}
```

```cpp
#include <hip/hip_runtime.h>
#include <hip/hip_cooperative_groups.h>
#include <cstdio>
#include <cstdint>
namespace cg = cooperative_groups;

#ifndef MK_MULTI_LAUNCH
#define MK_MULTI_LAUNCH 0
#endif
#ifndef MK_GEMM_REP
#define MK_GEMM_REP 1
#endif
#ifndef MK_DUP
#define MK_DUP -1
#endif

#define LAS __attribute__((address_space(3)))
typedef unsigned short bf16_t;
typedef short bf16x8 __attribute__((ext_vector_type(8)));
typedef float f32x4 __attribute__((ext_vector_type(4)));
typedef float f32x2 __attribute__((ext_vector_type(2)));
typedef unsigned u32x4 __attribute__((ext_vector_type(4)));
typedef unsigned u32x2 __attribute__((ext_vector_type(2)));
typedef short s16x4 __attribute__((ext_vector_type(4)));

constexpr int D = 1024, SEQ = 8192, NSEQ = 10, NPROMPT = 8, T = NSEQ * SEQ, FF = 2816, NIN = 3328;
constexpr int NMOD = 9 * D;
constexpr float EPS = 1e-6f;
constexpr float LOG2E = 1.4426950408889634f;

constexpr size_t MiB = 1u << 20;
constexpr size_t WS_MOD = 0;
constexpr size_t WS_CTL = 384 * 1024, CTL_BYTES = 16 * 1024;
constexpr size_t WS_CT = 1 * MiB, WS_ST = 2 * MiB;
constexpr size_t WS_W1GU = 3 * MiB;
constexpr size_t WS_W1D = 14 * MiB;
constexpr size_t WS_W2GU = 20 * MiB;
constexpr size_t WS_W2D = 31 * MiB;
constexpr size_t WS_WIN = 37 * MiB;
constexpr size_t WS_WAB = 44 * MiB;
constexpr size_t WS_WPB = 45 * MiB;
constexpr size_t WS_WOUT = 46 * MiB;
constexpr size_t WS_H = 48 * MiB;
constexpr size_t WS_Y = 208 * MiB;
constexpr size_t WS_BIG = 368 * MiB;
constexpr size_t WS_Q = WS_BIG, WS_K = WS_Q + 80 * MiB, WS_V = WS_K + 20 * MiB, WS_U = WS_V + 20 * MiB, WS_GA = WS_U + 80 * MiB, WS_GB = WS_GA + 160 * MiB;
constexpr size_t WS_END = WS_GB + 160 * MiB;
static_assert((size_t)T * D * 2 == 160 * MiB && (size_t)T * FF * 2 == 440 * MiB && (size_t)T * 512 * 2 == 80 * MiB && (size_t)T * 128 * 2 == 20 * MiB, "ws map");

constexpr int LDS_BYTES = 135168;

typedef __bf16 bf16x2v __attribute__((ext_vector_type(2)));
__device__ __forceinline__ unsigned cvt_pk_bf16(float lo, float hi) { const f32x2 v = {lo, hi}; return __builtin_bit_cast(unsigned, __builtin_convertvector(v, bf16x2v)); }
__device__ __forceinline__ float bf_lo(unsigned w) { return __builtin_bit_cast(float, w << 16); }
__device__ __forceinline__ float bf_hi(unsigned w) { return __builtin_bit_cast(float, w & 0xffff0000u); }
__device__ __forceinline__ float fast_sigmoid(float x) { return __builtin_amdgcn_rcpf(1.0f + __builtin_amdgcn_exp2f(-x * LOG2E)); }
__device__ __forceinline__ float fast_silu(float x) { return x * fast_sigmoid(x); }
__device__ __forceinline__ f32x2 sigmoid2(f32x2 x) { const f32x2 t = x * (-LOG2E); f32x2 e; e.x = __builtin_amdgcn_exp2f(t.x); e.y = __builtin_amdgcn_exp2f(t.y);
    const f32x2 d = e + 1.0f; f32x2 r; r.x = __builtin_amdgcn_rcpf(d.x); r.y = __builtin_amdgcn_rcpf(d.y); return r; }
__device__ __forceinline__ unsigned swiglu_pk(float g0, float g1, float u0, float u1) { const f32x2 g = {g0, g1}, u = {u0, u1}; const f32x2 o = (g * u) * sigmoid2(g); return cvt_pk_bf16(o.x, o.y); }
__device__ __forceinline__ unsigned sigmoid_pk(float a, float b) { const f32x2 r = sigmoid2((f32x2){a, b}); return cvt_pk_bf16(r.x, r.y); }
__device__ __forceinline__ float wave_sum(float v) {
#pragma unroll
    for (int o = 1; o < 64; o <<= 1) v += __shfl_xor(v, o);
    return v;
}
#define LDS_WAIT() asm volatile("s_waitcnt lgkmcnt(0)" ::: "memory")
__device__ __forceinline__ size_t blk_off(int row, int col, int KB) { return ((size_t)(row >> 8) * KB + (col >> 6)) * 16384 + (size_t)(((row & 255) << 6) + (col & 63)); }

namespace pg8 {
constexpr int BM = 256, BK = 64, HALF = 128, HTB = HALF * BK * 2, STAGE_BYTES = 8 * HTB, NXCD = 8, WGM = 8;
__host__ __device__ __forceinline__ int lds_byte(int r, int c) { const int st = (r >> 4) * 2 + (c >> 5), rr = r & 15, cc = c & 31, ob = rr * 64 + cc * 2; return st * 1024 + (ob ^ (((ob >> 9) & 1) << 5)); }
__host__ __device__ __forceinline__ void stage_rc(int b, int& R, int& C) { const int st = b / 1024, sb = b % 1024, swz = sb ^ (((sb >> 9) & 1) << 5); R = (st >> 1) * 16 + swz / 64; C = (st & 1) * 32 + (swz % 64) / 2; }
__host__ __device__ __forceinline__ int perm32(int rho) { const int n = rho >> 4, i = rho & 15; return 8 * (i >> 2) + 4 * n + (i & 3); }

struct Unit { int pm, pn; };
struct Gemm { const bf16_t* A; const bf16_t* Bt; int M, N, K; };

struct StaticOrder {
    int nM, nN, nwg, G, c;
    __device__ void init(int M, int N, int G_, int c_) { nM = M / BM; nN = N / BM; nwg = nM * nN; G = G_; c = c_; }
    __device__ bool next(int i, Unit& u) const {
        const long L = (long)i * G + c; if (L >= nwg) return false;
        int wgid = (int)L; { const int q = nwg / NXCD, r = nwg % NXCD, xcd = wgid % NXCD, off = wgid / NXCD; wgid = (xcd < r ? xcd * (q + 1) : r * (q + 1) + (xcd - r) * q) + off; }
        const int nig = WGM * nN, gid = wgid / nig, fm = gid * WGM, gsz = (nM - fm) < WGM ? (nM - fm) : WGM;
        u.pm = fm + ((wgid % nig) % gsz); u.pn = (wgid % nig) / gsz; return true;
    }
    __device__ __forceinline__ void a_ready(const Unit&) const {}
    __device__ __forceinline__ void done(const Unit&) const {}
};

typedef f32x4 Acc[2][2][4][2];

struct EpiBf16 {
    static constexpr bool PERM = true, AFTER_DRAIN = false, HAS_MID = false;
    bf16_t* O; int ldc;
    __device__ __forceinline__ void operator()(const Acc& acc, const Unit& u, int wr, int wc, int fr, int fq) const {
        const int row0 = u.pm * BM + wr * 64 + fr, col0 = u.pn * BM + wc * 32 + 8 * fq;
#pragma unroll
        for (int ai = 0; ai < 2; ++ai)
#pragma unroll
            for (int m = 0; m < 4; ++m) { bf16_t* rowp = O + (size_t)(row0 + ai * HALF + m * 16) * ldc + col0;
#pragma unroll
                for (int bj = 0; bj < 2; ++bj) { const f32x4 v0 = acc[ai][bj][m][0], v1 = acc[ai][bj][m][1];
                    u32x4 w; w.x = cvt_pk_bf16(v0[0], v0[1]); w.y = cvt_pk_bf16(v0[2], v0[3]); w.z = cvt_pk_bf16(v1[0], v1[1]); w.w = cvt_pk_bf16(v1[2], v1[3]);
                    *(u32x4*)(rowp + bj * HALF) = w; } }
    }
};

struct EpiSwiGLU {
    static constexpr bool PERM = true, AFTER_DRAIN = false, HAS_MID = false;
    bf16_t* O; int ldc;
    __device__ __forceinline__ void operator()(const Acc& acc, const Unit& u, int wr, int wc, int fr, int fq) const {
        const int row0 = u.pm * BM + wr * 64 + fr, col0 = u.pn * HALF + wc * 32 + 8 * fq;
#pragma unroll
        for (int ai = 0; ai < 2; ++ai)
#pragma unroll
            for (int m = 0; m < 4; ++m) { bf16_t* rowp = O + blk_off(row0 + ai * HALF + m * 16, col0, ldc / 64);
                const f32x4 g0 = acc[ai][0][m][0], g1 = acc[ai][0][m][1], u0 = acc[ai][1][m][0], u1 = acc[ai][1][m][1];
                u32x4 w;
                w.x = swiglu_pk(g0[0], g0[1], u0[0], u0[1]); w.y = swiglu_pk(g0[2], g0[3], u0[2], u0[3]);
                w.z = swiglu_pk(g1[0], g1[1], u1[0], u1[1]); w.w = swiglu_pk(g1[2], g1[3], u1[2], u1[3]);
                *(u32x4*)rowp = w; }
    }
};

struct EpiProj {
    static constexpr bool PERM = true, AFTER_DRAIN = false, HAS_MID = false;
    bf16_t *Q, *K, *V, *U, *GA, *GB; const float *ct, *st;
    __device__ __forceinline__ void rope_store(const Acc& acc, int row0, bf16_t* base, int ld, int colbase, int fq, float sc) const {
#pragma unroll
        for (int ai = 0; ai < 2; ++ai)
#pragma unroll
            for (int m = 0; m < 4; ++m) { const int row = row0 + ai * HALF + m * 16; const int pos = row & (SEQ - 1);
                const float* cp = ct + pos * 32 + 8 * fq; const float* sp = st + pos * 32 + 8 * fq;
                const f32x4 c0 = *(const f32x4*)cp, c1 = *(const f32x4*)(cp + 4), s0 = *(const f32x4*)sp, s1 = *(const f32x4*)(sp + 4);
                const f32x4 a0 = acc[ai][0][m][0] * sc, a1 = acc[ai][0][m][1] * sc, b0 = acc[ai][1][m][0] * sc, b1 = acc[ai][1][m][1] * sc;
                const f32x4 lo0 = a0 * c0 - b0 * s0, lo1 = a1 * c1 - b1 * s1, hi0 = b0 * c0 + a0 * s0, hi1 = b1 * c1 + a1 * s1;
                bf16_t* p = base + (size_t)row * ld + colbase + 8 * fq;
                u32x4 w; w.x = cvt_pk_bf16(lo0[0], lo0[1]); w.y = cvt_pk_bf16(lo0[2], lo0[3]); w.z = cvt_pk_bf16(lo1[0], lo1[1]); w.w = cvt_pk_bf16(lo1[2], lo1[3]);
                *(u32x4*)p = w;
                w.x = cvt_pk_bf16(hi0[0], hi0[1]); w.y = cvt_pk_bf16(hi0[2], hi0[3]); w.z = cvt_pk_bf16(hi1[0], hi1[1]); w.w = cvt_pk_bf16(hi1[2], hi1[3]);
                *(u32x4*)(p + 32) = w;
                if (m & 1) asm volatile("" ::: "memory"); }
    }
    template <int ACT> __device__ __forceinline__ void plain_store(const Acc& acc, int row0, bf16_t* base, int ld, int col0) const {
#pragma unroll
        for (int ai = 0; ai < 2; ++ai)
#pragma unroll
            for (int m = 0; m < 4; ++m) { bf16_t* rowp = base + (size_t)(row0 + ai * HALF + m * 16) * ld + col0;
#pragma unroll
                for (int bj = 0; bj < 2; ++bj) { const f32x4 v0 = acc[ai][bj][m][0], v1 = acc[ai][bj][m][1];
                    u32x4 w;
                    if (ACT == 1) { w.x = sigmoid_pk(v0[0], v0[1]); w.y = sigmoid_pk(v0[2], v0[3]); w.z = sigmoid_pk(v1[0], v1[1]); w.w = sigmoid_pk(v1[2], v1[3]); }
                    else { w.x = cvt_pk_bf16(v0[0], v0[1]); w.y = cvt_pk_bf16(v0[2], v0[3]); w.z = cvt_pk_bf16(v1[0], v1[1]); w.w = cvt_pk_bf16(v1[2], v1[3]); }
                    *(u32x4*)(rowp + bj * HALF) = w; }
                asm volatile("" ::: "memory"); }
    }
    __device__ __forceinline__ void operator()(const Acc& acc, const Unit& u, int wr, int wc, int fr, int fq) const {
        int row0 = u.pm * BM + wr * 64 + fr; const int pn = u.pn;
#define OPAQUE_ROW() asm volatile("" : "+v"(row0))
        if (pn < 2) { OPAQUE_ROW(); rope_store(acc, row0, Q, 512, (4 * pn + wc) * 64, fq, 0.125f * LOG2E); }
        else if (pn == 2) {
            if (wc < 2) { OPAQUE_ROW(); rope_store(acc, row0, K, 128, wc * 64, fq, 1.0f); }
            else { OPAQUE_ROW();
#pragma unroll
                for (int ai = 0; ai < 2; ++ai)
#pragma unroll
                    for (int m = 0; m < 4; ++m) { bf16_t* rowp = V + (size_t)(row0 + ai * HALF + m * 16) * 128 + (wc - 2) * 32 + 8 * fq;
#pragma unroll
                        for (int bj = 0; bj < 2; ++bj) { const f32x4 v0 = acc[ai][bj][m][0], v1 = acc[ai][bj][m][1];
                            u32x4 w; w.x = cvt_pk_bf16(v0[0], v0[1]); w.y = cvt_pk_bf16(v0[2], v0[3]); w.z = cvt_pk_bf16(v1[0], v1[1]); w.w = cvt_pk_bf16(v1[2], v1[3]);
                            *(u32x4*)(rowp + bj * 64) = w; } }
            }
        }
        else if (pn < 5) { OPAQUE_ROW(); plain_store<0>(acc, row0, U, 512, (pn - 3) * BM + wc * 32 + 8 * fq); }
        else { OPAQUE_ROW(); bf16_t* gbase = pn < 9 ? GA : GB; const int gt = pn < 9 ? pn - 5 : pn - 9; plain_store<1>(acc, row0, gbase, D, gt * BM + wc * 32 + 8 * fq); }
#undef OPAQUE_ROW
    }
};

struct EpiMerge {
    static constexpr bool PERM = true, AFTER_DRAIN = false, HAS_MID = true;
    bf16_t* O; const bf16_t* Ga; const bf16_t* Gb;
    __device__ __forceinline__ void mid(Acc& acc, const Unit& u, int wr, int wc, int fr, int fq) const {
        int row0 = u.pm * BM + wr * 64 + fr, col0 = u.pn * BM + wc * 32 + 8 * fq; asm volatile("" : "+v"(row0), "+v"(col0));
#pragma unroll
        for (int ai = 0; ai < 2; ++ai)
#pragma unroll
            for (int m = 0; m < 4; ++m) { const size_t offg = (size_t)(row0 + ai * HALF + m * 16) * D + col0;
#pragma unroll
                for (int bj = 0; bj < 2; ++bj) {
                    const u32x4 a = *(const u32x4*)(Ga + offg + bj * HALF), b = *(const u32x4*)(Gb + offg + bj * HALF);
                    const float r0 = bf_lo(a.x) * __builtin_amdgcn_rcpf(fmaxf(bf_lo(b.x), 1e-30f)), r1 = bf_hi(a.x) * __builtin_amdgcn_rcpf(fmaxf(bf_hi(b.x), 1e-30f));
                    const float r2 = bf_lo(a.y) * __builtin_amdgcn_rcpf(fmaxf(bf_lo(b.y), 1e-30f)), r3 = bf_hi(a.y) * __builtin_amdgcn_rcpf(fmaxf(bf_hi(b.y), 1e-30f));
                    acc[ai][bj][m][0] = acc[ai][bj][m][0] * (f32x4){r0, r1, r2, r3};
                    const float r4 = bf_lo(a.z) * __builtin_amdgcn_rcpf(fmaxf(bf_lo(b.z), 1e-30f)), r5 = bf_hi(a.z) * __builtin_amdgcn_rcpf(fmaxf(bf_hi(b.z), 1e-30f));
                    const float r6 = bf_lo(a.w) * __builtin_amdgcn_rcpf(fmaxf(bf_lo(b.w), 1e-30f)), r7 = bf_hi(a.w) * __builtin_amdgcn_rcpf(fmaxf(bf_hi(b.w), 1e-30f));
                    acc[ai][bj][m][1] = acc[ai][bj][m][1] * (f32x4){r4, r5, r6, r7}; }
                if (m & 1) asm volatile("" ::: "memory"); }
    }
    __device__ __forceinline__ void operator()(const Acc& acc, const Unit& u, int wr, int wc, int fr, int fq) const {
        int row0 = u.pm * BM + wr * 64 + fr, col0 = u.pn * BM + wc * 32 + 8 * fq; asm volatile("" : "+v"(row0), "+v"(col0));
#pragma unroll
        for (int ai = 0; ai < 2; ++ai)
#pragma unroll
            for (int m = 0; m < 4; ++m) { const size_t offg = (size_t)(row0 + ai * HALF + m * 16) * D + col0;
#pragma unroll
                for (int bj = 0; bj < 2; ++bj) { const f32x4 v0 = acc[ai][bj][m][0], v1 = acc[ai][bj][m][1];
                    const u32x4 g = *(const u32x4*)(Gb + offg + bj * HALF);
                    const float q0 = fmaxf(bf_lo(g.x), 1e-30f), q1 = fmaxf(bf_hi(g.x), 1e-30f), q2 = fmaxf(bf_lo(g.y), 1e-30f), q3 = fmaxf(bf_hi(g.y), 1e-30f);
                    const float q4 = fmaxf(bf_lo(g.z), 1e-30f), q5 = fmaxf(bf_hi(g.z), 1e-30f), q6 = fmaxf(bf_lo(g.w), 1e-30f), q7 = fmaxf(bf_hi(g.w), 1e-30f);
                    u32x4 w; w.x = cvt_pk_bf16(v0[0] * q0, v0[1] * q1); w.y = cvt_pk_bf16(v0[2] * q2, v0[3] * q3); w.z = cvt_pk_bf16(v1[0] * q4, v1[1] * q5); w.w = cvt_pk_bf16(v1[2] * q6, v1[3] * q7);
                    *(u32x4*)(O + blk_off(row0 + ai * HALF + m * 16, col0 + bj * HALF, D / 64)) = w; }
                if (m & 1) asm volatile("" ::: "memory"); }
    }
};

template <class Epi, class Sched, bool ALIGN_EPI = false, bool SP2 = false>
__device__ __forceinline__ void gemm_phase(LAS unsigned char* lds, const Gemm g, const Sched& S, const Epi& E) {
    const int tid = threadIdx.x, wid = __builtin_amdgcn_readfirstlane(tid >> 6), lane = tid & 63, wr = wid >> 2, wc = wid & 3, fr = lane & 15, fq = lane >> 4;
    const int K = g.K, nt = K / BK;
    unsigned voffA[2], voffB[2];
#pragma unroll
    for (int i = 0; i < 2; ++i) { int R, C; stage_rc(tid * 16 + i * 8192, R, C); const int Rb = Epi::PERM ? ((R & ~31) + perm32(R & 31)) : R;
        voffA[i] = (unsigned)(R * 64 + C) * 2u; voffB[i] = (unsigned)(Rb * 64 + C) * 2u; }
    const size_t kstep = (size_t)BM * BK * 2;
    const size_t hstep = (size_t)HALF * BK * 2;
    const size_t tstep = (size_t)nt * kstep;
    const unsigned ldsw = (unsigned)wid * 1024u;
    const int aoff = lds_byte(wr * 64 + fr, fq * 8), boff = lds_byte(wc * 32 + fr, fq * 8);
#define PG8_SA(b, h) (((b) * 2 + (h)) * HTB)
#define PG8_SB(b, h) ((4 + (b) * 2 + (h)) * HTB)
#define PG8_STAGE(bufoff, gbase, voff) do { _Pragma("unroll") for (int _i = 0; _i < 2; ++_i) \
        __builtin_amdgcn_global_load_lds((const unsigned*)((const char*)(gbase) + (voff)[_i]), (LAS unsigned*)(lds + (bufoff) + ldsw + _i * 8192), 16, 0, 0); } while (0)
#define PG8_LDA(dst, b, h) do { _Pragma("unroll") for (int m = 0; m < 4; ++m) _Pragma("unroll") for (int k = 0; k < 2; ++k) dst[m][k] = *(const LAS bf16x8*)(lds + PG8_SA(b, h) + aoff + m * 2048 + k * 1024); } while (0)
#define PG8_LDB(dst, b, h) do { _Pragma("unroll") for (int n = 0; n < 2; ++n) _Pragma("unroll") for (int k = 0; k < 2; ++k) dst[n][k] = *(const LAS bf16x8*)(lds + PG8_SB(b, h) + boff + n * 2048 + k * 1024); } while (0)
#define PG8_MMA(ai, bj, At, Bt) do { __builtin_amdgcn_s_setprio(1); _Pragma("unroll") for (int m = 0; m < 4; ++m) _Pragma("unroll") for (int n = 0; n < 2; ++n) _Pragma("unroll") for (int k = 0; k < 2; ++k) \
        acc[ai][bj][m][n] = __builtin_amdgcn_mfma_f32_16x16x32_bf16(Bt[n][k], At[m][k], acc[ai][bj][m][n], 0, 0, 0); __builtin_amdgcn_s_setprio(0); } while (0)
#define PG8_WAIT_V(n) asm volatile("s_waitcnt vmcnt(" #n ")" ::: "memory")
#define PG8_WAIT_V8_UNLESS(f) asm volatile("s_cmp_lg_u32 %0, 0\n\ts_cbranch_scc1 .Lpg8skip%=\n\ts_waitcnt vmcnt(8)\n.Lpg8skip%=:" :: "s"(f) : "scc", "memory")
#define PG8_WAIT_L(n) asm volatile("s_waitcnt lgkmcnt(" #n ")" ::: "memory")
#define PG8_BAR __builtin_amdgcn_s_barrier()
#define PG8_SCHED __builtin_amdgcn_sched_barrier(0)
    Unit cur, nxt; int ui = 0;
    if (!S.next(0, cur)) return;
    f32x4 acc[2][2][4][2];
#pragma unroll
    for (int a = 0; a < 2; ++a)
#pragma unroll
        for (int b = 0; b < 2; ++b)
#pragma unroll
            for (int m = 0; m < 4; ++m)
#pragma unroll
                for (int n = 0; n < 2; ++n) acc[a][b][m][n] = (f32x4){0.f, 0.f, 0.f, 0.f};
    bf16x8 At[4][2], B0[2][2], B1[2][2];
    const char* cA = (const char*)g.A + (size_t)cur.pm * tstep; const char* cB = (const char*)g.Bt + (size_t)cur.pn * tstep;
    S.a_ready(cur);
    if constexpr (SP2) {
        PG8_STAGE(PG8_SB(0, 0), cB, voffB); PG8_STAGE(PG8_SB(0, 1), cB + hstep, voffB); PG8_STAGE(PG8_SA(0, 0), cA, voffA); PG8_STAGE(PG8_SA(0, 1), cA + hstep, voffA);
        if (wr == 1) PG8_BAR;
        PG8_WAIT_V(2); PG8_BAR;
        PG8_STAGE(PG8_SB(1, 0), cB + kstep, voffB); PG8_STAGE(PG8_SA(1, 0), cA + kstep, voffA); PG8_STAGE(PG8_SB(1, 1), cB + hstep + kstep, voffB);
        PG8_WAIT_V(6); PG8_BAR;
    } else {
        PG8_STAGE(PG8_SB(0, 0), cB, voffB); PG8_STAGE(PG8_SA(0, 0), cA, voffA); PG8_STAGE(PG8_SB(0, 1), cB + hstep, voffB); PG8_STAGE(PG8_SA(0, 1), cA + hstep, voffA);
        if (wr == 1) PG8_BAR;
        PG8_WAIT_V(4); PG8_BAR;
        PG8_STAGE(PG8_SB(1, 0), cB + kstep, voffB); PG8_STAGE(PG8_SA(1, 0), cA + kstep, voffA); PG8_STAGE(PG8_SB(1, 1), cB + hstep + kstep, voffB);
        PG8_WAIT_V(6); PG8_BAR;
    }
    for (;;) {
        const bool has_next = S.next(ui + 1, nxt);
        const char* nA = has_next ? (const char*)g.A + (size_t)nxt.pm * tstep : cA; const char* nB = has_next ? (const char*)g.Bt + (size_t)nxt.pn * tstep : cB;
        for (int t = 0; t < nt; t += 2) {
            const bool last = (t == nt - 2);
            const char* a1 = cA + (size_t)(t + 1) * kstep;
            const char* a2 = last ? nA : cA + (size_t)(t + 2) * kstep; const char* b2 = last ? nB : cB + (size_t)(t + 2) * kstep;
            const char* a3 = a2 + kstep; const char* b3 = b2 + kstep;
            if (last && has_next) S.a_ready(nxt);
            if constexpr (SP2) {
            if constexpr (Epi::HAS_MID) { if (t == nt / 2) E.mid(acc, cur, wr, wc, fr, fq); }
            const int fresh = __builtin_amdgcn_readfirstlane(((t == 0) && (ui > 0)) ? 1 : 0);
            PG8_LDB(B0, 0, 0); PG8_LDB(B1, 0, 1); PG8_SCHED; PG8_LDA(At, 0, 0); PG8_STAGE(PG8_SA(1, 1), a1 + hstep, voffA);
            PG8_WAIT_V8_UNLESS(fresh); PG8_WAIT_L(0); PG8_BAR; PG8_MMA(0, 0, At, B0); PG8_MMA(0, 1, At, B1); PG8_BAR; PG8_SCHED;
            PG8_LDA(At, 0, 1); PG8_STAGE(PG8_SB(0, 0), b2, voffB); PG8_STAGE(PG8_SB(0, 1), b2 + hstep, voffB); PG8_STAGE(PG8_SA(0, 0), a2, voffA);
            PG8_WAIT_V8_UNLESS(fresh); PG8_WAIT_L(0); PG8_BAR; PG8_MMA(1, 0, At, B0); PG8_MMA(1, 1, At, B1); PG8_BAR; PG8_SCHED;
            PG8_LDB(B0, 1, 0); PG8_LDB(B1, 1, 1); PG8_SCHED; PG8_LDA(At, 1, 0); PG8_STAGE(PG8_SA(0, 1), a2 + hstep, voffA);
            PG8_WAIT_V(8); PG8_WAIT_L(0); PG8_BAR; PG8_MMA(0, 0, At, B0); PG8_MMA(0, 1, At, B1); PG8_BAR; PG8_SCHED;
            PG8_LDA(At, 1, 1); PG8_STAGE(PG8_SB(1, 0), b3, voffB); PG8_STAGE(PG8_SB(1, 1), b3 + hstep, voffB); PG8_STAGE(PG8_SA(1, 0), a3, voffA);
            PG8_WAIT_V(8); PG8_WAIT_L(0); PG8_BAR; PG8_MMA(1, 0, At, B0); PG8_MMA(1, 1, At, B1); PG8_BAR; PG8_SCHED;
            } else {
            PG8_LDB(B0, 0, 0); PG8_SCHED; PG8_LDA(At, 0, 0); PG8_STAGE(PG8_SA(1, 1), a1 + hstep, voffA);
            PG8_WAIT_L(8); PG8_BAR; PG8_WAIT_L(0); PG8_MMA(0, 0, At, B0); PG8_BAR; PG8_SCHED;
            PG8_LDB(B1, 0, 1); PG8_STAGE(PG8_SB(0, 0), b2, voffB);
            PG8_BAR; PG8_WAIT_L(0); PG8_MMA(0, 1, At, B1); PG8_BAR;
            PG8_LDA(At, 0, 1); PG8_STAGE(PG8_SA(0, 0), a2, voffA);
            PG8_BAR; PG8_WAIT_L(0); PG8_MMA(1, 0, At, B0); PG8_BAR; PG8_SCHED;
            PG8_STAGE(PG8_SB(0, 1), b2 + hstep, voffB);
            PG8_WAIT_V(6); PG8_BAR; PG8_MMA(1, 1, At, B1); PG8_BAR;
            PG8_LDB(B0, 1, 0); PG8_SCHED; PG8_LDA(At, 1, 0); PG8_STAGE(PG8_SA(0, 1), a2 + hstep, voffA);
            PG8_WAIT_L(8); PG8_BAR; PG8_WAIT_L(0); PG8_MMA(0, 0, At, B0); PG8_BAR; PG8_SCHED;
            PG8_LDB(B1, 1, 1); PG8_STAGE(PG8_SB(1, 0), b3, voffB);
            PG8_BAR; PG8_WAIT_L(0); PG8_MMA(0, 1, At, B1); PG8_BAR;
            PG8_LDA(At, 1, 1); PG8_STAGE(PG8_SA(1, 0), a3, voffA);
            PG8_BAR; PG8_WAIT_L(0); PG8_MMA(1, 0, At, B0); PG8_BAR; PG8_SCHED;
            PG8_STAGE(PG8_SB(1, 1), b3 + hstep, voffB);
            PG8_WAIT_V(6); PG8_BAR; PG8_MMA(1, 1, At, B1); PG8_BAR;
            }
        }
        if constexpr (ALIGN_EPI) { if (wr == 0) PG8_BAR; }
        if constexpr (SP2) PG8_WAIT_V(0);
        if constexpr (!Epi::AFTER_DRAIN) { E(acc, cur, wr, wc, fr, fq); S.done(cur); }
        if (!has_next) break;
#pragma unroll
        for (int a = 0; a < 2; ++a)
#pragma unroll
            for (int b = 0; b < 2; ++b)
#pragma unroll
                for (int m = 0; m < 4; ++m)
#pragma unroll
                    for (int n = 0; n < 2; ++n) acc[a][b][m][n] = (f32x4){0.f, 0.f, 0.f, 0.f};
        cur = nxt; cA = nA; cB = nB; ++ui;
        if constexpr (ALIGN_EPI) { if (wr == 1) PG8_BAR; }
    }
    PG8_WAIT_V(0);
    if constexpr (!ALIGN_EPI) { if (wr == 0) PG8_BAR; }
    PG8_BAR;
#undef PG8_SA
#undef PG8_SB
#undef PG8_STAGE
#undef PG8_LDA
#undef PG8_LDB
#undef PG8_MMA
#undef PG8_WAIT_V
#undef PG8_WAIT_V8_UNLESS
#undef PG8_WAIT_L
#undef PG8_BAR
#undef PG8_SCHED
}
}

#define XB_TMO      128
#define XB_XCNT(j)  (256  + 64 * (j))
#define XB_XSUB(j)  (1280 + 64 * (j))
#define XB_XGEN(j)  (2304 + 64 * (j))
#define XB_TOP      3328
#define XB_TOPGEN   3392
#define XCD_BAR_WORDS 3456
#define XB_SPIN_CAP (1u << 22)
__device__ __forceinline__ unsigned xb_ld(unsigned* p)              { return __hip_atomic_load(p, __ATOMIC_RELAXED, __HIP_MEMORY_SCOPE_AGENT); }
__device__ __forceinline__ unsigned xb_add(unsigned* p, unsigned v) { return __hip_atomic_fetch_add(p, v, __ATOMIC_RELAXED, __HIP_MEMORY_SCOPE_AGENT); }
__device__ __forceinline__ unsigned xb_xcc_id() { return (unsigned)__builtin_amdgcn_s_getreg((3 << 11) | 20) & 0xFu; }
#define XB_SPIN(cond, bar) do { unsigned _sp = 0; while (cond) { __builtin_amdgcn_s_sleep(1); \
    if ((++_sp & 255u) == 0u) { if (xb_ld(&(bar)[XB_TMO])) break; if (_sp > XB_SPIN_CAP) { atomicAdd(&(bar)[XB_TMO], 1u); break; } } } } while (0)
struct XcdBarrier { unsigned* bar; unsigned x; volatile LAS unsigned* st; };
__device__ __forceinline__ XcdBarrier xcd_barrier_post(unsigned* bar, volatile LAS unsigned* st) {
    XcdBarrier b; b.bar = bar; b.x = xb_xcc_id(); b.st = st;
    if (threadIdx.x == 0) st[2] = xb_add(&bar[XB_XCNT(b.x)], 1u);
    return b;
}
__device__ __forceinline__ void xcd_barrier_complete(unsigned* bar, unsigned x, unsigned& nloc, unsigned& nx) {
    const unsigned G = gridDim.x * gridDim.y * gridDim.z;
    unsigned sum, cnt, mine, sp = 0u;
    for (;;) {
        sum = 0u; cnt = 0u; mine = 0u;
#pragma unroll
        for (unsigned j = 0; j < 16; ++j) { const unsigned c = xb_ld(&bar[XB_XCNT(j)]); sum += c; cnt += (c > 0u) ? 1u : 0u; mine = (j == x) ? c : mine; }
        if (sum == G) break;
        __builtin_amdgcn_s_sleep(1);
        if ((++sp & 255u) == 0u) { if (xb_ld(&bar[XB_TMO])) break; if (sp > XB_SPIN_CAP) { atomicAdd(&bar[XB_TMO], 1u); break; } }
    }
    nloc = mine > 0u ? mine : 1u; nx = cnt > 0u ? cnt : 1u;
}
__device__ __forceinline__ void xcd_barrier(const XcdBarrier& b) {
    asm volatile("s_waitcnt vmcnt(0)" ::: "memory");
    __syncthreads();
    if (threadIdx.x == 0) {
        unsigned* bar = b.bar;
        __builtin_amdgcn_s_waitcnt(0);
        unsigned nloc = b.st[0], nx = b.st[1];
        if (nloc == 0u) { xcd_barrier_complete(bar, b.x, nloc, nx); b.st[0] = nloc; b.st[1] = nx; }
        const unsigned old = xb_add(&bar[XB_XSUB(b.x)], 1u);
        const unsigned gen = old / nloc;
        if (old + 1u == (gen + 1u) * nloc) {
            __builtin_amdgcn_fence(__ATOMIC_RELEASE, "agent");
            asm volatile("s_waitcnt vmcnt(0)" ::: "memory");
            const unsigned og = xb_add(&bar[XB_TOP], 1u);
            const unsigned tg = og / nx;
            if (og + 1u == (tg + 1u) * nx) xb_add(&bar[XB_TOPGEN], 1u);
            else XB_SPIN(xb_ld(&bar[XB_TOPGEN]) == tg, bar);
            __builtin_amdgcn_fence(__ATOMIC_ACQUIRE, "agent");
            xb_add(&bar[XB_XGEN(b.x)], 1u);
            asm volatile("s_waitcnt vmcnt(0)" ::: "memory");
        } else {
            XB_SPIN(xb_ld(&bar[XB_XGEN(b.x)]) == gen, bar);
            __builtin_amdgcn_fence(__ATOMIC_ACQUIRE, "agent");
            asm volatile("s_waitcnt vmcnt(0)" ::: "memory");
        }
    }
    __syncthreads();
}

struct Args { const float* in[21]; float* out; unsigned char* ws; int ph_lo, ph_hi; };
enum { I_XP = 0, I_XS, I_CP, I_CS, I_ADAW, I_ADAB, I_NPRE, I_NPOST, I_F1G, I_F1U, I_F1D, I_WIN, I_SINK, I_WAB, I_POOLW, I_POOLS, I_WPB, I_WOUT, I_F2G, I_F2U, I_F2D };

__device__ __forceinline__ int map_row(int mode, int n0) {
    if (mode == 0) return n0;
    if (mode == 1) return 256 * (n0 >> 7) + (n0 & 127);
    if (mode == 2) return 256 * (n0 >> 7) + 128 + (n0 & 127);
    if (n0 < 512) { const int head = n0 >> 6, half = (n0 >> 5) & 1; return 256 * (head >> 2) + 128 * half + (head & 3) * 32; }
    if (n0 < 640) { const int kh = (n0 - 512) >> 6, half = (n0 >> 5) & 1; return 512 + 128 * half + kh * 32; }
    if (n0 < 768) { const int vv = n0 - 640; return 512 + 128 * (vv >> 6) + 64 + (vv & 63); }
    return n0;
}
__device__ __forceinline__ void transpose_item(const float* W, int K, int N, bf16_t* WT, int KB, int mode, LAS float* scr, int item, int lane) {
    const int nblk = N / 32, kb = item / nblk, nb = item % nblk, k0 = 64 * kb, n0 = 32 * nb;
#pragma unroll 8
    for (int i = 0; i < 32; ++i) { const int kk = 2 * i + (lane >> 5); scr[kk * 33 + (lane & 31)] = W[(size_t)(k0 + kk) * N + n0 + (lane & 31)]; }
    LDS_WAIT();
    const int rb = map_row(mode, n0);
    const int c = lane & 7;
#pragma unroll
    for (int j = 0; j < 4; ++j) { const int n = (lane >> 3) + 8 * j; const LAS float* s = scr + (8 * c) * 33 + n;
        u32x4 o; o.x = cvt_pk_bf16(s[0 * 33], s[1 * 33]); o.y = cvt_pk_bf16(s[2 * 33], s[3 * 33]); o.z = cvt_pk_bf16(s[4 * 33], s[5 * 33]); o.w = cvt_pk_bf16(s[6 * 33], s[7 * 33]);
        *(u32x4*)(WT + blk_off(rb + n, k0 + 8 * c, KB)) = o; }
    LDS_WAIT();
}

__device__ __forceinline__ void mod_phase(LAS unsigned char* lds, const Args& a, int G, int bid) {
    const int tid = threadIdx.x, lane = tid & 63, wid = tid >> 6;
    LAS float* sc = (LAS float*)lds;
    LAS float* part = (LAS float*)(lds + 40960);
    for (int i = tid; i < NSEQ * D; i += 512) { const int b = i >> 10, k = i & 1023; const float c = (b < NPROMPT) ? a.in[I_CP][b * D + k] : a.in[I_CS][(b - NPROMPT) * D + k]; sc[i] = c / (1.0f + expf(-c)); }
    __syncthreads();
    float* mod = (float*)(a.ws + WS_MOD);
    for (int it = bid; it < NMOD / 36; it += G) {
        const int j0 = it * 36; const int ln = lane < 36 ? lane : 35;
        float acc[NSEQ];
#pragma unroll
        for (int b = 0; b < NSEQ; ++b) acc[b] = 0.f;
        const float* w = a.in[I_ADAW] + (size_t)(wid * 128) * NMOD + j0 + ln;
#pragma unroll 16
        for (int k = 0; k < 128; ++k) { const float wv = w[(size_t)k * NMOD];
#pragma unroll
            for (int b = 0; b < NSEQ; ++b) acc[b] += sc[b * D + wid * 128 + k] * wv; }
#pragma unroll
        for (int b = 0; b < NSEQ; ++b) part[(wid * NSEQ + b) * 64 + lane] = acc[b];
        __syncthreads();
        for (int i = tid; i < NSEQ * 36; i += 512) { const int b = i / 36, l = i - b * 36; float s = a.in[I_ADAB][j0 + l];
#pragma unroll
            for (int w8 = 0; w8 < 8; ++w8) s += part[(w8 * NSEQ + b) * 64 + l];
            mod[b * NMOD + j0 + l] = s; }
        __syncthreads();
    }
}

__device__ __forceinline__ void prep_phase(LAS unsigned char* lds, const Args& a, int G, int bid) {
    const int tid = threadIdx.x, lane = tid & 63, wid = tid >> 6;
    unsigned char* ws = a.ws;
    LAS float* scr = (LAS float*)(lds + wid * 16384);
    const int gw = bid * 8 + wid, NGW = G * 8;
    constexpr int I_GU = (D / 64) * (FF / 32), I_DN = (FF / 64) * (D / 32), I_IN = (D / 64) * (NIN / 32), I_AB = (512 / 64) * (D / 32), I_OUT = (D / 64) * (D / 32);
    constexpr int NITEMS = 4 * I_GU + 2 * I_DN + I_IN + I_AB + I_OUT;
    for (int it = gw; it < NITEMS; it += NGW) {
        int r = it;
        if (r < I_GU) { transpose_item(a.in[I_F1G], D, FF, (bf16_t*)(ws + WS_W1GU), D / 64, 1, scr, r, lane); continue; } r -= I_GU;
        if (r < I_GU) { transpose_item(a.in[I_F1U], D, FF, (bf16_t*)(ws + WS_W1GU), D / 64, 2, scr, r, lane); continue; } r -= I_GU;
        if (r < I_GU) { transpose_item(a.in[I_F2G], D, FF, (bf16_t*)(ws + WS_W2GU), D / 64, 1, scr, r, lane); continue; } r -= I_GU;
        if (r < I_GU) { transpose_item(a.in[I_F2U], D, FF, (bf16_t*)(ws + WS_W2GU), D / 64, 2, scr, r, lane); continue; } r -= I_GU;
        if (r < I_DN) { transpose_item(a.in[I_F1D], FF, D, (bf16_t*)(ws + WS_W1D), FF / 64, 0, scr, r, lane); continue; } r -= I_DN;
        if (r < I_DN) { transpose_item(a.in[I_F2D], FF, D, (bf16_t*)(ws + WS_W2D), FF / 64, 0, scr, r, lane); continue; } r -= I_DN;
        if (r < I_IN) { transpose_item(a.in[I_WIN], D, NIN, (bf16_t*)(ws + WS_WIN), D / 64, 3, scr, r, lane); continue; } r -= I_IN;
        if (r < I_AB) { transpose_item(a.in[I_WAB], 512, D, (bf16_t*)(ws + WS_WAB), D / 64, 0, scr, r, lane); continue; } r -= I_AB;
        transpose_item(a.in[I_WOUT], D, D, (bf16_t*)(ws + WS_WOUT), D / 64, 0, scr, r, lane);
    }
    {
        const float* pw = a.in[I_POOLW]; const float* ps = a.in[I_POOLS]; const float* wpb = a.in[I_WPB]; bf16_t* o = (bf16_t*)(ws + WS_WAB);
        for (int it = gw; it < 2048; it += NGW) {
            const int nq = it & 3, c = (it >> 2) & 127, g = it >> 9;
            scr[lane] = pw[(g * 128 + c) * 128 + lane] * ps[g * 128 + lane];
            scr[lane + 64] = pw[(g * 128 + c) * 128 + lane + 64] * ps[g * 128 + lane + 64];
            LDS_WAIT();
            for (int nc = 0; nc < 4; ++nc) { const int n = nq * 256 + nc * 64 + lane; float s = 0.f; const float* wp = wpb + (size_t)(g * 128) * D + n;
#pragma unroll 8
                for (int d = 0; d < 128; ++d) s += scr[d] * wp[(size_t)d * D];
                o[blk_off(n, 512 + g * 128 + c, 16)] = (bf16_t)(cvt_pk_bf16(s, 0.f) & 0xffffu); }
            LDS_WAIT();
        }
    }
    {
        float* ct = (float*)(ws + WS_CT); float* st = (float*)(ws + WS_ST);
        for (int i = bid * 512 + tid; i < SEQ * 32; i += G * 512) { const int pos = i >> 5, f = i & 31;
            const float inv = exp2f(-(float)f * (13.287712379549449f / 32.0f));
            const float ang = (float)pos * inv;
            const double ad = (double)ang; const double kk = rint(ad * 0.15915494309189535);
            double r = fma(-kk, 6.283185307179586, ad); r = fma(-kk, 2.4492935982947064e-16, r);
            const float rf = (float)r;
            ct[i] = cosf(rf); st[i] = sinf(rf); }
    }
}

__device__ __forceinline__ const float* xrow_in(const Args& a, int row) { return row < NPROMPT * SEQ ? a.in[I_XP] + (size_t)row * D : a.in[I_XS] + (size_t)(row - NPROMPT * SEQ) * D; }

template <int MODE, bool XF32> __device__ __forceinline__ void norm_phase(const Args& a, int j, float rw, int G, int bid, const bf16_t* Xin, const bf16_t* Yin, bf16_t* Xout) {
    const int tid = threadIdx.x, lane = tid & 63, wid = tid >> 6;
    const float* mod = (const float*)(a.ws + WS_MOD);
    bf16_t* H = (bf16_t*)(a.ws + WS_H);
    const int rpb = (((T + G - 1) / G) + 31) & ~31;
    const int r0 = bid * rpb + wid * 4, r1 = (bid * rpb + rpb) < T ? (bid * rpb + rpb) : T;
    int cur_b = -1;
    f32x4 pA[4], pB[4], pC[4];
#pragma unroll
    for (int q = 0; q < 4; ++q) { pA[q] = (f32x4){0.f, 0.f, 0.f, 0.f}; pB[q] = pA[q]; pC[q] = pA[q]; }
    for (int r = r0; r < r1; r += 32) {
        const int b = r >> 13;
        if (b != cur_b) { cur_b = b;
            if (MODE != 0) { const f32x4* gp = (const f32x4*)(a.in[I_NPOST] + j * D) + lane; const f32x4* gt = (const f32x4*)(mod + (size_t)b * NMOD + j * 3 * D + 2 * D) + lane;
#pragma unroll
                for (int q = 0; q < 4; ++q) pA[q] = gp[64 * q] * (gt[64 * q] * rw); }
            if (MODE != 2) { const int jn = (MODE == 0) ? j : j + 1;
                const f32x4* gp = (const f32x4*)(a.in[I_NPRE] + jn * D) + lane; const f32x4* sh = (const f32x4*)(mod + (size_t)b * NMOD + jn * 3 * D) + lane; const f32x4* sc = sh + D / 4;
#pragma unroll
                for (int q = 0; q < 4; ++q) { pB[q] = gp[64 * q] * (sc[64 * q] + 1.0f); pC[q] = sh[64 * q]; } }
        }
        f32x4 x[4][4]; u32x2 yw[4][4];
#pragma unroll
        for (int i = 0; i < 4; ++i) { const int row = (r + i) < r1 ? (r + i) : (r1 - 1);
            if (XF32) { const f32x4* xr = (const f32x4*)xrow_in(a, row) + lane;
#pragma unroll
                for (int q = 0; q < 4; ++q) x[i][q] = xr[64 * q]; }
            else { const u32x2* xr = (const u32x2*)(Xin + (size_t)row * D) + lane;
#pragma unroll
                for (int q = 0; q < 4; ++q) { const u32x2 w = xr[64 * q]; x[i][q] = (f32x4){bf_lo(w.x), bf_hi(w.x), bf_lo(w.y), bf_hi(w.y)}; } }
            if (MODE != 0) { const u32x2* yr = (const u32x2*)(Yin + (size_t)row * D) + lane;
#pragma unroll
                for (int q = 0; q < 4; ++q) yw[i][q] = yr[64 * q]; }
        }
#pragma unroll
        for (int i = 0; i < 4; ++i) { const int row = r + i; const bool live = row < r1;
            if (MODE != 0) {
                f32x4 y[4]; float ss = 0.f;
#pragma unroll
                for (int q = 0; q < 4; ++q) { const u32x2 w = yw[i][q]; y[q] = (f32x4){bf_lo(w.x), bf_hi(w.x), bf_lo(w.y), bf_hi(w.y)};
                    ss += (y[q][0] * y[q][0] + y[q][1] * y[q][1]) + (y[q][2] * y[q][2] + y[q][3] * y[q][3]); }
                const float rstd = rsqrtf(wave_sum(ss) * (1.0f / D) + EPS);
#pragma unroll
                for (int q = 0; q < 4; ++q) x[i][q] = x[i][q] + (y[q] * rstd) * pA[q];
                if (MODE == 2) { f32x4* xo = (f32x4*)(a.out + (size_t)row * D) + lane;
#pragma unroll
                    for (int q = 0; q < 4; ++q) if (live) xo[64 * q] = x[i][q]; }
                else { u32x2* xo = (u32x2*)(Xout + (size_t)row * D) + lane;
#pragma unroll
                    for (int q = 0; q < 4; ++q) { u32x2 w; w.x = cvt_pk_bf16(x[i][q][0], x[i][q][1]); w.y = cvt_pk_bf16(x[i][q][2], x[i][q][3]); if (live) xo[64 * q] = w; } }
            }
            if (MODE != 2) {
                float ss = 0.f;
#pragma unroll
                for (int q = 0; q < 4; ++q) ss += (x[i][q][0] * x[i][q][0] + x[i][q][1] * x[i][q][1]) + (x[i][q][2] * x[i][q][2] + x[i][q][3] * x[i][q][3]);
                const float rstd = rsqrtf(wave_sum(ss) * (1.0f / D) + EPS);
#pragma unroll
                for (int q = 0; q < 4; ++q) { const f32x4 h = (x[i][q] * rstd) * pB[q] + pC[q];
                    u32x2 w; w.x = cvt_pk_bf16(h[0], h[1]); w.y = cvt_pk_bf16(h[2], h[3]); if (live) *(u32x2*)(H + blk_off(row, 4 * lane + 256 * q, D / 64)) = w; }
            }
        }
    }
}

namespace att {
constexpr int KSTR = 144;
constexpr int VSTR = 784;
constexpr int K_OFF = 0, V_OFF = 384 * KSTR, BYTES = V_OFF + 64 * VSTR;
static_assert(BYTES <= 131072, "attention LDS");
}
__device__ __forceinline__ void attn_phase(LAS unsigned char* lds, const bf16_t* Q, const bf16_t* K, const bf16_t* V, bf16_t* O, const float* sink, int G, int bid) {
    using namespace att;
    const int tid = threadIdx.x, lane = tid & 63, wid = tid >> 6, fr = lane & 15, fq = lane >> 4;
    for (int unit = bid; unit < NSEQ * 64 * 2; unit += G) {
        const int kvh = unit & 1, blk = (unit >> 1) & 63, b = unit >> 7;
        const size_t seq0 = (size_t)b * SEQ;
        const int kp0 = (blk - 1) * 128;
        __syncthreads();
#pragma unroll
        for (int it = 0; it < 6; ++it) {
            const int id = tid + 512 * it, row = id >> 3, ch = id & 7; const int kpos = kp0 + row;
            u32x4 kv = {0u, 0u, 0u, 0u}, vv = {0u, 0u, 0u, 0u};
            if (kpos >= 0 && kpos < SEQ) { const size_t off = (seq0 + kpos) * 128 + kvh * 64 + ch * 8; kv = *(const u32x4*)(K + off); vv = *(const u32x4*)(V + off); }
            *(LAS u32x4*)(lds + K_OFF + row * KSTR + ch * 16) = kv;
            LAS unsigned short* vt = (LAS unsigned short*)(lds + V_OFF + (ch * 8) * VSTR + row * 2);
            vt[0 * (VSTR / 2)] = (unsigned short)(vv.x & 0xffffu); vt[1 * (VSTR / 2)] = (unsigned short)(vv.x >> 16);
            vt[2 * (VSTR / 2)] = (unsigned short)(vv.y & 0xffffu); vt[3 * (VSTR / 2)] = (unsigned short)(vv.y >> 16);
            vt[4 * (VSTR / 2)] = (unsigned short)(vv.z & 0xffffu); vt[5 * (VSTR / 2)] = (unsigned short)(vv.z >> 16);
            vt[6 * (VSTR / 2)] = (unsigned short)(vv.w & 0xffffu); vt[7 * (VSTR / 2)] = (unsigned short)(vv.w >> 16);
        }
        __syncthreads();
        const int qg = __builtin_amdgcn_readfirstlane(wid);
        const int r = qg * 16 + fr;
        const size_t qrow = seq0 + (size_t)blk * 128 + r;
        const bool edge = (blk == 0) || (blk == 63);
#pragma unroll 1
        for (int h4 = 0; h4 < 4; ++h4) {
            const int head = kvh * 4 + h4;
            const bf16x8 qf0 = *(const bf16x8*)(Q + qrow * 512 + head * 64 + fq * 8);
            const bf16x8 qf1 = *(const bf16x8*)(Q + qrow * 512 + head * 64 + 32 + fq * 8);
            f32x4 s[17];
            int lofs = 0; asm volatile("" : "+v"(lofs));
            const LAS unsigned char* kb = lds + K_OFF + (qg * 16 + fr) * KSTR + fq * 16 + lofs;
#pragma unroll
            for (int t = 0; t < 17; ++t) {
                const bf16x8 k0 = *(const LAS bf16x8*)(kb + t * 16 * KSTR), k1 = *(const LAS bf16x8*)(kb + t * 16 * KSTR + 64);
                f32x4 c = {0.f, 0.f, 0.f, 0.f};
                c = __builtin_amdgcn_mfma_f32_16x16x32_bf16(k0, qf0, c, 0, 0, 0);
                c = __builtin_amdgcn_mfma_f32_16x16x32_bf16(k1, qf1, c, 0, 0, 0);
                s[t] = c;
            }
#pragma unroll
            for (int e = 0; e < 4; ++e) { if (fq * 4 + e < fr) s[0][e] = -1e30f; if (fq * 4 + e > fr) s[16][e] = -1e30f; }
            if (edge) {
#pragma unroll
                for (int t = 0; t < 17; ++t) { const int jt = qg + t; if ((blk == 0 && jt < 8) || (blk == 63 && jt >= 16)) s[t] = (f32x4){-1e30f, -1e30f, -1e30f, -1e30f}; }
            }
            const float skl = sink[head] * LOG2E;
            float mx = skl;
#pragma unroll
            for (int t = 0; t < 17; ++t) mx = fmaxf(mx, fmaxf(fmaxf(s[t][0], s[t][1]), fmaxf(s[t][2], s[t][3])));
            mx = fmaxf(mx, __shfl_xor(mx, 16)); mx = fmaxf(mx, __shfl_xor(mx, 32));
            f32x4 lv = {0.f, 0.f, 0.f, 0.f};
#pragma unroll
            for (int t = 0; t < 17; ++t) { const f32x4 d = s[t] - mx; f32x4 p;
                p[0] = __builtin_amdgcn_exp2f(d[0]); p[1] = __builtin_amdgcn_exp2f(d[1]); p[2] = __builtin_amdgcn_exp2f(d[2]); p[3] = __builtin_amdgcn_exp2f(d[3]);
                s[t] = p; lv += p; }
            float l = (lv[0] + lv[1]) + (lv[2] + lv[3]);
            l += __shfl_xor(l, 16); l += __shfl_xor(l, 32);
            l += __builtin_amdgcn_exp2f(skl - mx);
            const float inv = 1.0f / l;
            f32x4 o[4];
#pragma unroll
            for (int dt = 0; dt < 4; ++dt) o[dt] = (f32x4){0.f, 0.f, 0.f, 0.f};
#pragma unroll
            for (int pp = 0; pp < 8; ++pp) {
                u32x4 pw; pw.x = cvt_pk_bf16(s[2 * pp][0], s[2 * pp][1]); pw.y = cvt_pk_bf16(s[2 * pp][2], s[2 * pp][3]);
                pw.z = cvt_pk_bf16(s[2 * pp + 1][0], s[2 * pp + 1][1]); pw.w = cvt_pk_bf16(s[2 * pp + 1][2], s[2 * pp + 1][3]);
                const bf16x8 pf = __builtin_bit_cast(bf16x8, pw);
#pragma unroll
                for (int dt = 0; dt < 4; ++dt) {
                    const LAS unsigned char* vb = lds + V_OFF + (dt * 16 + fr) * VSTR + ((qg + 2 * pp) * 16 + fq * 4) * 2 + lofs;
                    const u32x2 va = *(const LAS u32x2*)vb, vc = *(const LAS u32x2*)(vb + 32);
                    u32x4 vw; vw.x = va.x; vw.y = va.y; vw.z = vc.x; vw.w = vc.y;
                    o[dt] = __builtin_amdgcn_mfma_f32_16x16x32_bf16(__builtin_bit_cast(bf16x8, vw), pf, o[dt], 0, 0, 0);
                }
            }
            {
                u32x2 pw; pw.x = cvt_pk_bf16(s[16][0], s[16][1]); pw.y = cvt_pk_bf16(s[16][2], s[16][3]);
                const s16x4 pf = __builtin_bit_cast(s16x4, pw);
#pragma unroll
                for (int dt = 0; dt < 4; ++dt) {
                    const LAS unsigned char* vb = lds + V_OFF + (dt * 16 + fr) * VSTR + ((qg + 16) * 16 + fq * 4) * 2 + lofs;
                    const u32x2 va = *(const LAS u32x2*)vb;
                    o[dt] = __builtin_amdgcn_mfma_f32_16x16x16bf16_1k(__builtin_bit_cast(s16x4, va), pf, o[dt], 0, 0, 0);
                }
            }
            bf16_t* op = O + blk_off((int)qrow, head * 64 + fq * 4, 16);
#pragma unroll
            for (int dt = 0; dt < 4; ++dt) { u32x2 w; w.x = cvt_pk_bf16(o[dt][0] * inv, o[dt][1] * inv); w.y = cvt_pk_bf16(o[dt][2] * inv, o[dt][3] * inv); *(u32x2*)(op + dt * 16) = w; }
        }
    }
}
__device__ __forceinline__ void pool_phase(LAS unsigned char* lds, const bf16_t* U, bf16_t* P, int G, int bid) {
    constexpr int RS = 1040;
    const int tid = threadIdx.x, c = tid & 63, sub = tid >> 6, g = c >> 4, hw = 1 << g;
    for (int unit = bid; unit < NSEQ * 128; unit += G) {
        const int b = unit >> 7, s0 = (unit & 127) * 64; const size_t seqrow = (size_t)b * SEQ;
        __syncthreads();
#pragma unroll
        for (int it = 0; it < 10; ++it) { const int id = tid + 512 * it, row = id >> 6, ch = id & 63, sp = s0 - 8 + row;
            u32x4 v = {0u, 0u, 0u, 0u}; if (sp >= 0 && sp < SEQ) v = *(const u32x4*)(U + (seqrow + sp) * 512 + ch * 8);
            *(LAS u32x4*)(lds + row * RS + ch * 16) = v; }
        __syncthreads();
        const int rbase = sub * 8 + 8;
        const LAS unsigned char* col = lds + c * 16;
        float S[8];
#pragma unroll
        for (int e = 0; e < 8; ++e) S[e] = 0.f;
#pragma unroll
        for (int k = 0; k < 16; ++k) if (k < 2 * hw) { const u32x4 w = *(const LAS u32x4*)(col + (rbase - hw + k) * RS);
            S[0] += bf_lo(w.x); S[1] += bf_hi(w.x); S[2] += bf_lo(w.y); S[3] += bf_hi(w.y); S[4] += bf_lo(w.z); S[5] += bf_hi(w.z); S[6] += bf_lo(w.w); S[7] += bf_hi(w.w); }
#pragma unroll
        for (int k = 0; k < 8; ++k) { const int sp = s0 + sub * 8 + k; const int lo = (sp - hw) < 0 ? 0 : (sp - hw), hi = (sp + hw) > SEQ ? SEQ : (sp + hw);
            const float ic = 1.0f / (float)(hi - lo);
            const u32x4 w = *(const LAS u32x4*)(col + (rbase + k) * RS);
            u32x4 o; o.x = cvt_pk_bf16(S[0] * ic - bf_lo(w.x), S[1] * ic - bf_hi(w.x)); o.y = cvt_pk_bf16(S[2] * ic - bf_lo(w.y), S[3] * ic - bf_hi(w.y));
            o.z = cvt_pk_bf16(S[4] * ic - bf_lo(w.z), S[5] * ic - bf_hi(w.z)); o.w = cvt_pk_bf16(S[6] * ic - bf_lo(w.w), S[7] * ic - bf_hi(w.w));
            *(u32x4*)(P + blk_off((int)(seqrow + sp), 512 + c * 8, 16)) = o;
            if (k < 7) { const u32x4 wa = *(const LAS u32x4*)(col + (rbase + k + hw) * RS), wd = *(const LAS u32x4*)(col + (rbase + k - hw) * RS);
                S[0] += bf_lo(wa.x) - bf_lo(wd.x); S[1] += bf_hi(wa.x) - bf_hi(wd.x); S[2] += bf_lo(wa.y) - bf_lo(wd.y); S[3] += bf_hi(wa.y) - bf_hi(wd.y);
                S[4] += bf_lo(wa.z) - bf_lo(wd.z); S[5] += bf_hi(wa.z) - bf_hi(wd.z); S[6] += bf_lo(wa.w) - bf_lo(wd.w); S[7] += bf_hi(wa.w) - bf_hi(wd.w); }
        }
    }
}

__global__ void __launch_bounds__(512, 2) mega_fwd(Args a) {
    extern __shared__ __attribute__((aligned(16))) unsigned char lds_raw[];
    LAS unsigned char* lds = (LAS unsigned char*)lds_raw;
    const int G = gridDim.x, bid = blockIdx.x;
    unsigned char* ws = a.ws;
#define IN(k) (a.ph_lo <= (k) && (k) < a.ph_hi)
    volatile LAS unsigned* bst = (volatile LAS unsigned*)(lds + 131072);
    if (threadIdx.x < 4) bst[threadIdx.x] = (threadIdx.x == 3) ? (unsigned)blockIdx.x : 0u;
    __syncthreads();
    XcdBarrier xbar = xcd_barrier_post((unsigned*)(ws + WS_CTL), bst);
    if (a.ph_hi > 1000) cg::this_grid().sync();
#define SEAM(k) do { if (IN(k) && IN((k) + 1)) { xcd_barrier(xbar); } } while (0)
    typedef pg8::StaticOrder SO;
    bf16_t* H = (bf16_t*)(ws + WS_H); bf16_t* Y = (bf16_t*)(ws + WS_Y); bf16_t* ACT = (bf16_t*)(ws + WS_BIG); bf16_t* X1 = (bf16_t*)a.out;

    if (IN(0)) mod_phase(lds, a, G, bid);
    SEAM(0);
    if (IN(0) && IN(1)) {
        if (threadIdx.x == 0) { unsigned* bar = (unsigned*)(ws + WS_CTL); bool ok = (G % 8) == 0;
            for (unsigned jx = 0; jx < 16; ++jx) { const unsigned cx = xb_ld(&bar[XB_XCNT(jx)]); ok = ok && (jx < 8 ? cx == (unsigned)(G / 8) : cx == 0u); }
            if (ok) bst[3] = bst[2] * 8u + xbar.x; }
        __syncthreads();
    }
#define VCU() __builtin_amdgcn_readfirstlane((int)bst[3])
    if (IN(1)) { prep_phase(lds, a, G, bid); norm_phase<0, true>(a, 0, 0.f, G, bid, nullptr, nullptr, nullptr); }
    SEAM(1);
    if (IN(2)) for (int rep = 0; rep < MK_GEMM_REP; ++rep) { pg8::Gemm g{H, (const bf16_t*)(ws + WS_W1GU), T, 2 * FF, D}; SO S; S.init(T, 2 * FF, G, VCU()); pg8::EpiSwiGLU E{ACT, FF};
        pg8::gemm_phase<pg8::EpiSwiGLU, SO, true, true>(lds, g, S, E); }
    SEAM(2);
    if (IN(3)) for (int rep = 0; rep < MK_GEMM_REP; ++rep) { pg8::Gemm g{ACT, (const bf16_t*)(ws + WS_W1D), T, D, FF}; SO S; S.init(T, D, G, VCU()); pg8::EpiBf16 E{Y, D};
        pg8::gemm_phase<pg8::EpiBf16, SO, true, true>(lds, g, S, E); }
    SEAM(3);
    if (IN(4)) norm_phase<1, true>(a, 0, 0.5f, G, bid, nullptr, Y, X1);
    SEAM(4);
    if (IN(5)) for (int rep = 0; rep < MK_GEMM_REP; ++rep) { pg8::Gemm g{H, (const bf16_t*)(ws + WS_WIN), T, NIN, D}; SO S; S.init(T, NIN, G, VCU());
        pg8::EpiProj E{(bf16_t*)(ws + WS_Q), (bf16_t*)(ws + WS_K), (bf16_t*)(ws + WS_V), (bf16_t*)(ws + WS_U), (bf16_t*)(ws + WS_GA), (bf16_t*)(ws + WS_GB), (const float*)(ws + WS_CT), (const float*)(ws + WS_ST)};
        pg8::gemm_phase<pg8::EpiProj, SO, true, true>(lds, g, S, E); }
    SEAM(5);
    if (IN(6)) {
        attn_phase(lds, (const bf16_t*)(ws + WS_Q), (const bf16_t*)(ws + WS_K), (const bf16_t*)(ws + WS_V), Y, a.in[I_SINK], G, bid);
        pool_phase(lds, (const bf16_t*)(ws + WS_U), Y, G, bid);
        __syncthreads();
        if (MK_DUP == 6) {
            attn_phase(lds, (const bf16_t*)(ws + WS_Q), (const bf16_t*)(ws + WS_K), (const bf16_t*)(ws + WS_V), Y, a.in[I_SINK], G, bid);
            pool_phase(lds, (const bf16_t*)(ws + WS_U), Y, G, bid);
            __syncthreads();
        }
    }
    SEAM(6);
    if (IN(7)) for (int rep = 0; rep < MK_GEMM_REP; ++rep) { pg8::Gemm g{Y, (const bf16_t*)(ws + WS_WAB), T, D, D}; SO S; S.init(T, D, G, VCU());
        pg8::EpiMerge E{H, (const bf16_t*)(ws + WS_GA), (const bf16_t*)(ws + WS_GB)};
        pg8::gemm_phase<pg8::EpiMerge, SO, true, true>(lds, g, S, E); }
    SEAM(7);
    if (IN(8)) for (int rep = 0; rep < MK_GEMM_REP; ++rep) { pg8::Gemm g{H, (const bf16_t*)(ws + WS_WOUT), T, D, D}; SO S; S.init(T, D, G, VCU()); pg8::EpiBf16 E{Y, D};
        pg8::gemm_phase<pg8::EpiBf16, SO, true, true>(lds, g, S, E); }
    SEAM(8);
    if (IN(9)) norm_phase<1, false>(a, 1, 1.0f, G, bid, X1, Y, Y);
    SEAM(9);
    if (IN(10)) for (int rep = 0; rep < MK_GEMM_REP; ++rep) { pg8::Gemm g{H, (const bf16_t*)(ws + WS_W2GU), T, 2 * FF, D}; SO S; S.init(T, 2 * FF, G, VCU()); pg8::EpiSwiGLU E{ACT, FF};
        pg8::gemm_phase<pg8::EpiSwiGLU, SO, true, true>(lds, g, S, E); }
    SEAM(10);
    if (IN(11)) for (int rep = 0; rep < MK_GEMM_REP; ++rep) { pg8::Gemm g{ACT, (const bf16_t*)(ws + WS_W2D), T, D, FF}; SO S; S.init(T, D, G, VCU()); pg8::EpiBf16 E{H, D};
        pg8::gemm_phase<pg8::EpiBf16, SO, true, true>(lds, g, S, E); }
    SEAM(11);
    if (IN(12)) norm_phase<2, false>(a, 2, 0.5f, G, bid, Y, H, nullptr);
#undef IN
#undef SEAM
}

__global__ void chk_kernel(const unsigned* p, size_t nwords, unsigned long long* dst) {
    unsigned long long s = 0;
    for (size_t i = (size_t)blockIdx.x * blockDim.x + threadIdx.x; i < nwords; i += (size_t)gridDim.x * blockDim.x) s += p[i];
    atomicAdd(dst, s);
}
__global__ void verdict_kernel(const unsigned long long* chk, float* out, size_t n) {
    int code = 0;
    for (int p = 0; p < 6; ++p) if (chk[p] != chk[16 + p]) code |= 1 << p;
    for (size_t i = (size_t)blockIdx.x * blockDim.x + threadIdx.x; i < n; i += (size_t)gridDim.x * blockDim.x) out[i] = (float)code;
}
constexpr int NPHASE = 13;
extern "C" void kernel_launch(void* const* d_in, const int* in_sizes, int n_in, void* d_out, int out_size, void* d_ws, size_t ws_size, hipStream_t stream) {
    static int grid = 0;
    if (grid == 0) {
        if (n_in != 21 || out_size != T * D || ws_size < WS_END) { fprintf(stderr, "kernel_launch: unexpected shapes: n_in %d out %d ws %zu (need %zu)\n", n_in, out_size, ws_size, (size_t)WS_END); grid = -1; return; }
        int dev = 0, cus = 0, per_cu = 0;
        if (hipGetDevice(&dev) != hipSuccess || hipDeviceGetAttribute(&cus, hipDeviceAttributeMultiprocessorCount, dev) != hipSuccess) { grid = -1; return; }
        if (hipFuncSetAttribute((const void*)mega_fwd, hipFuncAttributeMaxDynamicSharedMemorySize, LDS_BYTES) != hipSuccess) { fprintf(stderr, "kernel_launch: hipFuncSetAttribute failed\n"); grid = -1; return; }
        if (hipOccupancyMaxActiveBlocksPerMultiprocessor(&per_cu, (const void*)mega_fwd, 512, LDS_BYTES) != hipSuccess || per_cu < 1) { fprintf(stderr, "kernel_launch: occupancy query says %d\n", per_cu); per_cu = 1; }
        (void)hipGetLastError();
        grid = cus * 1;
    }
    if (grid < 0) return;
    (void)hipMemsetAsync((unsigned char*)d_ws + WS_CTL, 0, CTL_BYTES, stream);
    Args a{};
    for (int i = 0; i < 21; ++i) a.in[i] = (const float*)d_in[i];
    a.out = (float*)d_out; a.ws = (unsigned char*)d_ws;
#if MK_MULTI_LAUNCH == 2
    {
        unsigned char* ws = (unsigned char*)d_ws; unsigned long long* chk = (unsigned long long*)(ws + 900 * MiB);
        (void)hipMemsetAsync(chk, 0, 4096, stream);
        const size_t offs[7] = {WS_Q, WS_K, WS_V, WS_U, WS_GA, WS_GB, WS_END};
        for (int run = 0; run < 2; ++run) {
            for (int p = 0; p < 6; ++p) { a.ph_lo = p; a.ph_hi = p + 1; hipLaunchKernelGGL(mega_fwd, dim3(grid), dim3(512), LDS_BYTES, stream, a); }
            for (int i = 0; i < 6; ++i) hipLaunchKernelGGL(chk_kernel, dim3(2048), dim3(256), 0, stream, (const unsigned*)(ws + offs[i]), (offs[i + 1] - offs[i]) / 4, chk + run * 16 + i);
        }
        hipLaunchKernelGGL(verdict_kernel, dim3(2048), dim3(256), 0, stream, (const unsigned long long*)chk, (float*)d_out, (size_t)T * D);
    }
#elif MK_MULTI_LAUNCH
    for (int p = 0; p < NPHASE; ++p) { const bool is_gemm = (p == 2 || p == 3 || p == 5 || p == 7 || p == 8 || p == 10 || p == 11);
        const int reps = (MK_MULTI_LAUNCH == 3 && is_gemm) ? 2 : ((MK_MULTI_LAUNCH == 4 && !is_gemm && p != 9 && p != 12) ? 2 : 1);
        for (int rep = 0; rep < reps; ++rep) { a.ph_lo = p; a.ph_hi = p + 1; hipLaunchKernelGGL(mega_fwd, dim3(grid), dim3(512), LDS_BYTES, stream, a); } }
#else
    a.ph_lo = 0; a.ph_hi = NPHASE;
    void* args[] = {&a};
    hipError_t e = hipLaunchCooperativeKernel((const void*)mega_fwd, dim3(grid), dim3(512), args, LDS_BYTES, stream);
    if (e != hipSuccess) fprintf(stderr, "kernel_launch: cooperative launch failed: %s (grid %d)\n", hipGetErrorString(e), grid);
#endif
}
```

```cpp
#include <hip/hip_runtime.h>
#include <hip/hip_cooperative_groups.h>
#include <cstdio>
#include <cstdint>
namespace cg = cooperative_groups;

#ifndef MK_MULTI_LAUNCH
#define MK_MULTI_LAUNCH 0
#endif
#ifndef MK_GEMM_REP
#define MK_GEMM_REP 1
#endif
#ifndef MK_DUP
#define MK_DUP -1
#endif

#define LAS __attribute__((address_space(3)))
typedef unsigned short bf16_t;
typedef short bf16x8 __attribute__((ext_vector_type(8)));
typedef float f32x4 __attribute__((ext_vector_type(4)));
typedef float f32x2 __attribute__((ext_vector_type(2)));
typedef unsigned u32x4 __attribute__((ext_vector_type(4)));
typedef unsigned u32x2 __attribute__((ext_vector_type(2)));
typedef short s16x4 __attribute__((ext_vector_type(4)));

constexpr int D = 1024, SEQ = 8192, NSEQ = 10, NPROMPT = 8, T = NSEQ * SEQ, FF = 2816, NIN = 3328;
constexpr int NMOD = 9 * D;
constexpr float EPS = 1e-6f;
constexpr float LOG2E = 1.4426950408889634f;

constexpr size_t MiB = 1u << 20;
constexpr size_t WS_MOD = 0;
constexpr size_t WS_CTL = 384 * 1024, CTL_BYTES = 16 * 1024;
constexpr size_t WS_CT = 1 * MiB, WS_ST = 2 * MiB;
constexpr size_t WS_W1GU = 3 * MiB;
constexpr size_t WS_W1D = 14 * MiB;
constexpr size_t WS_W2GU = 20 * MiB;
constexpr size_t WS_W2D = 31 * MiB;
constexpr size_t WS_WIN = 37 * MiB;
constexpr size_t WS_WAB = 44 * MiB;
constexpr size_t WS_WPB = 45 * MiB;
constexpr size_t WS_WOUT = 46 * MiB;
constexpr size_t WS_H = 48 * MiB;
constexpr size_t WS_Y = 208 * MiB;
constexpr size_t WS_BIG = 368 * MiB;
constexpr size_t WS_Q = WS_BIG, WS_K = WS_Q + 80 * MiB, WS_V = WS_K + 20 * MiB, WS_U = WS_V + 20 * MiB, WS_GA = WS_U + 80 * MiB, WS_GB = WS_GA + 160 * MiB;
constexpr size_t WS_END = WS_GB + 160 * MiB;
static_assert((size_t)T * D * 2 == 160 * MiB && (size_t)T * FF * 2 == 440 * MiB && (size_t)T * 512 * 2 == 80 * MiB && (size_t)T * 128 * 2 == 20 * MiB, "ws map");

constexpr int LDS_BYTES = 135168;

typedef __bf16 bf16x2v __attribute__((ext_vector_type(2)));
__device__ __forceinline__ unsigned cvt_pk_bf16(float lo, float hi) { const f32x2 v = {lo, hi}; return __builtin_bit_cast(unsigned, __builtin_convertvector(v, bf16x2v)); }
__device__ __forceinline__ float bf_lo(unsigned w) { return __builtin_bit_cast(float, w << 16); }
__device__ __forceinline__ float bf_hi(unsigned w) { return __builtin_bit_cast(float, w & 0xffff0000u); }
__device__ __forceinline__ float fast_sigmoid(float x) { return __builtin_amdgcn_rcpf(1.0f + __builtin_amdgcn_exp2f(-x * LOG2E)); }
__device__ __forceinline__ float fast_silu(float x) { return x * fast_sigmoid(x); }
__device__ __forceinline__ f32x2 sigmoid2(f32x2 x) { const f32x2 t = x * (-LOG2E); f32x2 e; e.x = __builtin_amdgcn_exp2f(t.x); e.y = __builtin_amdgcn_exp2f(t.y);
    const f32x2 d = e + 1.0f; f32x2 r; r.x = __builtin_amdgcn_rcpf(d.x); r.y = __builtin_amdgcn_rcpf(d.y); return r; }
__device__ __forceinline__ unsigned swiglu_pk(float g0, float g1, float u0, float u1) { const f32x2 g = {g0, g1}, u = {u0, u1}; const f32x2 o = (g * u) * sigmoid2(g); return cvt_pk_bf16(o.x, o.y); }
__device__ __forceinline__ unsigned sigmoid_pk(float a, float b) { const f32x2 r = sigmoid2((f32x2){a, b}); return cvt_pk_bf16(r.x, r.y); }
__device__ __forceinline__ float wave_sum(float v) {
#pragma unroll
    for (int o = 1; o < 64; o <<= 1) v += __shfl_xor(v, o);
    return v;
}
#define LDS_WAIT() asm volatile("s_waitcnt lgkmcnt(0)" ::: "memory")
__device__ __forceinline__ size_t blk_off(int row, int col, int KB) { return ((size_t)(row >> 8) * KB + (col >> 6)) * 16384 + (size_t)(((row & 255) << 6) + (col & 63)); }

namespace pg8 {
constexpr int BM = 256, BK = 64, HALF = 128, HTB = HALF * BK * 2, STAGE_BYTES = 8 * HTB, NXCD = 8, WGM = 8;
__host__ __device__ __forceinline__ int lds_byte(int r, int c) { const int st = (r >> 4) * 2 + (c >> 5), rr = r & 15, cc = c & 31, ob = rr * 64 + cc * 2; return st * 1024 + (ob ^ (((ob >> 9) & 1) << 5)); }
__host__ __device__ __forceinline__ void stage_rc(int b, int& R, int& C) { const int st = b / 1024, sb = b % 1024, swz = sb ^ (((sb >> 9) & 1) << 5); R = (st >> 1) * 16 + swz / 64; C = (st & 1) * 32 + (swz % 64) / 2; }
__host__ __device__ __forceinline__ int perm32(int rho) { const int n = rho >> 4, i = rho & 15; return 8 * (i >> 2) + 4 * n + (i & 3); }

struct Unit { int pm, pn; };
struct Gemm { const bf16_t* A; const bf16_t* Bt; int M, N, K; };

struct StaticOrder {
    int nM, nN, nwg, G, c;
    __device__ void init(int M, int N, int G_, int c_) { nM = M / BM; nN = N / BM; nwg = nM * nN; G = G_; c = c_; }
    __device__ bool next(int i, Unit& u) const {
        const long L = (long)i * G + c; if (L >= nwg) return false;
        int wgid = (int)L; { const int q = nwg / NXCD, r = nwg % NXCD, xcd = wgid % NXCD, off = wgid / NXCD; wgid = (xcd < r ? xcd * (q + 1) : r * (q + 1) + (xcd - r) * q) + off; }
        const int nig = WGM * nN, gid = wgid / nig, fm = gid * WGM, gsz = (nM - fm) < WGM ? (nM - fm) : WGM;
        u.pm = fm + ((wgid % nig) % gsz); u.pn = (wgid % nig) / gsz; return true;
    }
    __device__ __forceinline__ void a_ready(const Unit&) const {}
    __device__ __forceinline__ void done(const Unit&) const {}
};

typedef f32x4 Acc[2][2][4][2];

#define EPI_DRAIN() asm volatile("s_waitcnt vmcnt(0)" ::: "memory")
struct EpiBf16 {
    static constexpr bool PERM = true, AFTER_DRAIN = false, HAS_MID = false, SELF_DRAIN = true;
    bf16_t* O; int ldc;
    __device__ __forceinline__ void operator()(const Acc& acc, const Unit& u, int wr, int wc, int fr, int fq) const {
        const int row0 = u.pm * BM + wr * 64 + fr, col0 = u.pn * BM + wc * 32 + 8 * fq;
        u32x4 w[2][4][2];
#pragma unroll
        for (int ai = 0; ai < 2; ++ai)
#pragma unroll
            for (int m = 0; m < 4; ++m)
#pragma unroll
                for (int bj = 0; bj < 2; ++bj) { const f32x4 v0 = acc[ai][bj][m][0], v1 = acc[ai][bj][m][1];
                    w[ai][m][bj].x = cvt_pk_bf16(v0[0], v0[1]); w[ai][m][bj].y = cvt_pk_bf16(v0[2], v0[3]); w[ai][m][bj].z = cvt_pk_bf16(v1[0], v1[1]); w[ai][m][bj].w = cvt_pk_bf16(v1[2], v1[3]);
                    asm volatile("" :: "v"(w[ai][m][bj])); }
        EPI_DRAIN();
#pragma unroll
        for (int ai = 0; ai < 2; ++ai)
#pragma unroll
            for (int m = 0; m < 4; ++m) { bf16_t* rowp = O + (size_t)(row0 + ai * HALF + m * 16) * ldc + col0;
#pragma unroll
                for (int bj = 0; bj < 2; ++bj) *(u32x4*)(rowp + bj * HALF) = w[ai][m][bj]; }
    }
};

struct EpiSwiGLU {
    static constexpr bool PERM = true, AFTER_DRAIN = false, HAS_MID = false, SELF_DRAIN = true;
    bf16_t* O; int ldc;
    __device__ __forceinline__ void operator()(const Acc& acc, const Unit& u, int wr, int wc, int fr, int fq) const {
        const int row0 = u.pm * BM + wr * 64 + fr, col0 = u.pn * HALF + wc * 32 + 8 * fq;
        u32x4 w[2][4];
#pragma unroll
        for (int ai = 0; ai < 2; ++ai)
#pragma unroll
            for (int m = 0; m < 4; ++m) {
                const f32x4 g0 = acc[ai][0][m][0], g1 = acc[ai][0][m][1], u0 = acc[ai][1][m][0], u1 = acc[ai][1][m][1];
                w[ai][m].x = swiglu_pk(g0[0], g0[1], u0[0], u0[1]); w[ai][m].y = swiglu_pk(g0[2], g0[3], u0[2], u0[3]);
                w[ai][m].z = swiglu_pk(g1[0], g1[1], u1[0], u1[1]); w[ai][m].w = swiglu_pk(g1[2], g1[3], u1[2], u1[3]);
                asm volatile("" :: "v"(w[ai][m])); }
        EPI_DRAIN();
#pragma unroll
        for (int ai = 0; ai < 2; ++ai)
#pragma unroll
            for (int m = 0; m < 4; ++m) *(u32x4*)(O + blk_off(row0 + ai * HALF + m * 16, col0, ldc / 64)) = w[ai][m];
    }
};

struct EpiProj {
    static constexpr bool PERM = true, AFTER_DRAIN = false, HAS_MID = false, SELF_DRAIN = false;
    bf16_t *Q, *K, *V, *U, *GA, *GB; const float *ct, *st;
    __device__ __forceinline__ void rope_store(const Acc& acc, int row0, bf16_t* base, int ld, int colbase, int fq, float sc) const {
#pragma unroll
        for (int ai = 0; ai < 2; ++ai)
#pragma unroll
            for (int m = 0; m < 4; ++m) { const int row = row0 + ai * HALF + m * 16; const int pos = row & (SEQ - 1);
                const float* cp = ct + pos * 32 + 8 * fq; const float* sp = st + pos * 32 + 8 * fq;
                const f32x4 c0 = *(const f32x4*)cp, c1 = *(const f32x4*)(cp + 4), s0 = *(const f32x4*)sp, s1 = *(const f32x4*)(sp + 4);
                const f32x4 a0 = acc[ai][0][m][0] * sc, a1 = acc[ai][0][m][1] * sc, b0 = acc[ai][1][m][0] * sc, b1 = acc[ai][1][m][1] * sc;
                const f32x4 lo0 = a0 * c0 - b0 * s0, lo1 = a1 * c1 - b1 * s1, hi0 = b0 * c0 + a0 * s0, hi1 = b1 * c1 + a1 * s1;
                bf16_t* p = base + (size_t)row * ld + colbase + 8 * fq;
                u32x4 w; w.x = cvt_pk_bf16(lo0[0], lo0[1]); w.y = cvt_pk_bf16(lo0[2], lo0[3]); w.z = cvt_pk_bf16(lo1[0], lo1[1]); w.w = cvt_pk_bf16(lo1[2], lo1[3]);
                *(u32x4*)p = w;
                w.x = cvt_pk_bf16(hi0[0], hi0[1]); w.y = cvt_pk_bf16(hi0[2], hi0[3]); w.z = cvt_pk_bf16(hi1[0], hi1[1]); w.w = cvt_pk_bf16(hi1[2], hi1[3]);
                *(u32x4*)(p + 32) = w;
                if (m & 1) asm volatile("" ::: "memory"); }
    }
    template <int ACT> __device__ __forceinline__ void plain_store(const Acc& acc, int row0, bf16_t* base, int ld, int col0) const {
#pragma unroll
        for (int ai = 0; ai < 2; ++ai)
#pragma unroll
            for (int m = 0; m < 4; ++m) { bf16_t* rowp = base + (size_t)(row0 + ai * HALF + m * 16) * ld + col0;
#pragma unroll
                for (int bj = 0; bj < 2; ++bj) { const f32x4 v0 = acc[ai][bj][m][0], v1 = acc[ai][bj][m][1];
                    u32x4 w;
                    if (ACT == 1) { w.x = sigmoid_pk(v0[0], v0[1]); w.y = sigmoid_pk(v0[2], v0[3]); w.z = sigmoid_pk(v1[0], v1[1]); w.w = sigmoid_pk(v1[2], v1[3]); }
                    else { w.x = cvt_pk_bf16(v0[0], v0[1]); w.y = cvt_pk_bf16(v0[2], v0[3]); w.z = cvt_pk_bf16(v1[0], v1[1]); w.w = cvt_pk_bf16(v1[2], v1[3]); }
                    *(u32x4*)(rowp + bj * HALF) = w; }
                asm volatile("" ::: "memory"); }
    }
    __device__ __forceinline__ void operator()(const Acc& acc, const Unit& u, int wr, int wc, int fr, int fq) const {
        int row0 = u.pm * BM + wr * 64 + fr; const int pn = u.pn;
#define OPAQUE_ROW() asm volatile("" : "+v"(row0))
        if (pn < 2) { OPAQUE_ROW(); rope_store(acc, row0, Q, 512, (4 * pn + wc) * 64, fq, 0.125f * LOG2E); }
        else if (pn == 2) {
            if (wc < 2) { OPAQUE_ROW(); rope_store(acc, row0, K, 128, wc * 64, fq, 1.0f); }
            else { OPAQUE_ROW();
#pragma unroll
                for (int ai = 0; ai < 2; ++ai)
#pragma unroll
                    for (int m = 0; m < 4; ++m) { bf16_t* rowp = V + (size_t)(row0 + ai * HALF + m * 16) * 128 + (wc - 2) * 32 + 8 * fq;
#pragma unroll
                        for (int bj = 0; bj < 2; ++bj) { const f32x4 v0 = acc[ai][bj][m][0], v1 = acc[ai][bj][m][1];
                            u32x4 w; w.x = cvt_pk_bf16(v0[0], v0[1]); w.y = cvt_pk_bf16(v0[2], v0[3]); w.z = cvt_pk_bf16(v1[0], v1[1]); w.w = cvt_pk_bf16(v1[2], v1[3]);
                            *(u32x4*)(rowp + bj * 64) = w; } }
            }
        }
        else if (pn < 5) { OPAQUE_ROW(); plain_store<0>(acc, row0, U, 512, (pn - 3) * BM + wc * 32 + 8 * fq); }
        else { OPAQUE_ROW(); bf16_t* gbase = pn < 9 ? GA : GB; const int gt = pn < 9 ? pn - 5 : pn - 9; plain_store<1>(acc, row0, gbase, D, gt * BM + wc * 32 + 8 * fq); }
#undef OPAQUE_ROW
    }
};

struct EpiMerge {
    static constexpr bool PERM = true, AFTER_DRAIN = false, HAS_MID = true, SELF_DRAIN = false;
    bf16_t* O; const bf16_t* Ga; const bf16_t* Gb;
    __device__ __forceinline__ void mid(Acc& acc, const Unit& u, int wr, int wc, int fr, int fq) const {
        int row0 = u.pm * BM + wr * 64 + fr, col0 = u.pn * BM + wc * 32 + 8 * fq; asm volatile("" : "+v"(row0), "+v"(col0));
#pragma unroll
        for (int ai = 0; ai < 2; ++ai)
#pragma unroll
            for (int m = 0; m < 4; ++m) { const size_t offg = (size_t)(row0 + ai * HALF + m * 16) * D + col0;
#pragma unroll
                for (int bj = 0; bj < 2; ++bj) {
                    const u32x4 a = *(const u32x4*)(Ga + offg + bj * HALF), b = *(const u32x4*)(Gb + offg + bj * HALF);
                    const float r0 = bf_lo(a.x) * __builtin_amdgcn_rcpf(fmaxf(bf_lo(b.x), 1e-30f)), r1 = bf_hi(a.x) * __builtin_amdgcn_rcpf(fmaxf(bf_hi(b.x), 1e-30f));
                    const float r2 = bf_lo(a.y) * __builtin_amdgcn_rcpf(fmaxf(bf_lo(b.y), 1e-30f)), r3 = bf_hi(a.y) * __builtin_amdgcn_rcpf(fmaxf(bf_hi(b.y), 1e-30f));
                    acc[ai][bj][m][0] = acc[ai][bj][m][0] * (f32x4){r0, r1, r2, r3};
                    const float r4 = bf_lo(a.z) * __builtin_amdgcn_rcpf(fmaxf(bf_lo(b.z), 1e-30f)), r5 = bf_hi(a.z) * __builtin_amdgcn_rcpf(fmaxf(bf_hi(b.z), 1e-30f));
                    const float r6 = bf_lo(a.w) * __builtin_amdgcn_rcpf(fmaxf(bf_lo(b.w), 1e-30f)), r7 = bf_hi(a.w) * __builtin_amdgcn_rcpf(fmaxf(bf_hi(b.w), 1e-30f));
                    acc[ai][bj][m][1] = acc[ai][bj][m][1] * (f32x4){r4, r5, r6, r7}; }
                if (m & 1) asm volatile("" ::: "memory"); }
    }
    __device__ __forceinline__ void operator()(const Acc& acc, const Unit& u, int wr, int wc, int fr, int fq) const {
        int row0 = u.pm * BM + wr * 64 + fr, col0 = u.pn * BM + wc * 32 + 8 * fq; asm volatile("" : "+v"(row0), "+v"(col0));
#pragma unroll
        for (int ai = 0; ai < 2; ++ai)
#pragma unroll
            for (int m = 0; m < 4; ++m) { const size_t offg = (size_t)(row0 + ai * HALF + m * 16) * D + col0;
#pragma unroll
                for (int bj = 0; bj < 2; ++bj) { const f32x4 v0 = acc[ai][bj][m][0], v1 = acc[ai][bj][m][1];
                    const u32x4 g = *(const u32x4*)(Gb + offg + bj * HALF);
                    const float q0 = fmaxf(bf_lo(g.x), 1e-30f), q1 = fmaxf(bf_hi(g.x), 1e-30f), q2 = fmaxf(bf_lo(g.y), 1e-30f), q3 = fmaxf(bf_hi(g.y), 1e-30f);
                    const float q4 = fmaxf(bf_lo(g.z), 1e-30f), q5 = fmaxf(bf_hi(g.z), 1e-30f), q6 = fmaxf(bf_lo(g.w), 1e-30f), q7 = fmaxf(bf_hi(g.w), 1e-30f);
                    u32x4 w; w.x = cvt_pk_bf16(v0[0] * q0, v0[1] * q1); w.y = cvt_pk_bf16(v0[2] * q2, v0[3] * q3); w.z = cvt_pk_bf16(v1[0] * q4, v1[1] * q5); w.w = cvt_pk_bf16(v1[2] * q6, v1[3] * q7);
                    *(u32x4*)(O + blk_off(row0 + ai * HALF + m * 16, col0 + bj * HALF, D / 64)) = w; }
                if (m & 1) asm volatile("" ::: "memory"); }
    }
};

template <class Epi, class Sched, bool ALIGN_EPI = false, bool SP2 = false>
__device__ __forceinline__ void gemm_phase(LAS unsigned char* lds, const Gemm g, const Sched& S, const Epi& E) {
    const int tid = threadIdx.x, wid = __builtin_amdgcn_readfirstlane(tid >> 6), lane = tid & 63, wr = wid >> 2, wc = wid & 3, fr = lane & 15, fq = lane >> 4;
    const int K = g.K, nt = K / BK;
    unsigned voffA[2], voffB[2];
#pragma unroll
    for (int i = 0; i < 2; ++i) { int R, C; stage_rc(tid * 16 + i * 8192, R, C); const int Rb = Epi::PERM ? ((R & ~31) + perm32(R & 31)) : R;
        voffA[i] = (unsigned)(R * 64 + C) * 2u; voffB[i] = (unsigned)(Rb * 64 + C) * 2u; }
    const size_t kstep = (size_t)BM * BK * 2;
    const size_t hstep = (size_t)HALF * BK * 2;
    const size_t tstep = (size_t)nt * kstep;
    const unsigned ldsw = (unsigned)wid * 1024u;
    const int aoff = lds_byte(wr * 64 + fr, fq * 8), boff = lds_byte(wc * 32 + fr, fq * 8);
#define PG8_SA(b, h) (((b) * 2 + (h)) * HTB)
#define PG8_SB(b, h) ((4 + (b) * 2 + (h)) * HTB)
#define PG8_STAGE(bufoff, gbase, voff) do { _Pragma("unroll") for (int _i = 0; _i < 2; ++_i) \
        __builtin_amdgcn_global_load_lds((const unsigned*)((const char*)(gbase) + (voff)[_i]), (LAS unsigned*)(lds + (bufoff) + ldsw + _i * 8192), 16, 0, 0); } while (0)
#define PG8_LDA(dst, b, h) do { _Pragma("unroll") for (int m = 0; m < 4; ++m) _Pragma("unroll") for (int k = 0; k < 2; ++k) dst[m][k] = *(const LAS bf16x8*)(lds + PG8_SA(b, h) + aoff + m * 2048 + k * 1024); } while (0)
#define PG8_LDB(dst, b, h) do { _Pragma("unroll") for (int n = 0; n < 2; ++n) _Pragma("unroll") for (int k = 0; k < 2; ++k) dst[n][k] = *(const LAS bf16x8*)(lds + PG8_SB(b, h) + boff + n * 2048 + k * 1024); } while (0)
#define PG8_MMA(ai, bj, At, Bt) do { __builtin_amdgcn_s_setprio(1); _Pragma("unroll") for (int m = 0; m < 4; ++m) _Pragma("unroll") for (int n = 0; n < 2; ++n) _Pragma("unroll") for (int k = 0; k < 2; ++k) \
        acc[ai][bj][m][n] = __builtin_amdgcn_mfma_f32_16x16x32_bf16(Bt[n][k], At[m][k], acc[ai][bj][m][n], 0, 0, 0); __builtin_amdgcn_s_setprio(0); } while (0)
#define PG8_WAIT_V(n) asm volatile("s_waitcnt vmcnt(" #n ")" ::: "memory")
#define PG8_WAIT_V8_UNLESS(f) asm volatile("s_cmp_lg_u32 %0, 0\n\ts_cbranch_scc1 .Lpg8skip%=\n\ts_waitcnt vmcnt(8)\n.Lpg8skip%=:" :: "s"(f) : "scc", "memory")
#define PG8_WAIT_L(n) asm volatile("s_waitcnt lgkmcnt(" #n ")" ::: "memory")
#define PG8_BAR __builtin_amdgcn_s_barrier()
#define PG8_SCHED __builtin_amdgcn_sched_barrier(0)
    Unit cur, nxt; int ui = 0;
    if (!S.next(0, cur)) return;
    f32x4 acc[2][2][4][2];
#pragma unroll
    for (int a = 0; a < 2; ++a)
#pragma unroll
        for (int b = 0; b < 2; ++b)
#pragma unroll
            for (int m = 0; m < 4; ++m)
#pragma unroll
                for (int n = 0; n < 2; ++n) acc[a][b][m][n] = (f32x4){0.f, 0.f, 0.f, 0.f};
    bf16x8 At[4][2], B0[2][2], B1[2][2];
    const char* cA = (const char*)g.A + (size_t)cur.pm * tstep; const char* cB = (const char*)g.Bt + (size_t)cur.pn * tstep;
    S.a_ready(cur);
    if constexpr (SP2) {
        PG8_STAGE(PG8_SB(0, 0), cB, voffB); PG8_STAGE(PG8_SB(0, 1), cB + hstep, voffB); PG8_STAGE(PG8_SA(0, 0), cA, voffA); PG8_STAGE(PG8_SA(0, 1), cA + hstep, voffA);
        if (wr == 1) PG8_BAR;
        PG8_WAIT_V(2); PG8_BAR;
        PG8_STAGE(PG8_SB(1, 0), cB + kstep, voffB); PG8_STAGE(PG8_SA(1, 0), cA + kstep, voffA); PG8_STAGE(PG8_SB(1, 1), cB + hstep + kstep, voffB);
        PG8_WAIT_V(6); PG8_BAR;
    } else {
        PG8_STAGE(PG8_SB(0, 0), cB, voffB); PG8_STAGE(PG8_SA(0, 0), cA, voffA); PG8_STAGE(PG8_SB(0, 1), cB + hstep, voffB); PG8_STAGE(PG8_SA(0, 1), cA + hstep, voffA);
        if (wr == 1) PG8_BAR;
        PG8_WAIT_V(4); PG8_BAR;
        PG8_STAGE(PG8_SB(1, 0), cB + kstep, voffB); PG8_STAGE(PG8_SA(1, 0), cA + kstep, voffA); PG8_STAGE(PG8_SB(1, 1), cB + hstep + kstep, voffB);
        PG8_WAIT_V(6); PG8_BAR;
    }
    for (;;) {
        const bool has_next = S.next(ui + 1, nxt);
        const char* nA = has_next ? (const char*)g.A + (size_t)nxt.pm * tstep : cA; const char* nB = has_next ? (const char*)g.Bt + (size_t)nxt.pn * tstep : cB;
        for (int t = 0; t < nt; t += 2) {
            const bool last = (t == nt - 2);
            const char* a1 = cA + (size_t)(t + 1) * kstep;
            const char* a2 = last ? nA : cA + (size_t)(t + 2) * kstep; const char* b2 = last ? nB : cB + (size_t)(t + 2) * kstep;
            const char* a3 = a2 + kstep; const char* b3 = b2 + kstep;
            if (last && has_next) S.a_ready(nxt);
            if constexpr (SP2) {
            if constexpr (Epi::HAS_MID) { if (t == nt / 2) E.mid(acc, cur, wr, wc, fr, fq); }
            const int fresh = __builtin_amdgcn_readfirstlane(((t == 0) && (ui > 0)) ? 1 : 0);
            PG8_LDB(B0, 0, 0); PG8_LDB(B1, 0, 1); PG8_SCHED; PG8_LDA(At, 0, 0); PG8_STAGE(PG8_SA(1, 1), a1 + hstep, voffA);
            PG8_WAIT_V8_UNLESS(fresh); PG8_WAIT_L(0); PG8_BAR; PG8_MMA(0, 0, At, B0); PG8_MMA(0, 1, At, B1); PG8_BAR; PG8_SCHED;
            PG8_LDA(At, 0, 1); PG8_STAGE(PG8_SB(0, 0), b2, voffB); PG8_STAGE(PG8_SB(0, 1), b2 + hstep, voffB); PG8_STAGE(PG8_SA(0, 0), a2, voffA);
            PG8_WAIT_V8_UNLESS(fresh); PG8_WAIT_L(0); PG8_BAR; PG8_MMA(1, 0, At, B0); PG8_MMA(1, 1, At, B1); PG8_BAR; PG8_SCHED;
            PG8_LDB(B0, 1, 0); PG8_LDB(B1, 1, 1); PG8_SCHED; PG8_LDA(At, 1, 0); PG8_STAGE(PG8_SA(0, 1), a2 + hstep, voffA);
            PG8_WAIT_V(8); PG8_WAIT_L(0); PG8_BAR; PG8_MMA(0, 0, At, B0); PG8_MMA(0, 1, At, B1); PG8_BAR; PG8_SCHED;
            PG8_LDA(At, 1, 1); PG8_STAGE(PG8_SB(1, 0), b3, voffB); PG8_STAGE(PG8_SB(1, 1), b3 + hstep, voffB); PG8_STAGE(PG8_SA(1, 0), a3, voffA);
            PG8_WAIT_V(8); PG8_WAIT_L(0); PG8_BAR; PG8_MMA(1, 0, At, B0); PG8_MMA(1, 1, At, B1); PG8_BAR; PG8_SCHED;
            } else {
            PG8_LDB(B0, 0, 0); PG8_SCHED; PG8_LDA(At, 0, 0); PG8_STAGE(PG8_SA(1, 1), a1 + hstep, voffA);
            PG8_WAIT_L(8); PG8_BAR; PG8_WAIT_L(0); PG8_MMA(0, 0, At, B0); PG8_BAR; PG8_SCHED;
            PG8_LDB(B1, 0, 1); PG8_STAGE(PG8_SB(0, 0), b2, voffB);
            PG8_BAR; PG8_WAIT_L(0); PG8_MMA(0, 1, At, B1); PG8_BAR;
            PG8_LDA(At, 0, 1); PG8_STAGE(PG8_SA(0, 0), a2, voffA);
            PG8_BAR; PG8_WAIT_L(0); PG8_MMA(1, 0, At, B0); PG8_BAR; PG8_SCHED;
            PG8_STAGE(PG8_SB(0, 1), b2 + hstep, voffB);
            PG8_WAIT_V(6); PG8_BAR; PG8_MMA(1, 1, At, B1); PG8_BAR;
            PG8_LDB(B0, 1, 0); PG8_SCHED; PG8_LDA(At, 1, 0); PG8_STAGE(PG8_SA(0, 1), a2 + hstep, voffA);
            PG8_WAIT_L(8); PG8_BAR; PG8_WAIT_L(0); PG8_MMA(0, 0, At, B0); PG8_BAR; PG8_SCHED;
            PG8_LDB(B1, 1, 1); PG8_STAGE(PG8_SB(1, 0), b3, voffB);
            PG8_BAR; PG8_WAIT_L(0); PG8_MMA(0, 1, At, B1); PG8_BAR;
            PG8_LDA(At, 1, 1); PG8_STAGE(PG8_SA(1, 0), a3, voffA);
            PG8_BAR; PG8_WAIT_L(0); PG8_MMA(1, 0, At, B0); PG8_BAR; PG8_SCHED;
            PG8_STAGE(PG8_SB(1, 1), b3 + hstep, voffB);
            PG8_WAIT_V(6); PG8_BAR; PG8_MMA(1, 1, At, B1); PG8_BAR;
            }
        }
        if constexpr (ALIGN_EPI) { if (wr == 0) PG8_BAR; }
        if constexpr (SP2 && !Epi::SELF_DRAIN) PG8_WAIT_V(0);
        if constexpr (!Epi::AFTER_DRAIN) { E(acc, cur, wr, wc, fr, fq); S.done(cur); }
        if (!has_next) break;
#pragma unroll
        for (int a = 0; a < 2; ++a)
#pragma unroll
            for (int b = 0; b < 2; ++b)
#pragma unroll
                for (int m = 0; m < 4; ++m)
#pragma unroll
                    for (int n = 0; n < 2; ++n) acc[a][b][m][n] = (f32x4){0.f, 0.f, 0.f, 0.f};
        cur = nxt; cA = nA; cB = nB; ++ui;
        if constexpr (ALIGN_EPI) { if (wr == 1) PG8_BAR; }
    }
    PG8_WAIT_V(0);
    if constexpr (!ALIGN_EPI) { if (wr == 0) PG8_BAR; }
    PG8_BAR;
#undef PG8_SA
#undef PG8_SB
#undef PG8_STAGE
#undef PG8_LDA
#undef PG8_LDB
#undef PG8_MMA
#undef PG8_WAIT_V
#undef PG8_WAIT_V8_UNLESS
#undef PG8_WAIT_L
#undef PG8_BAR
#undef PG8_SCHED
}
}

#define XB_TMO      128
#define XB_XCNT(j)  (256  + 64 * (j))
#define XB_XSUB(j)  (1280 + 64 * (j))
#define XB_XGEN(j)  (2304 + 64 * (j))
#define XB_TOP      3328
#define XB_TOPGEN   3392
#define XCD_BAR_WORDS 3456
#define XB_SPIN_CAP (1u << 22)
__device__ __forceinline__ unsigned xb_ld(unsigned* p)              { return __hip_atomic_load(p, __ATOMIC_RELAXED, __HIP_MEMORY_SCOPE_AGENT); }
__device__ __forceinline__ unsigned xb_add(unsigned* p, unsigned v) { return __hip_atomic_fetch_add(p, v, __ATOMIC_RELAXED, __HIP_MEMORY_SCOPE_AGENT); }
__device__ __forceinline__ unsigned xb_xcc_id() { return (unsigned)__builtin_amdgcn_s_getreg((3 << 11) | 20) & 0xFu; }
#define XB_SPIN(cond, bar) do { unsigned _sp = 0; while (cond) { __builtin_amdgcn_s_sleep(1); \
    if ((++_sp & 255u) == 0u) { if (xb_ld(&(bar)[XB_TMO])) break; if (_sp > XB_SPIN_CAP) { atomicAdd(&(bar)[XB_TMO], 1u); break; } } } } while (0)
struct XcdBarrier { unsigned* bar; unsigned x; volatile LAS unsigned* st; };
__device__ __forceinline__ XcdBarrier xcd_barrier_post(unsigned* bar, volatile LAS unsigned* st) {
    XcdBarrier b; b.bar = bar; b.x = xb_xcc_id(); b.st = st;
    if (threadIdx.x == 0) st[2] = xb_add(&bar[XB_XCNT(b.x)], 1u);
    return b;
}
__device__ __forceinline__ void xcd_barrier_complete(unsigned* bar, unsigned x, unsigned& nloc, unsigned& nx) {
    const unsigned G = gridDim.x * gridDim.y * gridDim.z;
    unsigned sum, cnt, mine, sp = 0u;
    for (;;) {
        sum = 0u; cnt = 0u; mine = 0u;
#pragma unroll
        for (unsigned j = 0; j < 16; ++j) { const unsigned c = xb_ld(&bar[XB_XCNT(j)]); sum += c; cnt += (c > 0u) ? 1u : 0u; mine = (j == x) ? c : mine; }
        if (sum == G) break;
        __builtin_amdgcn_s_sleep(1);
        if ((++sp & 255u) == 0u) { if (xb_ld(&bar[XB_TMO])) break; if (sp > XB_SPIN_CAP) { atomicAdd(&bar[XB_TMO], 1u); break; } }
    }
    nloc = mine > 0u ? mine : 1u; nx = cnt > 0u ? cnt : 1u;
}
__device__ __forceinline__ void xcd_barrier(const XcdBarrier& b) {
    asm volatile("s_waitcnt vmcnt(0)" ::: "memory");
    __syncthreads();
    if (threadIdx.x == 0) {
        unsigned* bar = b.bar;
        __builtin_amdgcn_s_waitcnt(0);
        unsigned nloc = b.st[0], nx = b.st[1];
        if (nloc == 0u) { xcd_barrier_complete(bar, b.x, nloc, nx); b.st[0] = nloc; b.st[1] = nx; }
        const unsigned old = xb_add(&bar[XB_XSUB(b.x)], 1u);
        const unsigned gen = old / nloc;
        if (old + 1u == (gen + 1u) * nloc) {
            __builtin_amdgcn_fence(__ATOMIC_RELEASE, "agent");
            asm volatile("s_waitcnt vmcnt(0)" ::: "memory");
            const unsigned og = xb_add(&bar[XB_TOP], 1u);
            const unsigned tg = og / nx;
            if (og + 1u == (tg + 1u) * nx) xb_add(&bar[XB_TOPGEN], 1u);
            else XB_SPIN(xb_ld(&bar[XB_TOPGEN]) == tg, bar);
            __builtin_amdgcn_fence(__ATOMIC_ACQUIRE, "agent");
            xb_add(&bar[XB_XGEN(b.x)], 1u);
            asm volatile("s_waitcnt vmcnt(0)" ::: "memory");
        } else {
            XB_SPIN(xb_ld(&bar[XB_XGEN(b.x)]) == gen, bar);
            __builtin_amdgcn_fence(__ATOMIC_ACQUIRE, "agent");
            asm volatile("s_waitcnt vmcnt(0)" ::: "memory");
        }
    }
    __syncthreads();
}

struct Args { const float* in[21]; float* out; unsigned char* ws; int ph_lo, ph_hi; };
enum { I_XP = 0, I_XS, I_CP, I_CS, I_ADAW, I_ADAB, I_NPRE, I_NPOST, I_F1G, I_F1U, I_F1D, I_WIN, I_SINK, I_WAB, I_POOLW, I_POOLS, I_WPB, I_WOUT, I_F2G, I_F2U, I_F2D };

__device__ __forceinline__ int map_row(int mode, int n0) {
    if (mode == 0) return n0;
    if (mode == 1) return 256 * (n0 >> 7) + (n0 & 127);
    if (mode == 2) return 256 * (n0 >> 7) + 128 + (n0 & 127);
    if (n0 < 512) { const int head = n0 >> 6, half = (n0 >> 5) & 1; return 256 * (head >> 2) + 128 * half + (head & 3) * 32; }
    if (n0 < 640) { const int kh = (n0 - 512) >> 6, half = (n0 >> 5) & 1; return 512 + 128 * half + kh * 32; }
    if (n0 < 768) { const int vv = n0 - 640; return 512 + 128 * (vv >> 6) + 64 + (vv & 63); }
    return n0;
}
__device__ __forceinline__ void transpose_item(const float* W, int K, int N, bf16_t* WT, int KB, int mode, LAS float* scr, int item, int lane) {
    const int nblk = N / 32, kb = item / nblk, nb = item % nblk, k0 = 64 * kb, n0 = 32 * nb;
#pragma unroll 8
    for (int i = 0; i < 32; ++i) { const int kk = 2 * i + (lane >> 5); scr[kk * 33 + (lane & 31)] = W[(size_t)(k0 + kk) * N + n0 + (lane & 31)]; }
    LDS_WAIT();
    const int rb = map_row(mode, n0);
    const int c = lane & 7;
#pragma unroll
    for (int j = 0; j < 4; ++j) { const int n = (lane >> 3) + 8 * j; const LAS float* s = scr + (8 * c) * 33 + n;
        u32x4 o; o.x = cvt_pk_bf16(s[0 * 33], s[1 * 33]); o.y = cvt_pk_bf16(s[2 * 33], s[3 * 33]); o.z = cvt_pk_bf16(s[4 * 33], s[5 * 33]); o.w = cvt_pk_bf16(s[6 * 33], s[7 * 33]);
        *(u32x4*)(WT + blk_off(rb + n, k0 + 8 * c, KB)) = o; }
    LDS_WAIT();
}

__device__ __forceinline__ void mod_phase(LAS unsigned char* lds, const Args& a, int G, int bid) {
    const int tid = threadIdx.x, lane = tid & 63, wid = tid >> 6;
    LAS float* sc = (LAS float*)lds;
    LAS float* part = (LAS float*)(lds + 40960);
    for (int i = tid; i < NSEQ * D; i += 512) { const int b = i >> 10, k = i & 1023; const float c = (b < NPROMPT) ? a.in[I_CP][b * D + k] : a.in[I_CS][(b - NPROMPT) * D + k]; sc[i] = c / (1.0f + expf(-c)); }
    __syncthreads();
    float* mod = (float*)(a.ws + WS_MOD);
    for (int it = bid; it < NMOD / 36; it += G) {
        const int j0 = it * 36; const int ln = lane < 36 ? lane : 35;
        float acc[NSEQ];
#pragma unroll
        for (int b = 0; b < NSEQ; ++b) acc[b] = 0.f;
        const float* w = a.in[I_ADAW] + (size_t)(wid * 128) * NMOD + j0 + ln;
#pragma unroll 16
        for (int k = 0; k < 128; ++k) { const float wv = w[(size_t)k * NMOD];
#pragma unroll
            for (int b = 0; b < NSEQ; ++b) acc[b] += sc[b * D + wid * 128 + k] * wv; }
#pragma unroll
        for (int b = 0; b < NSEQ; ++b) part[(wid * NSEQ + b) * 64 + lane] = acc[b];
        __syncthreads();
        for (int i = tid; i < NSEQ * 36; i += 512) { const int b = i / 36, l = i - b * 36; float s = a.in[I_ADAB][j0 + l];
#pragma unroll
            for (int w8 = 0; w8 < 8; ++w8) s += part[(w8 * NSEQ + b) * 64 + l];
            mod[b * NMOD + j0 + l] = s; }
        __syncthreads();
    }
}

__device__ __forceinline__ void prep_phase(LAS unsigned char* lds, const Args& a, int G, int bid) {
    const int tid = threadIdx.x, lane = tid & 63, wid = tid >> 6;
    unsigned char* ws = a.ws;
    LAS float* scr = (LAS float*)(lds + wid * 16384);
    const int gw = bid * 8 + wid, NGW = G * 8;
    constexpr int I_GU = (D / 64) * (FF / 32), I_DN = (FF / 64) * (D / 32), I_IN = (D / 64) * (NIN / 32), I_AB = (512 / 64) * (D / 32), I_OUT = (D / 64) * (D / 32);
    constexpr int NITEMS = 4 * I_GU + 2 * I_DN + I_IN + I_AB + I_OUT;
    for (int it = gw; it < NITEMS; it += NGW) {
        int r = it;
        if (r < I_GU) { transpose_item(a.in[I_F1G], D, FF, (bf16_t*)(ws + WS_W1GU), D / 64, 1, scr, r, lane); continue; } r -= I_GU;
        if (r < I_GU) { transpose_item(a.in[I_F1U], D, FF, (bf16_t*)(ws + WS_W1GU), D / 64, 2, scr, r, lane); continue; } r -= I_GU;
        if (r < I_GU) { transpose_item(a.in[I_F2G], D, FF, (bf16_t*)(ws + WS_W2GU), D / 64, 1, scr, r, lane); continue; } r -= I_GU;
        if (r < I_GU) { transpose_item(a.in[I_F2U], D, FF, (bf16_t*)(ws + WS_W2GU), D / 64, 2, scr, r, lane); continue; } r -= I_GU;
        if (r < I_DN) { transpose_item(a.in[I_F1D], FF, D, (bf16_t*)(ws + WS_W1D), FF / 64, 0, scr, r, lane); continue; } r -= I_DN;
        if (r < I_DN) { transpose_item(a.in[I_F2D], FF, D, (bf16_t*)(ws + WS_W2D), FF / 64, 0, scr, r, lane); continue; } r -= I_DN;
        if (r < I_IN) { transpose_item(a.in[I_WIN], D, NIN, (bf16_t*)(ws + WS_WIN), D / 64, 3, scr, r, lane); continue; } r -= I_IN;
        if (r < I_AB) { transpose_item(a.in[I_WAB], 512, D, (bf16_t*)(ws + WS_WAB), D / 64, 0, scr, r, lane); continue; } r -= I_AB;
        transpose_item(a.in[I_WOUT], D, D, (bf16_t*)(ws + WS_WOUT), D / 64, 0, scr, r, lane);
    }
    {
        const float* pw = a.in[I_POOLW]; const float* ps = a.in[I_POOLS]; const float* wpb = a.in[I_WPB]; bf16_t* o = (bf16_t*)(ws + WS_WAB);
        for (int it = gw; it < 2048; it += NGW) {
            const int nq = it & 3, c = (it >> 2) & 127, g = it >> 9;
            scr[lane] = pw[(g * 128 + c) * 128 + lane] * ps[g * 128 + lane];
            scr[lane + 64] = pw[(g * 128 + c) * 128 + lane + 64] * ps[g * 128 + lane + 64];
            LDS_WAIT();
            for (int nc = 0; nc < 4; ++nc) { const int n = nq * 256 + nc * 64 + lane; float s = 0.f; const float* wp = wpb + (size_t)(g * 128) * D + n;
#pragma unroll 8
                for (int d = 0; d < 128; ++d) s += scr[d] * wp[(size_t)d * D];
                o[blk_off(n, 512 + g * 128 + c, 16)] = (bf16_t)(cvt_pk_bf16(s, 0.f) & 0xffffu); }
            LDS_WAIT();
        }
    }
    {
        float* ct = (float*)(ws + WS_CT); float* st = (float*)(ws + WS_ST);
        for (int i = bid * 512 + tid; i < SEQ * 32; i += G * 512) { const int pos = i >> 5, f = i & 31;
            const float inv = exp2f(-(float)f * (13.287712379549449f / 32.0f));
            const float ang = (float)pos * inv;
            const double ad = (double)ang; const double kk = rint(ad * 0.15915494309189535);
            double r = fma(-kk, 6.283185307179586, ad); r = fma(-kk, 2.4492935982947064e-16, r);
            const float rf = (float)r;
            ct[i] = cosf(rf); st[i] = sinf(rf); }
    }
}

__device__ __forceinline__ const float* xrow_in(const Args& a, int row) { return row < NPROMPT * SEQ ? a.in[I_XP] + (size_t)row * D : a.in[I_XS] + (size_t)(row - NPROMPT * SEQ) * D; }

template <int MODE, bool XF32> __device__ __forceinline__ void norm_phase(const Args& a, int j, float rw, int G, int bid, const bf16_t* Xin, const bf16_t* Yin, bf16_t* Xout) {
    const int tid = threadIdx.x, lane = tid & 63, wid = tid >> 6;
    const int gw = bid * 8 + wid, NGW = G * 8;
    const float* mod = (const float*)(a.ws + WS_MOD);
    bf16_t* H = (bf16_t*)(a.ws + WS_H);
    const int rpw = (((T + NGW - 1) / NGW) + 3) & ~3;
    const int r0 = gw * rpw, r1 = (r0 + rpw) < T ? (r0 + rpw) : T;
    int cur_b = -1;
    f32x4 pA[4], pB[4], pC[4];
#pragma unroll
    for (int q = 0; q < 4; ++q) { pA[q] = (f32x4){0.f, 0.f, 0.f, 0.f}; pB[q] = pA[q]; pC[q] = pA[q]; }
    for (int r = r0; r < r1; r += 4) {
        const int b = r >> 13;
        if (b != cur_b) { cur_b = b;
            if (MODE != 0) { const f32x4* gp = (const f32x4*)(a.in[I_NPOST] + j * D) + lane; const f32x4* gt = (const f32x4*)(mod + (size_t)b * NMOD + j * 3 * D + 2 * D) + lane;
#pragma unroll
                for (int q = 0; q < 4; ++q) pA[q] = gp[64 * q] * (gt[64 * q] * rw); }
            if (MODE != 2) { const int jn = (MODE == 0) ? j : j + 1;
                const f32x4* gp = (const f32x4*)(a.in[I_NPRE] + jn * D) + lane; const f32x4* sh = (const f32x4*)(mod + (size_t)b * NMOD + jn * 3 * D) + lane; const f32x4* sc = sh + D / 4;
#pragma unroll
                for (int q = 0; q < 4; ++q) { pB[q] = gp[64 * q] * (sc[64 * q] + 1.0f); pC[q] = sh[64 * q]; } }
        }
        f32x4 x[4][4]; u32x2 yw[4][4];
#pragma unroll
        for (int i = 0; i < 4; ++i) { const int row = (r + i) < r1 ? (r + i) : (r1 - 1);
            if (XF32) { const f32x4* xr = (const f32x4*)xrow_in(a, row) + lane;
#pragma unroll
                for (int q = 0; q < 4; ++q) x[i][q] = xr[64 * q]; }
            else { const u32x2* xr = (const u32x2*)(Xin + (size_t)row * D) + lane;
#pragma unroll
                for (int q = 0; q < 4; ++q) { const u32x2 w = xr[64 * q]; x[i][q] = (f32x4){bf_lo(w.x), bf_hi(w.x), bf_lo(w.y), bf_hi(w.y)}; } }
            if (MODE != 0) { const u32x2* yr = (const u32x2*)(Yin + (size_t)row * D) + lane;
#pragma unroll
                for (int q = 0; q < 4; ++q) yw[i][q] = yr[64 * q]; }
        }
#pragma unroll
        for (int i = 0; i < 4; ++i) { const int row = r + i; const bool live = row < r1;
            if (MODE != 0) {
                f32x4 y[4]; float ss = 0.f;
#pragma unroll
                for (int q = 0; q < 4; ++q) { const u32x2 w = yw[i][q]; y[q] = (f32x4){bf_lo(w.x), bf_hi(w.x), bf_lo(w.y), bf_hi(w.y)};
                    ss += (y[q][0] * y[q][0] + y[q][1] * y[q][1]) + (y[q][2] * y[q][2] + y[q][3] * y[q][3]); }
                const float rstd = rsqrtf(wave_sum(ss) * (1.0f / D) + EPS);
#pragma unroll
                for (int q = 0; q < 4; ++q) x[i][q] = x[i][q] + (y[q] * rstd) * pA[q];
                if (MODE == 2) { f32x4* xo = (f32x4*)(a.out + (size_t)row * D) + lane;
#pragma unroll
                    for (int q = 0; q < 4; ++q) if (live) xo[64 * q] = x[i][q]; }
                else { u32x2* xo = (u32x2*)(Xout + (size_t)row * D) + lane;
#pragma unroll
                    for (int q = 0; q < 4; ++q) { u32x2 w; w.x = cvt_pk_bf16(x[i][q][0], x[i][q][1]); w.y = cvt_pk_bf16(x[i][q][2], x[i][q][3]); if (live) xo[64 * q] = w; } }
            }
            if (MODE != 2) {
                float ss = 0.f;
#pragma unroll
                for (int q = 0; q < 4; ++q) ss += (x[i][q][0] * x[i][q][0] + x[i][q][1] * x[i][q][1]) + (x[i][q][2] * x[i][q][2] + x[i][q][3] * x[i][q][3]);
                const float rstd = rsqrtf(wave_sum(ss) * (1.0f / D) + EPS);
#pragma unroll
                for (int q = 0; q < 4; ++q) { const f32x4 h = (x[i][q] * rstd) * pB[q] + pC[q];
                    u32x2 w; w.x = cvt_pk_bf16(h[0], h[1]); w.y = cvt_pk_bf16(h[2], h[3]); if (live) *(u32x2*)(H + blk_off(row, 4 * lane + 256 * q, D / 64)) = w; }
            }
        }
    }
}

namespace att {
constexpr int KSTR = 144;
constexpr int VSTR = 784;
constexpr int K_OFF = 0, V_OFF = 384 * KSTR, BYTES = V_OFF + 64 * VSTR;
static_assert(BYTES <= 131072, "attention LDS");
}
__device__ __forceinline__ void attn_phase(LAS unsigned char* lds, const bf16_t* Q, const bf16_t* K, const bf16_t* V, bf16_t* O, const float* sink, int G, int bid) {
    using namespace att;
    const int tid = threadIdx.x, lane = tid & 63, wid = tid >> 6, fr = lane & 15, fq = lane >> 4;
    for (int unit = bid; unit < NSEQ * 64 * 2; unit += G) {
        const int kvh = unit & 1, blk = (unit >> 1) & 63, b = unit >> 7;
        const size_t seq0 = (size_t)b * SEQ;
        const int kp0 = (blk - 1) * 128;
        __syncthreads();
#pragma unroll
        for (int it = 0; it < 6; ++it) {
            const int id = tid + 512 * it, row = id >> 3, ch = id & 7; const int kpos = kp0 + row;
            u32x4 kv = {0u, 0u, 0u, 0u}, vv = {0u, 0u, 0u, 0u};
            if (kpos >= 0 && kpos < SEQ) { const size_t off = (seq0 + kpos) * 128 + kvh * 64 + ch * 8; kv = *(const u32x4*)(K + off); vv = *(const u32x4*)(V + off); }
            *(LAS u32x4*)(lds + K_OFF + row * KSTR + ch * 16) = kv;
            LAS unsigned short* vt = (LAS unsigned short*)(lds + V_OFF + (ch * 8) * VSTR + row * 2);
            vt[0 * (VSTR / 2)] = (unsigned short)(vv.x & 0xffffu); vt[1 * (VSTR / 2)] = (unsigned short)(vv.x >> 16);
            vt[2 * (VSTR / 2)] = (unsigned short)(vv.y & 0xffffu); vt[3 * (VSTR / 2)] = (unsigned short)(vv.y >> 16);
            vt[4 * (VSTR / 2)] = (unsigned short)(vv.z & 0xffffu); vt[5 * (VSTR / 2)] = (unsigned short)(vv.z >> 16);
            vt[6 * (VSTR / 2)] = (unsigned short)(vv.w & 0xffffu); vt[7 * (VSTR / 2)] = (unsigned short)(vv.w >> 16);
        }
        __syncthreads();
        const int qg = __builtin_amdgcn_readfirstlane(wid);
        const int r = qg * 16 + fr;
        const size_t qrow = seq0 + (size_t)blk * 128 + r;
        const bool edge = (blk == 0) || (blk == 63);
#pragma unroll 1
        for (int h4 = 0; h4 < 4; ++h4) {
            const int head = kvh * 4 + h4;
            const bf16x8 qf0 = *(const bf16x8*)(Q + qrow * 512 + head * 64 + fq * 8);
            const bf16x8 qf1 = *(const bf16x8*)(Q + qrow * 512 + head * 64 + 32 + fq * 8);
            f32x4 s[17];
            int lofs = 0; asm volatile("" : "+v"(lofs));
            const LAS unsigned char* kb = lds + K_OFF + (qg * 16 + fr) * KSTR + fq * 16 + lofs;
#pragma unroll
            for (int t = 0; t < 17; ++t) {
                const bf16x8 k0 = *(const LAS bf16x8*)(kb + t * 16 * KSTR), k1 = *(const LAS bf16x8*)(kb + t * 16 * KSTR + 64);
                f32x4 c = {0.f, 0.f, 0.f, 0.f};
                c = __builtin_amdgcn_mfma_f32_16x16x32_bf16(k0, qf0, c, 0, 0, 0);
                c = __builtin_amdgcn_mfma_f32_16x16x32_bf16(k1, qf1, c, 0, 0, 0);
                s[t] = c;
            }
#pragma unroll
            for (int e = 0; e < 4; ++e) { if (fq * 4 + e < fr) s[0][e] = -1e30f; if (fq * 4 + e > fr) s[16][e] = -1e30f; }
            if (edge) {
#pragma unroll
                for (int t = 0; t < 17; ++t) { const int jt = qg + t; if ((blk == 0 && jt < 8) || (blk == 63 && jt >= 16)) s[t] = (f32x4){-1e30f, -1e30f, -1e30f, -1e30f}; }
            }
            const float skl = sink[head] * LOG2E;
            float mx = skl;
#pragma unroll
            for (int t = 0; t < 17; ++t) mx = fmaxf(mx, fmaxf(fmaxf(s[t][0], s[t][1]), fmaxf(s[t][2], s[t][3])));
            mx = fmaxf(mx, __shfl_xor(mx, 16)); mx = fmaxf(mx, __shfl_xor(mx, 32));
            f32x4 lv = {0.f, 0.f, 0.f, 0.f};
#pragma unroll
            for (int t = 0; t < 17; ++t) { const f32x4 d = s[t] - mx; f32x4 p;
                p[0] = __builtin_amdgcn_exp2f(d[0]); p[1] = __builtin_amdgcn_exp2f(d[1]); p[2] = __builtin_amdgcn_exp2f(d[2]); p[3] = __builtin_amdgcn_exp2f(d[3]);
                s[t] = p; lv += p; }
            float l = (lv[0] + lv[1]) + (lv[2] + lv[3]);
            l += __shfl_xor(l, 16); l += __shfl_xor(l, 32);
            l += __builtin_amdgcn_exp2f(skl - mx);
            const float inv = 1.0f / l;
            f32x4 o[4];
#pragma unroll
            for (int dt = 0; dt < 4; ++dt) o[dt] = (f32x4){0.f, 0.f, 0.f, 0.f};
#pragma unroll
            for (int pp = 0; pp < 8; ++pp) {
                u32x4 pw; pw.x = cvt_pk_bf16(s[2 * pp][0], s[2 * pp][1]); pw.y = cvt_pk_bf16(s[2 * pp][2], s[2 * pp][3]);
                pw.z = cvt_pk_bf16(s[2 * pp + 1][0], s[2 * pp + 1][1]); pw.w = cvt_pk_bf16(s[2 * pp + 1][2], s[2 * pp + 1][3]);
                const bf16x8 pf = __builtin_bit_cast(bf16x8, pw);
#pragma unroll
                for (int dt = 0; dt < 4; ++dt) {
                    const LAS unsigned char* vb = lds + V_OFF + (dt * 16 + fr) * VSTR + ((qg + 2 * pp) * 16 + fq * 4) * 2 + lofs;
                    const u32x2 va = *(const LAS u32x2*)vb, vc = *(const LAS u32x2*)(vb + 32);
                    u32x4 vw; vw.x = va.x; vw.y = va.y; vw.z = vc.x; vw.w = vc.y;
                    o[dt] = __builtin_amdgcn_mfma_f32_16x16x32_bf16(__builtin_bit_cast(bf16x8, vw), pf, o[dt], 0, 0, 0);
                }
            }
            {
                u32x2 pw; pw.x = cvt_pk_bf16(s[16][0], s[16][1]); pw.y = cvt_pk_bf16(s[16][2], s[16][3]);
                const s16x4 pf = __builtin_bit_cast(s16x4, pw);
#pragma unroll
                for (int dt = 0; dt < 4; ++dt) {
                    const LAS unsigned char* vb = lds + V_OFF + (dt * 16 + fr) * VSTR + ((qg + 16) * 16 + fq * 4) * 2 + lofs;
                    const u32x2 va = *(const LAS u32x2*)vb;
                    o[dt] = __builtin_amdgcn_mfma_f32_16x16x16bf16_1k(__builtin_bit_cast(s16x4, va), pf, o[dt], 0, 0, 0);
                }
            }
            bf16_t* op = O + blk_off((int)qrow, head * 64 + fq * 4, 16);
#pragma unroll
            for (int dt = 0; dt < 4; ++dt) { u32x2 w; w.x = cvt_pk_bf16(o[dt][0] * inv, o[dt][1] * inv); w.y = cvt_pk_bf16(o[dt][2] * inv, o[dt][3] * inv); *(u32x2*)(op + dt * 16) = w; }
        }
    }
}
__device__ __forceinline__ void pool_phase(LAS unsigned char* lds, const bf16_t* U, bf16_t* P, int G, int bid) {
    constexpr int RS = 1040;
    const int tid = threadIdx.x, c = tid & 63, sub = tid >> 6, g = c >> 4, hw = 1 << g;
    for (int unit = bid; unit < NSEQ * 128; unit += G) {
        const int b = unit >> 7, s0 = (unit & 127) * 64; const size_t seqrow = (size_t)b * SEQ;
        __syncthreads();
#pragma unroll
        for (int it = 0; it < 10; ++it) { const int id = tid + 512 * it, row = id >> 6, ch = id & 63, sp = s0 - 8 + row;
            u32x4 v = {0u, 0u, 0u, 0u}; if (sp >= 0 && sp < SEQ) v = *(const u32x4*)(U + (seqrow + sp) * 512 + ch * 8);
            *(LAS u32x4*)(lds + row * RS + ch * 16) = v; }
        __syncthreads();
        const int rbase = sub * 8 + 8;
        const LAS unsigned char* col = lds + c * 16;
        float S[8];
#pragma unroll
        for (int e = 0; e < 8; ++e) S[e] = 0.f;
#pragma unroll
        for (int k = 0; k < 16; ++k) if (k < 2 * hw) { const u32x4 w = *(const LAS u32x4*)(col + (rbase - hw + k) * RS);
            S[0] += bf_lo(w.x); S[1] += bf_hi(w.x); S[2] += bf_lo(w.y); S[3] += bf_hi(w.y); S[4] += bf_lo(w.z); S[5] += bf_hi(w.z); S[6] += bf_lo(w.w); S[7] += bf_hi(w.w); }
#pragma unroll
        for (int k = 0; k < 8; ++k) { const int sp = s0 + sub * 8 + k; const int lo = (sp - hw) < 0 ? 0 : (sp - hw), hi = (sp + hw) > SEQ ? SEQ : (sp + hw);
            const float ic = 1.0f / (float)(hi - lo);
            const u32x4 w = *(const LAS u32x4*)(col + (rbase + k) * RS);
            u32x4 o; o.x = cvt_pk_bf16(S[0] * ic - bf_lo(w.x), S[1] * ic - bf_hi(w.x)); o.y = cvt_pk_bf16(S[2] * ic - bf_lo(w.y), S[3] * ic - bf_hi(w.y));
            o.z = cvt_pk_bf16(S[4] * ic - bf_lo(w.z), S[5] * ic - bf_hi(w.z)); o.w = cvt_pk_bf16(S[6] * ic - bf_lo(w.w), S[7] * ic - bf_hi(w.w));
            *(u32x4*)(P + blk_off((int)(seqrow + sp), 512 + c * 8, 16)) = o;
            if (k < 7) { const u32x4 wa = *(const LAS u32x4*)(col + (rbase + k + hw) * RS), wd = *(const LAS u32x4*)(col + (rbase + k - hw) * RS);
                S[0] += bf_lo(wa.x) - bf_lo(wd.x); S[1] += bf_hi(wa.x) - bf_hi(wd.x); S[2] += bf_lo(wa.y) - bf_lo(wd.y); S[3] += bf_hi(wa.y) - bf_hi(wd.y);
                S[4] += bf_lo(wa.z) - bf_lo(wd.z); S[5] += bf_hi(wa.z) - bf_hi(wd.z); S[6] += bf_lo(wa.w) - bf_lo(wd.w); S[7] += bf_hi(wa.w) - bf_hi(wd.w); }
        }
    }
}

__global__ void __launch_bounds__(512, 2) mega_fwd(Args a) {
    extern __shared__ __attribute__((aligned(16))) unsigned char lds_raw[];
    LAS unsigned char* lds = (LAS unsigned char*)lds_raw;
    const int G = gridDim.x, bid = blockIdx.x;
    unsigned char* ws = a.ws;
#define IN(k) (a.ph_lo <= (k) && (k) < a.ph_hi)
    volatile LAS unsigned* bst = (volatile LAS unsigned*)(lds + 131072);
    if (threadIdx.x < 4) bst[threadIdx.x] = (threadIdx.x == 3) ? (unsigned)blockIdx.x : 0u;
    __syncthreads();
    XcdBarrier xbar = xcd_barrier_post((unsigned*)(ws + WS_CTL), bst);
    if (a.ph_hi > 1000) cg::this_grid().sync();
#define SEAM(k) do { if (IN(k) && IN((k) + 1)) { xcd_barrier(xbar); } } while (0)
    typedef pg8::StaticOrder SO;
    bf16_t* H = (bf16_t*)(ws + WS_H); bf16_t* Y = (bf16_t*)(ws + WS_Y); bf16_t* ACT = (bf16_t*)(ws + WS_BIG); bf16_t* X1 = (bf16_t*)a.out;

    if (IN(0)) mod_phase(lds, a, G, bid);
    SEAM(0);
    if (IN(0) && IN(1)) {
        if (threadIdx.x == 0) { unsigned* bar = (unsigned*)(ws + WS_CTL); bool ok = (G % 8) == 0;
            for (unsigned jx = 0; jx < 16; ++jx) { const unsigned cx = xb_ld(&bar[XB_XCNT(jx)]); ok = ok && (jx < 8 ? cx == (unsigned)(G / 8) : cx == 0u); }
            if (ok) bst[3] = bst[2] * 8u + xbar.x; }
        __syncthreads();
    }
#define VCU() __builtin_amdgcn_readfirstlane((int)bst[3])
    if (IN(1)) { prep_phase(lds, a, G, bid); norm_phase<0, true>(a, 0, 0.f, G, bid, nullptr, nullptr, nullptr); }
    SEAM(1);
    if (IN(2)) for (int rep = 0; rep < MK_GEMM_REP; ++rep) { pg8::Gemm g{H, (const bf16_t*)(ws + WS_W1GU), T, 2 * FF, D}; SO S; S.init(T, 2 * FF, G, VCU()); pg8::EpiSwiGLU E{ACT, FF};
        pg8::gemm_phase<pg8::EpiSwiGLU, SO, true, true>(lds, g, S, E); }
    SEAM(2);
    if (IN(3)) for (int rep = 0; rep < MK_GEMM_REP; ++rep) { pg8::Gemm g{ACT, (const bf16_t*)(ws + WS_W1D), T, D, FF}; SO S; S.init(T, D, G, VCU()); pg8::EpiBf16 E{Y, D};
        pg8::gemm_phase<pg8::EpiBf16, SO, true, true>(lds, g, S, E); }
    SEAM(3);
    if (IN(4)) norm_phase<1, true>(a, 0, 0.5f, G, bid, nullptr, Y, X1);
    SEAM(4);
    if (IN(5)) for (int rep = 0; rep < MK_GEMM_REP; ++rep) { pg8::Gemm g{H, (const bf16_t*)(ws + WS_WIN), T, NIN, D}; SO S; S.init(T, NIN, G, VCU());
        pg8::EpiProj E{(bf16_t*)(ws + WS_Q), (bf16_t*)(ws + WS_K), (bf16_t*)(ws + WS_V), (bf16_t*)(ws + WS_U), (bf16_t*)(ws + WS_GA), (bf16_t*)(ws + WS_GB), (const float*)(ws + WS_CT), (const float*)(ws + WS_ST)};
        pg8::gemm_phase<pg8::EpiProj, SO, true, true>(lds, g, S, E); }
    SEAM(5);
    if (IN(6)) {
        attn_phase(lds, (const bf16_t*)(ws + WS_Q), (const bf16_t*)(ws + WS_K), (const bf16_t*)(ws + WS_V), Y, a.in[I_SINK], G, bid);
        pool_phase(lds, (const bf16_t*)(ws + WS_U), Y, G, bid);
        __syncthreads();
        if (MK_DUP == 6) {
            attn_phase(lds, (const bf16_t*)(ws + WS_Q), (const bf16_t*)(ws + WS_K), (const bf16_t*)(ws + WS_V), Y, a.in[I_SINK], G, bid);
            pool_phase(lds, (const bf16_t*)(ws + WS_U), Y, G, bid);
            __syncthreads();
        }
    }
    SEAM(6);
    if (IN(7)) for (int rep = 0; rep < MK_GEMM_REP; ++rep) { pg8::Gemm g{Y, (const bf16_t*)(ws + WS_WAB), T, D, D}; SO S; S.init(T, D, G, VCU());
        pg8::EpiMerge E{H, (const bf16_t*)(ws + WS_GA), (const bf16_t*)(ws + WS_GB)};
        pg8::gemm_phase<pg8::EpiMerge, SO, true, true>(lds, g, S, E); }
    SEAM(7);
    if (IN(8)) for (int rep = 0; rep < MK_GEMM_REP; ++rep) { pg8::Gemm g{H, (const bf16_t*)(ws + WS_WOUT), T, D, D}; SO S; S.init(T, D, G, VCU()); pg8::EpiBf16 E{Y, D};
        pg8::gemm_phase<pg8::EpiBf16, SO, true, true>(lds, g, S, E); }
    SEAM(8);
    if (IN(9)) norm_phase<1, false>(a, 1, 1.0f, G, bid, X1, Y, Y);
    SEAM(9);
    if (IN(10)) for (int rep = 0; rep < MK_GEMM_REP; ++rep) { pg8::Gemm g{H, (const bf16_t*)(ws + WS_W2GU), T, 2 * FF, D}; SO S; S.init(T, 2 * FF, G, VCU()); pg8::EpiSwiGLU E{ACT, FF};
        pg8::gemm_phase<pg8::EpiSwiGLU, SO, true, true>(lds, g, S, E); }
    SEAM(10);
    if (IN(11)) for (int rep = 0; rep < MK_GEMM_REP; ++rep) { pg8::Gemm g{ACT, (const bf16_t*)(ws + WS_W2D), T, D, FF}; SO S; S.init(T, D, G, VCU()); pg8::EpiBf16 E{H, D};
        pg8::gemm_phase<pg8::EpiBf16, SO, true, true>(lds, g, S, E); }
    SEAM(11);
    if (IN(12)) norm_phase<2, false>(a, 2, 0.5f, G, bid, Y, H, nullptr);
#undef IN
#undef SEAM
}

__global__ void chk_kernel(const unsigned* p, size_t nwords, unsigned long long* dst) {
    unsigned long long s = 0;
    for (size_t i = (size_t)blockIdx.x * blockDim.x + threadIdx.x; i < nwords; i += (size_t)gridDim.x * blockDim.x) s += p[i];
    atomicAdd(dst, s);
}
__global__ void verdict_kernel(const unsigned long long* chk, float* out, size_t n) {
    int code = 0;
    for (int p = 0; p < 6; ++p) if (chk[p] != chk[16 + p]) code |= 1 << p;
    for (size_t i = (size_t)blockIdx.x * blockDim.x + threadIdx.x; i < n; i += (size_t)gridDim.x * blockDim.x) out[i] = (float)code;
}
constexpr int NPHASE = 13;
extern "C" void kernel_launch(void* const* d_in, const int* in_sizes, int n_in, void* d_out, int out_size, void* d_ws, size_t ws_size, hipStream_t stream) {
    static int grid = 0;
    if (grid == 0) {
        if (n_in != 21 || out_size != T * D || ws_size < WS_END) { fprintf(stderr, "kernel_launch: unexpected shapes: n_in %d out %d ws %zu (need %zu)\n", n_in, out_size, ws_size, (size_t)WS_END); grid = -1; return; }
        int dev = 0, cus = 0, per_cu = 0;
        if (hipGetDevice(&dev) != hipSuccess || hipDeviceGetAttribute(&cus, hipDeviceAttributeMultiprocessorCount, dev) != hipSuccess) { grid = -1; return; }
        if (hipFuncSetAttribute((const void*)mega_fwd, hipFuncAttributeMaxDynamicSharedMemorySize, LDS_BYTES) != hipSuccess) { fprintf(stderr, "kernel_launch: hipFuncSetAttribute failed\n"); grid = -1; return; }
        if (hipOccupancyMaxActiveBlocksPerMultiprocessor(&per_cu, (const void*)mega_fwd, 512, LDS_BYTES) != hipSuccess || per_cu < 1) { fprintf(stderr, "kernel_launch: occupancy query says %d\n", per_cu); per_cu = 1; }
        (void)hipGetLastError();
        grid = cus * 1;
    }
    if (grid < 0) return;
    (void)hipMemsetAsync((unsigned char*)d_ws + WS_CTL, 0, CTL_BYTES, stream);
    Args a{};
    for (int i = 0; i < 21; ++i) a.in[i] = (const float*)d_in[i];
    a.out = (float*)d_out; a.ws = (unsigned char*)d_ws;
#if MK_MULTI_LAUNCH == 2
    {
        unsigned char* ws = (unsigned char*)d_ws; unsigned long long* chk = (unsigned long long*)(ws + 900 * MiB);
        (void)hipMemsetAsync(chk, 0, 4096, stream);
        const size_t offs[7] = {WS_Q, WS_K, WS_V, WS_U, WS_GA, WS_GB, WS_END};
        for (int run = 0; run < 2; ++run) {
            for (int p = 0; p < 6; ++p) { a.ph_lo = p; a.ph_hi = p + 1; hipLaunchKernelGGL(mega_fwd, dim3(grid), dim3(512), LDS_BYTES, stream, a); }
            for (int i = 0; i < 6; ++i) hipLaunchKernelGGL(chk_kernel, dim3(2048), dim3(256), 0, stream, (const unsigned*)(ws + offs[i]), (offs[i + 1] - offs[i]) / 4, chk + run * 16 + i);
        }
        hipLaunchKernelGGL(verdict_kernel, dim3(2048), dim3(256), 0, stream, (const unsigned long long*)chk, (float*)d_out, (size_t)T * D);
    }
#elif MK_MULTI_LAUNCH
    for (int p = 0; p < NPHASE; ++p) { const bool is_gemm = (p == 2 || p == 3 || p == 5 || p == 7 || p == 8 || p == 10 || p == 11);
        const int reps = (MK_MULTI_LAUNCH == 3 && is_gemm) ? 2 : ((MK_MULTI_LAUNCH == 4 && !is_gemm && p != 9 && p != 12) ? 2 : 1);
        for (int rep = 0; rep < reps; ++rep) { a.ph_lo = p; a.ph_hi = p + 1; hipLaunchKernelGGL(mega_fwd, dim3(grid), dim3(512), LDS_BYTES, stream, a); } }
#else
    a.ph_lo = 0; a.ph_hi = NPHASE;
    void* args[] = {&a};
    hipError_t e = hipLaunchCooperativeKernel((const void*)mega_fwd, dim3(grid), dim3(512), args, LDS_BYTES, stream);
    if (e != hipSuccess) fprintf(stderr, "kernel_launch: cooperative launch failed: %s (grid %d)\n", hipGetErrorString(e), grid);
#endif
}
```

```cpp
#include <hip/hip_runtime.h>
#include <hip/hip_cooperative_groups.h>
#include <cstdio>
#include <cstdint>
namespace cg = cooperative_groups;

#ifndef MK_MULTI_LAUNCH
#define MK_MULTI_LAUNCH 0
#endif
#ifndef MK_GEMM_REP
#define MK_GEMM_REP 1
#endif
#ifndef MK_DUP
#define MK_DUP -1
#endif

#define LAS __attribute__((address_space(3)))
typedef unsigned short bf16_t;
typedef short bf16x8 __attribute__((ext_vector_type(8)));
typedef float f32x4 __attribute__((ext_vector_type(4)));
typedef float f32x2 __attribute__((ext_vector_type(2)));
typedef unsigned u32x4 __attribute__((ext_vector_type(4)));
typedef unsigned u32x2 __attribute__((ext_vector_type(2)));
typedef short s16x4 __attribute__((ext_vector_type(4)));

constexpr int D = 1024, SEQ = 8192, NSEQ = 10, NPROMPT = 8, T = NSEQ * SEQ, FF = 2816, NIN = 3328;
constexpr int NMOD = 9 * D;
constexpr float EPS = 1e-6f;
constexpr float LOG2E = 1.4426950408889634f;

constexpr size_t MiB = 1u << 20;
constexpr size_t WS_MOD = 0;
constexpr size_t WS_CTL = 384 * 1024, CTL_BYTES = 16 * 1024;
constexpr size_t WS_CT = 1 * MiB, WS_ST = 2 * MiB;
constexpr size_t WS_W1GU = 3 * MiB;
constexpr size_t WS_W1D = 14 * MiB;
constexpr size_t WS_W2GU = 20 * MiB;
constexpr size_t WS_W2D = 31 * MiB;
constexpr size_t WS_WIN = 37 * MiB;
constexpr size_t WS_WAB = 44 * MiB;
constexpr size_t WS_WPB = 45 * MiB;
constexpr size_t WS_WOUT = 46 * MiB;
constexpr size_t WS_H = 48 * MiB;
constexpr size_t WS_Y = 208 * MiB;
constexpr size_t WS_BIG = 368 * MiB;
constexpr size_t WS_Q = WS_BIG, WS_K = WS_Q + 80 * MiB, WS_V = WS_K + 20 * MiB, WS_U = WS_V + 20 * MiB, WS_GA = WS_U + 80 * MiB, WS_GB = WS_GA + 160 * MiB;
constexpr size_t WS_END = WS_GB + 160 * MiB;
static_assert((size_t)T * D * 2 == 160 * MiB && (size_t)T * FF * 2 == 440 * MiB && (size_t)T * 512 * 2 == 80 * MiB && (size_t)T * 128 * 2 == 20 * MiB, "ws map");

constexpr int LDS_BYTES = 135168;

typedef __bf16 bf16x2v __attribute__((ext_vector_type(2)));
__device__ __forceinline__ unsigned cvt_pk_bf16(float lo, float hi) { const f32x2 v = {lo, hi}; return __builtin_bit_cast(unsigned, __builtin_convertvector(v, bf16x2v)); }
__device__ __forceinline__ float bf_lo(unsigned w) { return __builtin_bit_cast(float, w << 16); }
__device__ __forceinline__ float bf_hi(unsigned w) { return __builtin_bit_cast(float, w & 0xffff0000u); }
__device__ __forceinline__ float fast_sigmoid(float x) { return __builtin_amdgcn_rcpf(1.0f + __builtin_amdgcn_exp2f(-x * LOG2E)); }
__device__ __forceinline__ float fast_silu(float x) { return x * fast_sigmoid(x); }
__device__ __forceinline__ f32x2 sigmoid2(f32x2 x) { const f32x2 t = x * (-LOG2E); f32x2 e; e.x = __builtin_amdgcn_exp2f(t.x); e.y = __builtin_amdgcn_exp2f(t.y);
    const f32x2 d = e + 1.0f; f32x2 r; r.x = __builtin_amdgcn_rcpf(d.x); r.y = __builtin_amdgcn_rcpf(d.y); return r; }
__device__ __forceinline__ unsigned swiglu_pk(float g0, float g1, float u0, float u1) { const f32x2 g = {g0, g1}, u = {u0, u1}; const f32x2 o = (g * u) * sigmoid2(g); return cvt_pk_bf16(o.x, o.y); }
__device__ __forceinline__ unsigned sigmoid_pk(float a, float b) { const f32x2 r = sigmoid2((f32x2){a, b}); return cvt_pk_bf16(r.x, r.y); }
__device__ __forceinline__ float wave_sum(float v) {
#pragma unroll
    for (int o = 1; o < 64; o <<= 1) v += __shfl_xor(v, o);
    return v;
}
#define LDS_WAIT() asm volatile("s_waitcnt lgkmcnt(0)" ::: "memory")
__device__ __forceinline__ size_t blk_off(int row, int col, int KB) { return ((size_t)(row >> 8) * KB + (col >> 6)) * 16384 + (size_t)(((row & 255) << 6) + (col & 63)); }

namespace pg8 {
constexpr int BM = 256, BK = 64, HALF = 128, HTB = HALF * BK * 2, STAGE_BYTES = 8 * HTB, NXCD = 8, WGM = 8;
__host__ __device__ __forceinline__ int lds_byte(int r, int c) { const int st = (r >> 4) * 2 + (c >> 5), rr = r & 15, cc = c & 31, ob = rr * 64 + cc * 2; return st * 1024 + (ob ^ (((ob >> 9) & 1) << 5)); }
__host__ __device__ __forceinline__ void stage_rc(int b, int& R, int& C) { const int st = b / 1024, sb = b % 1024, swz = sb ^ (((sb >> 9) & 1) << 5); R = (st >> 1) * 16 + swz / 64; C = (st & 1) * 32 + (swz % 64) / 2; }
__host__ __device__ __forceinline__ int perm32(int rho) { const int n = rho >> 4, i = rho & 15; return 8 * (i >> 2) + 4 * n + (i & 3); }

struct Unit { int pm, pn; };
struct Gemm { const bf16_t* A; const bf16_t* Bt; int M, N, K; };

struct StaticOrder {
    int nM, nN, nwg, G, c;
    __device__ void init(int M, int N, int G_, int c_) { nM = M / BM; nN = N / BM; nwg = nM * nN; G = G_; c = c_; }
    __device__ bool next(int i, Unit& u) const {
        const long L = (long)i * G + c; if (L >= nwg) return false;
        int wgid = (int)L; { const int q = nwg / NXCD, r = nwg % NXCD, xcd = wgid % NXCD, off = wgid / NXCD; wgid = (xcd < r ? xcd * (q + 1) : r * (q + 1) + (xcd - r) * q) + off; }
        const int nig = WGM * nN, gid = wgid / nig, fm = gid * WGM, gsz = (nM - fm) < WGM ? (nM - fm) : WGM;
        u.pm = fm + ((wgid % nig) % gsz); u.pn = (wgid % nig) / gsz; return true;
    }
    __device__ __forceinline__ void a_ready(const Unit&) const {}
    __device__ __forceinline__ void done(const Unit&) const {}
};

typedef f32x4 Acc[2][2][4][2];

struct EpiBf16 {
    static constexpr bool PERM = true, AFTER_DRAIN = false, HAS_MID = false;
    bf16_t* O; int ldc;
    __device__ __forceinline__ void operator()(const Acc& acc, const Unit& u, int wr, int wc, int fr, int fq) const {
        const int row0 = u.pm * BM + wr * 64 + fr, col0 = u.pn * BM + wc * 32 + 8 * fq;
#pragma unroll
        for (int ai = 0; ai < 2; ++ai)
#pragma unroll
            for (int m = 0; m < 4; ++m) { bf16_t* rowp = O + (size_t)(row0 + ai * HALF + m * 16) * ldc + col0;
#pragma unroll
                for (int bj = 0; bj < 2; ++bj) { const f32x4 v0 = acc[ai][bj][m][0], v1 = acc[ai][bj][m][1];
                    u32x4 w; w.x = cvt_pk_bf16(v0[0], v0[1]); w.y = cvt_pk_bf16(v0[2], v0[3]); w.z = cvt_pk_bf16(v1[0], v1[1]); w.w = cvt_pk_bf16(v1[2], v1[3]);
                    *(u32x4*)(rowp + bj * HALF) = w; } }
    }
};

struct EpiSwiGLU {
    static constexpr bool PERM = true, AFTER_DRAIN = false, HAS_MID = false;
    bf16_t* O; int ldc;
    __device__ __forceinline__ void operator()(const Acc& acc, const Unit& u, int wr, int wc, int fr, int fq) const {
        const int row0 = u.pm * BM + wr * 64 + fr, col0 = u.pn * HALF + wc * 32 + 8 * fq;
#pragma unroll
        for (int ai = 0; ai < 2; ++ai)
#pragma unroll
            for (int m = 0; m < 4; ++m) { bf16_t* rowp = O + blk_off(row0 + ai * HALF + m * 16, col0, ldc / 64);
                const f32x4 g0 = acc[ai][0][m][0], g1 = acc[ai][0][m][1], u0 = acc[ai][1][m][0], u1 = acc[ai][1][m][1];
                u32x4 w;
                w.x = swiglu_pk(g0[0], g0[1], u0[0], u0[1]); w.y = swiglu_pk(g0[2], g0[3], u0[2], u0[3]);
                w.z = swiglu_pk(g1[0], g1[1], u1[0], u1[1]); w.w = swiglu_pk(g1[2], g1[3], u1[2], u1[3]);
                *(u32x4*)rowp = w; }
    }
};

struct EpiProj {
    static constexpr bool PERM = true, AFTER_DRAIN = false, HAS_MID = false;
    bf16_t *Q, *K, *V, *U, *GA, *GB; const float *ct, *st;
    __device__ __forceinline__ void rope_store(const Acc& acc, int row0, bf16_t* base, int ld, int colbase, int fq, float sc) const {
#pragma unroll
        for (int ai = 0; ai < 2; ++ai)
#pragma unroll
            for (int m = 0; m < 4; ++m) { const int row = row0 + ai * HALF + m * 16; const int pos = row & (SEQ - 1);
                const float* cp = ct + pos * 32 + 8 * fq; const float* sp = st + pos * 32 + 8 * fq;
                const f32x4 c0 = *(const f32x4*)cp, c1 = *(const f32x4*)(cp + 4), s0 = *(const f32x4*)sp, s1 = *(const f32x4*)(sp + 4);
                const f32x4 a0 = acc[ai][0][m][0] * sc, a1 = acc[ai][0][m][1] * sc, b0 = acc[ai][1][m][0] * sc, b1 = acc[ai][1][m][1] * sc;
                const f32x4 lo0 = a0 * c0 - b0 * s0, lo1 = a1 * c1 - b1 * s1, hi0 = b0 * c0 + a0 * s0, hi1 = b1 * c1 + a1 * s1;
                bf16_t* p = base + (size_t)row * ld + colbase + 8 * fq;
                u32x4 w; w.x = cvt_pk_bf16(lo0[0], lo0[1]); w.y = cvt_pk_bf16(lo0[2], lo0[3]); w.z = cvt_pk_bf16(lo1[0], lo1[1]); w.w = cvt_pk_bf16(lo1[2], lo1[3]);
                *(u32x4*)p = w;
                w.x = cvt_pk_bf16(hi0[0], hi0[1]); w.y = cvt_pk_bf16(hi0[2], hi0[3]); w.z = cvt_pk_bf16(hi1[0], hi1[1]); w.w = cvt_pk_bf16(hi1[2], hi1[3]);
                *(u32x4*)(p + 32) = w;
                if (m & 1) asm volatile("" ::: "memory"); }
    }
    template <int ACT> __device__ __forceinline__ void plain_store(const Acc& acc, int row0, bf16_t* base, int ld, int col0) const {
#pragma unroll
        for (int ai = 0; ai < 2; ++ai)
#pragma unroll
            for (int m = 0; m < 4; ++m) { bf16_t* rowp = base + (size_t)(row0 + ai * HALF + m * 16) * ld + col0;
#pragma unroll
                for (int bj = 0; bj < 2; ++bj) { const f32x4 v0 = acc[ai][bj][m][0], v1 = acc[ai][bj][m][1];
                    u32x4 w;
                    if (ACT == 1) { w.x = sigmoid_pk(v0[0], v0[1]); w.y = sigmoid_pk(v0[2], v0[3]); w.z = sigmoid_pk(v1[0], v1[1]); w.w = sigmoid_pk(v1[2], v1[3]); }
                    else { w.x = cvt_pk_bf16(v0[0], v0[1]); w.y = cvt_pk_bf16(v0[2], v0[3]); w.z = cvt_pk_bf16(v1[0], v1[1]); w.w = cvt_pk_bf16(v1[2], v1[3]); }
                    *(u32x4*)(rowp + bj * HALF) = w; }
                asm volatile("" ::: "memory"); }
    }
    __device__ __forceinline__ void operator()(const Acc& acc, const Unit& u, int wr, int wc, int fr, int fq) const {
        int row0 = u.pm * BM + wr * 64 + fr; const int pn = u.pn;
#define OPAQUE_ROW() asm volatile("" : "+v"(row0))
        if (pn < 2) { OPAQUE_ROW(); rope_store(acc, row0, Q, 512, (4 * pn + wc) * 64, fq, 0.125f * LOG2E); }
        else if (pn == 2) {
            if (wc < 2) { OPAQUE_ROW(); rope_store(acc, row0, K, 128, wc * 64, fq, 1.0f); }
            else { OPAQUE_ROW();
#pragma unroll
                for (int ai = 0; ai < 2; ++ai)
#pragma unroll
                    for (int m = 0; m < 4; ++m) { bf16_t* rowp = V + (size_t)(row0 + ai * HALF + m * 16) * 128 + (wc - 2) * 32 + 8 * fq;
#pragma unroll
                        for (int bj = 0; bj < 2; ++bj) { const f32x4 v0 = acc[ai][bj][m][0], v1 = acc[ai][bj][m][1];
                            u32x4 w; w.x = cvt_pk_bf16(v0[0], v0[1]); w.y = cvt_pk_bf16(v0[2], v0[3]); w.z = cvt_pk_bf16(v1[0], v1[1]); w.w = cvt_pk_bf16(v1[2], v1[3]);
                            *(u32x4*)(rowp + bj * 64) = w; } }
            }
        }
        else if (pn < 5) { OPAQUE_ROW(); plain_store<0>(acc, row0, U, 512, (pn - 3) * BM + wc * 32 + 8 * fq); }
        else { OPAQUE_ROW(); bf16_t* gbase = pn < 9 ? GA : GB; const int gt = pn < 9 ? pn - 5 : pn - 9; plain_store<1>(acc, row0, gbase, D, gt * BM + wc * 32 + 8 * fq); }
#undef OPAQUE_ROW
    }
};

struct EpiMerge {
    static constexpr bool PERM = true, AFTER_DRAIN = false, HAS_MID = true;
    bf16_t* O; const bf16_t* Ga; const bf16_t* Gb;
    __device__ __forceinline__ void mid(Acc& acc, const Unit& u, int wr, int wc, int fr, int fq) const {
        int row0 = u.pm * BM + wr * 64 + fr, col0 = u.pn * BM + wc * 32 + 8 * fq; asm volatile("" : "+v"(row0), "+v"(col0));
#pragma unroll
        for (int ai = 0; ai < 2; ++ai)
#pragma unroll
            for (int m = 0; m < 4; ++m) { const size_t offg = (size_t)(row0 + ai * HALF + m * 16) * D + col0;
#pragma unroll
                for (int bj = 0; bj < 2; ++bj) {
                    const u32x4 a = *(const u32x4*)(Ga + offg + bj * HALF), b = *(const u32x4*)(Gb + offg + bj * HALF);
                    const float r0 = bf_lo(a.x) * __builtin_amdgcn_rcpf(fmaxf(bf_lo(b.x), 1e-30f)), r1 = bf_hi(a.x) * __builtin_amdgcn_rcpf(fmaxf(bf_hi(b.x), 1e-30f));
                    const float r2 = bf_lo(a.y) * __builtin_amdgcn_rcpf(fmaxf(bf_lo(b.y), 1e-30f)), r3 = bf_hi(a.y) * __builtin_amdgcn_rcpf(fmaxf(bf_hi(b.y), 1e-30f));
                    acc[ai][bj][m][0] = acc[ai][bj][m][0] * (f32x4){r0, r1, r2, r3};
                    const float r4 = bf_lo(a.z) * __builtin_amdgcn_rcpf(fmaxf(bf_lo(b.z), 1e-30f)), r5 = bf_hi(a.z) * __builtin_amdgcn_rcpf(fmaxf(bf_hi(b.z), 1e-30f));
                    const float r6 = bf_lo(a.w) * __builtin_amdgcn_rcpf(fmaxf(bf_lo(b.w), 1e-30f)), r7 = bf_hi(a.w) * __builtin_amdgcn_rcpf(fmaxf(bf_hi(b.w), 1e-30f));
                    acc[ai][bj][m][1] = acc[ai][bj][m][1] * (f32x4){r4, r5, r6, r7}; }
                if (m & 1) asm volatile("" ::: "memory"); }
    }
    __device__ __forceinline__ void operator()(const Acc& acc, const Unit& u, int wr, int wc, int fr, int fq) const {
        int row0 = u.pm * BM + wr * 64 + fr, col0 = u.pn * BM + wc * 32 + 8 * fq; asm volatile("" : "+v"(row0), "+v"(col0));
#pragma unroll
        for (int ai = 0; ai < 2; ++ai)
#pragma unroll
            for (int m = 0; m < 4; ++m) { const size_t offg = (size_t)(row0 + ai * HALF + m * 16) * D + col0;
#pragma unroll
                for (int bj = 0; bj < 2; ++bj) { const f32x4 v0 = acc[ai][bj][m][0], v1 = acc[ai][bj][m][1];
                    const u32x4 g = *(const u32x4*)(Gb + offg + bj * HALF);
                    const float q0 = fmaxf(bf_lo(g.x), 1e-30f), q1 = fmaxf(bf_hi(g.x), 1e-30f), q2 = fmaxf(bf_lo(g.y), 1e-30f), q3 = fmaxf(bf_hi(g.y), 1e-30f);
                    const float q4 = fmaxf(bf_lo(g.z), 1e-30f), q5 = fmaxf(bf_hi(g.z), 1e-30f), q6 = fmaxf(bf_lo(g.w), 1e-30f), q7 = fmaxf(bf_hi(g.w), 1e-30f);
                    u32x4 w; w.x = cvt_pk_bf16(v0[0] * q0, v0[1] * q1); w.y = cvt_pk_bf16(v0[2] * q2, v0[3] * q3); w.z = cvt_pk_bf16(v1[0] * q4, v1[1] * q5); w.w = cvt_pk_bf16(v1[2] * q6, v1[3] * q7);
                    *(u32x4*)(O + blk_off(row0 + ai * HALF + m * 16, col0 + bj * HALF, D / 64)) = w; }
                if (m & 1) asm volatile("" ::: "memory"); }
    }
};

template <class Epi, class Sched, bool ALIGN_EPI = false, bool SP2 = false>
__device__ __forceinline__ void gemm_phase(LAS unsigned char* lds, const Gemm g, const Sched& S, const Epi& E) {
    const int tid = threadIdx.x, wid = __builtin_amdgcn_readfirstlane(tid >> 6), lane = tid & 63, wr = wid >> 2, wc = wid & 3, fr = lane & 15, fq = lane >> 4;
    const int K = g.K, nt = K / BK;
    unsigned voffA[2], voffB[2];
#pragma unroll
    for (int i = 0; i < 2; ++i) { int R, C; stage_rc(tid * 16 + i * 8192, R, C); const int Rb = Epi::PERM ? ((R & ~31) + perm32(R & 31)) : R;
        voffA[i] = (unsigned)(R * 64 + C) * 2u; voffB[i] = (unsigned)(Rb * 64 + C) * 2u; }
    const size_t kstep = (size_t)BM * BK * 2;
    const size_t hstep = (size_t)HALF * BK * 2;
    const size_t tstep = (size_t)nt * kstep;
    const unsigned ldsw = (unsigned)wid * 1024u;
    const int aoff = lds_byte(wr * 64 + fr, fq * 8), boff = lds_byte(wc * 32 + fr, fq * 8);
#define PG8_SA(b, h) (((b) * 2 + (h)) * HTB)
#define PG8_SB(b, h) ((4 + (b) * 2 + (h)) * HTB)
#define PG8_STAGE(bufoff, gbase, voff) do { _Pragma("unroll") for (int _i = 0; _i < 2; ++_i) \
        __builtin_amdgcn_global_load_lds((const unsigned*)((const char*)(gbase) + (voff)[_i]), (LAS unsigned*)(lds + (bufoff) + ldsw + _i * 8192), 16, 0, 0); } while (0)
#define PG8_LDA(dst, b, h) do { _Pragma("unroll") for (int m = 0; m < 4; ++m) _Pragma("unroll") for (int k = 0; k < 2; ++k) dst[m][k] = *(const LAS bf16x8*)(lds + PG8_SA(b, h) + aoff + m * 2048 + k * 1024); } while (0)
#define PG8_LDB(dst, b, h) do { _Pragma("unroll") for (int n = 0; n < 2; ++n) _Pragma("unroll") for (int k = 0; k < 2; ++k) dst[n][k] = *(const LAS bf16x8*)(lds + PG8_SB(b, h) + boff + n * 2048 + k * 1024); } while (0)
#define PG8_MMA(ai, bj, At, Bt) do { __builtin_amdgcn_s_setprio(1); _Pragma("unroll") for (int m = 0; m < 4; ++m) _Pragma("unroll") for (int n = 0; n < 2; ++n) _Pragma("unroll") for (int k = 0; k < 2; ++k) \
        acc[ai][bj][m][n] = __builtin_amdgcn_mfma_f32_16x16x32_bf16(Bt[n][k], At[m][k], acc[ai][bj][m][n], 0, 0, 0); __builtin_amdgcn_s_setprio(0); } while (0)
#define PG8_WAIT_V(n) asm volatile("s_waitcnt vmcnt(" #n ")" ::: "memory")
#define PG8_WAIT_V8_UNLESS(f) asm volatile("s_cmp_lg_u32 %0, 0\n\ts_cbranch_scc1 .Lpg8skip%=\n\ts_waitcnt vmcnt(8)\n.Lpg8skip%=:" :: "s"(f) : "scc", "memory")
#define PG8_WAIT_L(n) asm volatile("s_waitcnt lgkmcnt(" #n ")" ::: "memory")
#define PG8_BAR __builtin_amdgcn_s_barrier()
#define PG8_SCHED __builtin_amdgcn_sched_barrier(0)
    Unit cur, nxt; int ui = 0;
    if (!S.next(0, cur)) return;
    f32x4 acc[2][2][4][2];
#pragma unroll
    for (int a = 0; a < 2; ++a)
#pragma unroll
        for (int b = 0; b < 2; ++b)
#pragma unroll
            for (int m = 0; m < 4; ++m)
#pragma unroll
                for (int n = 0; n < 2; ++n) acc[a][b][m][n] = (f32x4){0.f, 0.f, 0.f, 0.f};
    bf16x8 At[4][2], B0[2][2], B1[2][2];
    const char* cA = (const char*)g.A + (size_t)cur.pm * tstep; const char* cB = (const char*)g.Bt + (size_t)cur.pn * tstep;
    S.a_ready(cur);
    if constexpr (SP2) {
        PG8_STAGE(PG8_SB(0, 0), cB, voffB); PG8_STAGE(PG8_SB(0, 1), cB + hstep, voffB); PG8_STAGE(PG8_SA(0, 0), cA, voffA); PG8_STAGE(PG8_SA(0, 1), cA + hstep, voffA);
        if (wr == 1) PG8_BAR;
        PG8_WAIT_V(2); PG8_BAR;
        PG8_STAGE(PG8_SB(1, 0), cB + kstep, voffB); PG8_STAGE(PG8_SA(1, 0), cA + kstep, voffA); PG8_STAGE(PG8_SB(1, 1), cB + hstep + kstep, voffB);
        PG8_WAIT_V(6); PG8_BAR;
    } else {
        PG8_STAGE(PG8_SB(0, 0), cB, voffB); PG8_STAGE(PG8_SA(0, 0), cA, voffA); PG8_STAGE(PG8_SB(0, 1), cB + hstep, voffB); PG8_STAGE(PG8_SA(0, 1), cA + hstep, voffA);
        if (wr == 1) PG8_BAR;
        PG8_WAIT_V(4); PG8_BAR;
        PG8_STAGE(PG8_SB(1, 0), cB + kstep, voffB); PG8_STAGE(PG8_SA(1, 0), cA + kstep, voffA); PG8_STAGE(PG8_SB(1, 1), cB + hstep + kstep, voffB);
        PG8_WAIT_V(6); PG8_BAR;
    }
    for (;;) {
        const bool has_next = S.next(ui + 1, nxt);
        const char* nA = has_next ? (const char*)g.A + (size_t)nxt.pm * tstep : cA; const char* nB = has_next ? (const char*)g.Bt + (size_t)nxt.pn * tstep : cB;
        for (int t = 0; t < nt; t += 2) {
            const bool last = (t == nt - 2);
            const char* a1 = cA + (size_t)(t + 1) * kstep;
            const char* a2 = last ? nA : cA + (size_t)(t + 2) * kstep; const char* b2 = last ? nB : cB + (size_t)(t + 2) * kstep;
            const char* a3 = a2 + kstep; const char* b3 = b2 + kstep;
            if (last && has_next) S.a_ready(nxt);
            if constexpr (SP2) {
            if constexpr (Epi::HAS_MID) { if (t == nt / 2) E.mid(acc, cur, wr, wc, fr, fq); }
            const int fresh = __builtin_amdgcn_readfirstlane(((t == 0) && (ui > 0)) ? 1 : 0);
            PG8_LDB(B0, 0, 0); PG8_LDB(B1, 0, 1); PG8_SCHED; PG8_LDA(At, 0, 0); PG8_STAGE(PG8_SA(1, 1), a1 + hstep, voffA);
            PG8_WAIT_V8_UNLESS(fresh); PG8_WAIT_L(0); PG8_BAR; PG8_MMA(0, 0, At, B0); PG8_MMA(0, 1, At, B1); PG8_BAR; PG8_SCHED;
            PG8_LDA(At, 0, 1); PG8_STAGE(PG8_SB(0, 0), b2, voffB); PG8_STAGE(PG8_SB(0, 1), b2 + hstep, voffB); PG8_STAGE(PG8_SA(0, 0), a2, voffA);
            PG8_WAIT_V8_UNLESS(fresh); PG8_WAIT_L(0); PG8_BAR; PG8_MMA(1, 0, At, B0); PG8_MMA(1, 1, At, B1); PG8_BAR; PG8_SCHED;
            PG8_LDB(B0, 1, 0); PG8_LDB(B1, 1, 1); PG8_SCHED; PG8_LDA(At, 1, 0); PG8_STAGE(PG8_SA(0, 1), a2 + hstep, voffA);
            PG8_WAIT_V(8); PG8_WAIT_L(0); PG8_BAR; PG8_MMA(0, 0, At, B0); PG8_MMA(0, 1, At, B1); PG8_BAR; PG8_SCHED;
            PG8_LDA(At, 1, 1); PG8_STAGE(PG8_SB(1, 0), b3, voffB); PG8_STAGE(PG8_SB(1, 1), b3 + hstep, voffB); PG8_STAGE(PG8_SA(1, 0), a3, voffA);
            PG8_WAIT_V(8); PG8_WAIT_L(0); PG8_BAR; PG8_MMA(1, 0, At, B0); PG8_MMA(1, 1, At, B1); PG8_BAR; PG8_SCHED;
            } else {
            PG8_LDB(B0, 0, 0); PG8_SCHED; PG8_LDA(At, 0, 0); PG8_STAGE(PG8_SA(1, 1), a1 + hstep, voffA);
            PG8_WAIT_L(8); PG8_BAR; PG8_WAIT_L(0); PG8_MMA(0, 0, At, B0); PG8_BAR; PG8_SCHED;
            PG8_LDB(B1, 0, 1); PG8_STAGE(PG8_SB(0, 0), b2, voffB);
            PG8_BAR; PG8_WAIT_L(0); PG8_MMA(0, 1, At, B1); PG8_BAR;
            PG8_LDA(At, 0, 1); PG8_STAGE(PG8_SA(0, 0), a2, voffA);
            PG8_BAR; PG8_WAIT_L(0); PG8_MMA(1, 0, At, B0); PG8_BAR; PG8_SCHED;
            PG8_STAGE(PG8_SB(0, 1), b2 + hstep, voffB);
            PG8_WAIT_V(6); PG8_BAR; PG8_MMA(1, 1, At, B1); PG8_BAR;
            PG8_LDB(B0, 1, 0); PG8_SCHED; PG8_LDA(At, 1, 0); PG8_STAGE(PG8_SA(0, 1), a2 + hstep, voffA);
            PG8_WAIT_L(8); PG8_BAR; PG8_WAIT_L(0); PG8_MMA(0, 0, At, B0); PG8_BAR; PG8_SCHED;
            PG8_LDB(B1, 1, 1); PG8_STAGE(PG8_SB(1, 0), b3, voffB);
            PG8_BAR; PG8_WAIT_L(0); PG8_MMA(0, 1, At, B1); PG8_BAR;
            PG8_LDA(At, 1, 1); PG8_STAGE(PG8_SA(1, 0), a3, voffA);
            PG8_BAR; PG8_WAIT_L(0); PG8_MMA(1, 0, At, B0); PG8_BAR; PG8_SCHED;
            PG8_STAGE(PG8_SB(1, 1), b3 + hstep, voffB);
            PG8_WAIT_V(6); PG8_BAR; PG8_MMA(1, 1, At, B1); PG8_BAR;
            }
        }
        if constexpr (ALIGN_EPI) { if (wr == 0) PG8_BAR; }
        if constexpr (SP2) PG8_WAIT_V(0);
        if constexpr (!Epi::AFTER_DRAIN) { E(acc, cur, wr, wc, fr, fq); S.done(cur); }
        if (!has_next) break;
#pragma unroll
        for (int a = 0; a < 2; ++a)
#pragma unroll
            for (int b = 0; b < 2; ++b)
#pragma unroll
                for (int m = 0; m < 4; ++m)
#pragma unroll
                    for (int n = 0; n < 2; ++n) acc[a][b][m][n] = (f32x4){0.f, 0.f, 0.f, 0.f};
        cur = nxt; cA = nA; cB = nB; ++ui;
        if constexpr (ALIGN_EPI) { if (wr == 1) PG8_BAR; }
    }
    PG8_WAIT_V(0);
    if constexpr (!ALIGN_EPI) { if (wr == 0) PG8_BAR; }
    PG8_BAR;
#undef PG8_SA
#undef PG8_SB
#undef PG8_STAGE
#undef PG8_LDA
#undef PG8_LDB
#undef PG8_MMA
#undef PG8_WAIT_V
#undef PG8_WAIT_V8_UNLESS
#undef PG8_WAIT_L
#undef PG8_BAR
#undef PG8_SCHED
}
}

#define XB_TMO      128
#define XB_XCNT(j)  (256  + 64 * (j))
#define XB_XSUB(j)  (1280 + 64 * (j))
#define XB_XGEN(j)  (2304 + 64 * (j))
#define XB_TOP      3328
#define XB_TOPGEN   3392
#define XCD_BAR_WORDS 3456
#define XB_SPIN_CAP (1u << 22)
__device__ __forceinline__ unsigned xb_ld(unsigned* p)              { return __hip_atomic_load(p, __ATOMIC_RELAXED, __HIP_MEMORY_SCOPE_AGENT); }
__device__ __forceinline__ unsigned xb_add(unsigned* p, unsigned v) { return __hip_atomic_fetch_add(p, v, __ATOMIC_RELAXED, __HIP_MEMORY_SCOPE_AGENT); }
__device__ __forceinline__ unsigned xb_xcc_id() { return (unsigned)__builtin_amdgcn_s_getreg((3 << 11) | 20) & 0xFu; }
#define XB_SPIN(cond, bar) do { unsigned _sp = 0; while (cond) { __builtin_amdgcn_s_sleep(1); \
    if ((++_sp & 255u) == 0u) { if (xb_ld(&(bar)[XB_TMO])) break; if (_sp > XB_SPIN_CAP) { atomicAdd(&(bar)[XB_TMO], 1u); break; } } } } while (0)
struct XcdBarrier { unsigned* bar; unsigned x; volatile LAS unsigned* st; };
__device__ __forceinline__ XcdBarrier xcd_barrier_post(unsigned* bar, volatile LAS unsigned* st) {
    XcdBarrier b; b.bar = bar; b.x = xb_xcc_id(); b.st = st;
    if (threadIdx.x == 0) st[2] = xb_add(&bar[XB_XCNT(b.x)], 1u);
    return b;
}
__device__ __forceinline__ void xcd_barrier_complete(unsigned* bar, unsigned x, unsigned& nloc, unsigned& nx) {
    const unsigned G = gridDim.x * gridDim.y * gridDim.z;
    unsigned sum, cnt, mine, sp = 0u;
    for (;;) {
        sum = 0u; cnt = 0u; mine = 0u;
#pragma unroll
        for (unsigned j = 0; j < 16; ++j) { const unsigned c = xb_ld(&bar[XB_XCNT(j)]); sum += c; cnt += (c > 0u) ? 1u : 0u; mine = (j == x) ? c : mine; }
        if (sum == G) break;
        __builtin_amdgcn_s_sleep(1);
        if ((++sp & 255u) == 0u) { if (xb_ld(&bar[XB_TMO])) break; if (sp > XB_SPIN_CAP) { atomicAdd(&bar[XB_TMO], 1u); break; } }
    }
    nloc = mine > 0u ? mine : 1u; nx = cnt > 0u ? cnt : 1u;
}
__device__ __forceinline__ void xcd_barrier(const XcdBarrier& b) {
    asm volatile("s_waitcnt vmcnt(0)" ::: "memory");
    __syncthreads();
    if (threadIdx.x == 0) {
        unsigned* bar = b.bar;
        __builtin_amdgcn_s_waitcnt(0);
        unsigned nloc = b.st[0], nx = b.st[1];
        if (nloc == 0u) { xcd_barrier_complete(bar, b.x, nloc, nx); b.st[0] = nloc; b.st[1] = nx; }
        const unsigned old = xb_add(&bar[XB_XSUB(b.x)], 1u);
        const unsigned gen = old / nloc;
        if (old + 1u == (gen + 1u) * nloc) {
            __builtin_amdgcn_fence(__ATOMIC_RELEASE, "agent");
            asm volatile("s_waitcnt vmcnt(0)" ::: "memory");
            const unsigned og = xb_add(&bar[XB_TOP], 1u);
            const unsigned tg = og / nx;
            if (og + 1u == (tg + 1u) * nx) xb_add(&bar[XB_TOPGEN], 1u);
            else XB_SPIN(xb_ld(&bar[XB_TOPGEN]) == tg, bar);
            __builtin_amdgcn_fence(__ATOMIC_ACQUIRE, "agent");
            xb_add(&bar[XB_XGEN(b.x)], 1u);
            asm volatile("s_waitcnt vmcnt(0)" ::: "memory");
        } else {
            XB_SPIN(xb_ld(&bar[XB_XGEN(b.x)]) == gen, bar);
            __builtin_amdgcn_fence(__ATOMIC_ACQUIRE, "agent");
            asm volatile("s_waitcnt vmcnt(0)" ::: "memory");
        }
    }
    __syncthreads();
}

struct Args { const float* in[21]; float* out; unsigned char* ws; int ph_lo, ph_hi; };
enum { I_XP = 0, I_XS, I_CP, I_CS, I_ADAW, I_ADAB, I_NPRE, I_NPOST, I_F1G, I_F1U, I_F1D, I_WIN, I_SINK, I_WAB, I_POOLW, I_POOLS, I_WPB, I_WOUT, I_F2G, I_F2U, I_F2D };

__device__ __forceinline__ int map_row(int mode, int n0) {
    if (mode == 0) return n0;
    if (mode == 1) return 256 * (n0 >> 7) + (n0 & 127);
    if (mode == 2) return 256 * (n0 >> 7) + 128 + (n0 & 127);
    if (n0 < 512) { const int head = n0 >> 6, half = (n0 >> 5) & 1; return 256 * (head >> 2) + 128 * half + (head & 3) * 32; }
    if (n0 < 640) { const int kh = (n0 - 512) >> 6, half = (n0 >> 5) & 1; return 512 + 128 * half + kh * 32; }
    if (n0 < 768) { const int vv = n0 - 640; return 512 + 128 * (vv >> 6) + 64 + (vv & 63); }
    return n0;
}
__device__ __forceinline__ void transpose_item(const float* W, int K, int N, bf16_t* WT, int KB, int mode, LAS float* scr, int item, int lane) {
    const int nblk = N / 32, kb = item / nblk, nb = item % nblk, k0 = 64 * kb, n0 = 32 * nb;
#pragma unroll 8
    for (int i = 0; i < 32; ++i) { const int kk = 2 * i + (lane >> 5); scr[kk * 33 + (lane & 31)] = W[(size_t)(k0 + kk) * N + n0 + (lane & 31)]; }
    LDS_WAIT();
    const int rb = map_row(mode, n0);
    const int c = lane & 7;
#pragma unroll
    for (int j = 0; j < 4; ++j) { const int n = (lane >> 3) + 8 * j; const LAS float* s = scr + (8 * c) * 33 + n;
        u32x4 o; o.x = cvt_pk_bf16(s[0 * 33], s[1 * 33]); o.y = cvt_pk_bf16(s[2 * 33], s[3 * 33]); o.z = cvt_pk_bf16(s[4 * 33], s[5 * 33]); o.w = cvt_pk_bf16(s[6 * 33], s[7 * 33]);
        *(u32x4*)(WT + blk_off(rb + n, k0 + 8 * c, KB)) = o; }
    LDS_WAIT();
}

__device__ __forceinline__ void mod_phase(LAS unsigned char* lds, const Args& a, int G, int bid) {
    const int tid = threadIdx.x, lane = tid & 63, wid = tid >> 6;
    LAS float* sc = (LAS float*)lds;
    LAS float* part = (LAS float*)(lds + 40960);
    for (int i = tid; i < NSEQ * D; i += 512) { const int b = i >> 10, k = i & 1023; const float c = (b < NPROMPT) ? a.in[I_CP][b * D + k] : a.in[I_CS][(b - NPROMPT) * D + k]; sc[i] = c / (1.0f + expf(-c)); }
    __syncthreads();
    float* mod = (float*)(a.ws + WS_MOD);
    for (int it = bid; it < NMOD / 36; it += G) {
        const int j0 = it * 36; const int ln = lane < 36 ? lane : 35;
        float acc[NSEQ];
#pragma unroll
        for (int b = 0; b < NSEQ; ++b) acc[b] = 0.f;
        const float* w = a.in[I_ADAW] + (size_t)(wid * 128) * NMOD + j0 + ln;
#pragma unroll 16
        for (int k = 0; k < 128; ++k) { const float wv = w[(size_t)k * NMOD];
#pragma unroll
            for (int b = 0; b < NSEQ; ++b) acc[b] += sc[b * D + wid * 128 + k] * wv; }
#pragma unroll
        for (int b = 0; b < NSEQ; ++b) part[(wid * NSEQ + b) * 64 + lane] = acc[b];
        __syncthreads();
        for (int i = tid; i < NSEQ * 36; i += 512) { const int b = i / 36, l = i - b * 36; float s = a.in[I_ADAB][j0 + l];
#pragma unroll
            for (int w8 = 0; w8 < 8; ++w8) s += part[(w8 * NSEQ + b) * 64 + l];
            mod[b * NMOD + j0 + l] = s; }
        __syncthreads();
    }
}

__device__ __forceinline__ void prep_phase(LAS unsigned char* lds, const Args& a, int G, int bid) {
    const int tid = threadIdx.x, lane = tid & 63, wid = tid >> 6;
    unsigned char* ws = a.ws;
    LAS float* scr = (LAS float*)(lds + wid * 16384);
    const int gw = bid * 8 + wid, NGW = G * 8;
    constexpr int I_GU = (D / 64) * (FF / 32), I_DN = (FF / 64) * (D / 32), I_IN = (D / 64) * (NIN / 32), I_AB = (512 / 64) * (D / 32), I_OUT = (D / 64) * (D / 32);
    constexpr int NITEMS = 4 * I_GU + 2 * I_DN + I_IN + I_AB + I_OUT;
    for (int it = gw; it < NITEMS; it += NGW) {
        int r = it;
        if (r < I_GU) { transpose_item(a.in[I_F1G], D, FF, (bf16_t*)(ws + WS_W1GU), D / 64, 1, scr, r, lane); continue; } r -= I_GU;
        if (r < I_GU) { transpose_item(a.in[I_F1U], D, FF, (bf16_t*)(ws + WS_W1GU), D / 64, 2, scr, r, lane); continue; } r -= I_GU;
        if (r < I_GU) { transpose_item(a.in[I_F2G], D, FF, (bf16_t*)(ws + WS_W2GU), D / 64, 1, scr, r, lane); continue; } r -= I_GU;
        if (r < I_GU) { transpose_item(a.in[I_F2U], D, FF, (bf16_t*)(ws + WS_W2GU), D / 64, 2, scr, r, lane); continue; } r -= I_GU;
        if (r < I_DN) { transpose_item(a.in[I_F1D], FF, D, (bf16_t*)(ws + WS_W1D), FF / 64, 0, scr, r, lane); continue; } r -= I_DN;
        if (r < I_DN) { transpose_item(a.in[I_F2D], FF, D, (bf16_t*)(ws + WS_W2D), FF / 64, 0, scr, r, lane); continue; } r -= I_DN;
        if (r < I_IN) { transpose_item(a.in[I_WIN], D, NIN, (bf16_t*)(ws + WS_WIN), D / 64, 3, scr, r, lane); continue; } r -= I_IN;
        if (r < I_AB) { transpose_item(a.in[I_WAB], 512, D, (bf16_t*)(ws + WS_WAB), D / 64, 0, scr, r, lane); continue; } r -= I_AB;
        transpose_item(a.in[I_WOUT], D, D, (bf16_t*)(ws + WS_WOUT), D / 64, 0, scr, r, lane);
    }
    {
        const float* pw = a.in[I_POOLW]; const float* ps = a.in[I_POOLS]; const float* wpb = a.in[I_WPB]; bf16_t* o = (bf16_t*)(ws + WS_WAB);
        for (int it = gw; it < 2048; it += NGW) {
            const int nq = it & 3, c = (it >> 2) & 127, g = it >> 9;
            scr[lane] = pw[(g * 128 + c) * 128 + lane] * ps[g * 128 + lane];
            scr[lane + 64] = pw[(g * 128 + c) * 128 + lane + 64] * ps[g * 128 + lane + 64];
            LDS_WAIT();
            for (int nc = 0; nc < 4; ++nc) { const int n = nq * 256 + nc * 64 + lane; float s = 0.f; const float* wp = wpb + (size_t)(g * 128) * D + n;
#pragma unroll 8
                for (int d = 0; d < 128; ++d) s += scr[d] * wp[(size_t)d * D];
                o[blk_off(n, 512 + g * 128 + c, 16)] = (bf16_t)(cvt_pk_bf16(s, 0.f) & 0xffffu); }
            LDS_WAIT();
        }
    }
    {
        float* ct = (float*)(ws + WS_CT); float* st = (float*)(ws + WS_ST);
        for (int i = bid * 512 + tid; i < SEQ * 32; i += G * 512) { const int pos = i >> 5, f = i & 31;
            const float inv = exp2f(-(float)f * (13.287712379549449f / 32.0f));
            const float ang = (float)pos * inv;
            const double ad = (double)ang; const double kk = rint(ad * 0.15915494309189535);
            double r = fma(-kk, 6.283185307179586, ad); r = fma(-kk, 2.4492935982947064e-16, r);
            const float rf = (float)r;
            ct[i] = cosf(rf); st[i] = sinf(rf); }
    }
}

__device__ __forceinline__ const float* xrow_in(const Args& a, int row) { return row < NPROMPT * SEQ ? a.in[I_XP] + (size_t)row * D : a.in[I_XS] + (size_t)(row - NPROMPT * SEQ) * D; }

template <int MODE, bool XF32> __device__ __forceinline__ void norm_phase(const Args& a, int j, float rw, int G, int bid, const bf16_t* Xin, const bf16_t* Yin, bf16_t* Xout) {
    const int tid = threadIdx.x, lane = tid & 63, wid = tid >> 6;
    const int gw = bid * 8 + wid, NGW = G * 8;
    const float* mod = (const float*)(a.ws + WS_MOD);
    bf16_t* H = (bf16_t*)(a.ws + WS_H);
    const int rpw = (((T + NGW - 1) / NGW) + 3) & ~3;
    const int r0 = gw * rpw, r1 = (r0 + rpw) < T ? (r0 + rpw) : T;
    int cur_b = -1;
    f32x4 pA[4], pB[4], pC[4];
#pragma unroll
    for (int q = 0; q < 4; ++q) { pA[q] = (f32x4){0.f, 0.f, 0.f, 0.f}; pB[q] = pA[q]; pC[q] = pA[q]; }
    for (int r = r0; r < r1; r += 4) {
        const int b = r >> 13;
        if (b != cur_b) { cur_b = b;
            if (MODE != 0) { const f32x4* gp = (const f32x4*)(a.in[I_NPOST] + j * D) + lane; const f32x4* gt = (const f32x4*)(mod + (size_t)b * NMOD + j * 3 * D + 2 * D) + lane;
#pragma unroll
                for (int q = 0; q < 4; ++q) pA[q] = gp[64 * q] * (gt[64 * q] * rw); }
            if (MODE != 2) { const int jn = (MODE == 0) ? j : j + 1;
                const f32x4* gp = (const f32x4*)(a.in[I_NPRE] + jn * D) + lane; const f32x4* sh = (const f32x4*)(mod + (size_t)b * NMOD + jn * 3 * D) + lane; const f32x4* sc = sh + D / 4;
#pragma unroll
                for (int q = 0; q < 4; ++q) { pB[q] = gp[64 * q] * (sc[64 * q] + 1.0f); pC[q] = sh[64 * q]; } }
        }
        f32x4 x[4][4]; u32x2 yw[4][4];
#pragma unroll
        for (int i = 0; i < 4; ++i) { const int row = (r + i) < r1 ? (r + i) : (r1 - 1);
            if (XF32) { const f32x4* xr = (const f32x4*)xrow_in(a, row) + lane;
#pragma unroll
                for (int q = 0; q < 4; ++q) x[i][q] = xr[64 * q]; }
            else { const u32x2* xr = (const u32x2*)(Xin + (size_t)row * D) + lane;
#pragma unroll
                for (int q = 0; q < 4; ++q) { const u32x2 w = xr[64 * q]; x[i][q] = (f32x4){bf_lo(w.x), bf_hi(w.x), bf_lo(w.y), bf_hi(w.y)}; } }
            if (MODE != 0) { const u32x2* yr = (const u32x2*)(Yin + (size_t)row * D) + lane;
#pragma unroll
                for (int q = 0; q < 4; ++q) yw[i][q] = yr[64 * q]; }
        }
#pragma unroll
        for (int i = 0; i < 4; ++i) { const int row = r + i; const bool live = row < r1;
            if (MODE != 0) {
                f32x4 y[4]; float ss = 0.f;
#pragma unroll
                for (int q = 0; q < 4; ++q) { const u32x2 w = yw[i][q]; y[q] = (f32x4){bf_lo(w.x), bf_hi(w.x), bf_lo(w.y), bf_hi(w.y)};
                    ss += (y[q][0] * y[q][0] + y[q][1] * y[q][1]) + (y[q][2] * y[q][2] + y[q][3] * y[q][3]); }
                const float rstd = rsqrtf(wave_sum(ss) * (1.0f / D) + EPS);
#pragma unroll
                for (int q = 0; q < 4; ++q) x[i][q] = x[i][q] + (y[q] * rstd) * pA[q];
                if (MODE == 2) { f32x4* xo = (f32x4*)(a.out + (size_t)row * D) + lane;
#pragma unroll
                    for (int q = 0; q < 4; ++q) if (live) xo[64 * q] = x[i][q]; }
                else { u32x2* xo = (u32x2*)(Xout + (size_t)row * D) + lane;
#pragma unroll
                    for (int q = 0; q < 4; ++q) { u32x2 w; w.x = cvt_pk_bf16(x[i][q][0], x[i][q][1]); w.y = cvt_pk_bf16(x[i][q][2], x[i][q][3]); if (live) xo[64 * q] = w; } }
            }
            if (MODE != 2) {
                float ss = 0.f;
#pragma unroll
                for (int q = 0; q < 4; ++q) ss += (x[i][q][0] * x[i][q][0] + x[i][q][1] * x[i][q][1]) + (x[i][q][2] * x[i][q][2] + x[i][q][3] * x[i][q][3]);
                const float rstd = rsqrtf(wave_sum(ss) * (1.0f / D) + EPS);
#pragma unroll
                for (int q = 0; q < 4; ++q) { const f32x4 h = (x[i][q] * rstd) * pB[q] + pC[q];
                    u32x2 w; w.x = cvt_pk_bf16(h[0], h[1]); w.y = cvt_pk_bf16(h[2], h[3]); if (live) *(u32x2*)(H + blk_off(row, 4 * lane + 256 * q, D / 64)) = w; }
            }
        }
    }
}

namespace att {
constexpr int KSTR = 144;
constexpr int VSTR = 784;
constexpr int K_OFF = 0, V_OFF = 384 * KSTR, BYTES = V_OFF + 64 * VSTR;
static_assert(BYTES <= 131072, "attention LDS");
}
__device__ __forceinline__ void attn_phase(LAS unsigned char* lds, const bf16_t* Q, const bf16_t* K, const bf16_t* V, bf16_t* O, const float* sink, int G, int bid) {
    using namespace att;
    const int tid = threadIdx.x, lane = tid & 63, wid = tid >> 6, fr = lane & 15, fq = lane >> 4;
    for (int unit = bid; unit < NSEQ * 64 * 2; unit += G) {
        const int kvh = unit & 1, blk = (unit >> 1) & 63, b = unit >> 7;
        const size_t seq0 = (size_t)b * SEQ;
        const int kp0 = (blk - 1) * 128;
        __syncthreads();
#pragma unroll
        for (int it = 0; it < 6; ++it) {
            const int id = tid + 512 * it, row = id >> 3, ch = id & 7; const int kpos = kp0 + row;
            u32x4 kv = {0u, 0u, 0u, 0u}, vv = {0u, 0u, 0u, 0u};
            if (kpos >= 0 && kpos < SEQ) { const size_t off = (seq0 + kpos) * 128 + kvh * 64 + ch * 8; kv = *(const u32x4*)(K + off); vv = *(const u32x4*)(V + off); }
            *(LAS u32x4*)(lds + K_OFF + row * KSTR + ch * 16) = kv;
            LAS unsigned short* vt = (LAS unsigned short*)(lds + V_OFF + (ch * 8) * VSTR + row * 2);
            vt[0 * (VSTR / 2)] = (unsigned short)(vv.x & 0xffffu); vt[1 * (VSTR / 2)] = (unsigned short)(vv.x >> 16);
            vt[2 * (VSTR / 2)] = (unsigned short)(vv.y & 0xffffu); vt[3 * (VSTR / 2)] = (unsigned short)(vv.y >> 16);
            vt[4 * (VSTR / 2)] = (unsigned short)(vv.z & 0xffffu); vt[5 * (VSTR / 2)] = (unsigned short)(vv.z >> 16);
            vt[6 * (VSTR / 2)] = (unsigned short)(vv.w & 0xffffu); vt[7 * (VSTR / 2)] = (unsigned short)(vv.w >> 16);
        }
        __syncthreads();
        const int qg = __builtin_amdgcn_readfirstlane(wid);
        const int r = qg * 16 + fr;
        const size_t qrow = seq0 + (size_t)blk * 128 + r;
        const bool edge = (blk == 0) || (blk == 63);
#pragma unroll 1
        for (int hp = 0; hp < 2; ++hp) {
            const int headA = kvh * 4 + 2 * hp;
            const bf16_t* qp = Q + qrow * 512 + headA * 64 + fq * 8;
            const bf16x8 qA0 = *(const bf16x8*)qp, qA1 = *(const bf16x8*)(qp + 32), qB0 = *(const bf16x8*)(qp + 64), qB1 = *(const bf16x8*)(qp + 96);
            f32x4 sA[17], sB[17];
            int lofs = 0; asm volatile("" : "+v"(lofs));
            const LAS unsigned char* kb = lds + K_OFF + (qg * 16 + fr) * KSTR + fq * 16 + lofs;
#pragma unroll
            for (int t = 0; t < 17; ++t) {
                const bf16x8 k0 = *(const LAS bf16x8*)(kb + t * 16 * KSTR), k1 = *(const LAS bf16x8*)(kb + t * 16 * KSTR + 64);
                f32x4 c = {0.f, 0.f, 0.f, 0.f}, d = {0.f, 0.f, 0.f, 0.f};
                c = __builtin_amdgcn_mfma_f32_16x16x32_bf16(k0, qA0, c, 0, 0, 0); d = __builtin_amdgcn_mfma_f32_16x16x32_bf16(k0, qB0, d, 0, 0, 0);
                c = __builtin_amdgcn_mfma_f32_16x16x32_bf16(k1, qA1, c, 0, 0, 0); d = __builtin_amdgcn_mfma_f32_16x16x32_bf16(k1, qB1, d, 0, 0, 0);
                sA[t] = c; sB[t] = d;
            }
#pragma unroll
            for (int e = 0; e < 4; ++e) { if (fq * 4 + e < fr) { sA[0][e] = -1e30f; sB[0][e] = -1e30f; } if (fq * 4 + e > fr) { sA[16][e] = -1e30f; sB[16][e] = -1e30f; } }
            if (edge) {
#pragma unroll
                for (int t = 0; t < 17; ++t) { const int jt = qg + t; if ((blk == 0 && jt < 8) || (blk == 63 && jt >= 16)) { sA[t] = (f32x4){-1e30f, -1e30f, -1e30f, -1e30f}; sB[t] = sA[t]; } }
            }
            u32x4 pA[8], pB[8]; u32x2 pA16, pB16; float invA, invB;
#define SOFTMAX_PACK(S_, P_, P16_, INV_, HEAD_) do { \
            const float skl = sink[HEAD_] * LOG2E; float mx = skl; \
            _Pragma("unroll") for (int t = 0; t < 17; ++t) mx = fmaxf(mx, fmaxf(fmaxf(S_[t][0], S_[t][1]), fmaxf(S_[t][2], S_[t][3]))); \
            mx = fmaxf(mx, __shfl_xor(mx, 16)); mx = fmaxf(mx, __shfl_xor(mx, 32)); \
            f32x4 lv = {0.f, 0.f, 0.f, 0.f}; \
            _Pragma("unroll") for (int t = 0; t < 17; ++t) { const f32x4 dd = S_[t] - mx; f32x4 p; \
                p[0] = __builtin_amdgcn_exp2f(dd[0]); p[1] = __builtin_amdgcn_exp2f(dd[1]); p[2] = __builtin_amdgcn_exp2f(dd[2]); p[3] = __builtin_amdgcn_exp2f(dd[3]); S_[t] = p; lv += p; } \
            float l = (lv[0] + lv[1]) + (lv[2] + lv[3]); l += __shfl_xor(l, 16); l += __shfl_xor(l, 32); l += __builtin_amdgcn_exp2f(skl - mx); INV_ = 1.0f / l; \
            _Pragma("unroll") for (int pp = 0; pp < 8; ++pp) { P_[pp].x = cvt_pk_bf16(S_[2 * pp][0], S_[2 * pp][1]); P_[pp].y = cvt_pk_bf16(S_[2 * pp][2], S_[2 * pp][3]); \
                P_[pp].z = cvt_pk_bf16(S_[2 * pp + 1][0], S_[2 * pp + 1][1]); P_[pp].w = cvt_pk_bf16(S_[2 * pp + 1][2], S_[2 * pp + 1][3]); } \
            P16_.x = cvt_pk_bf16(S_[16][0], S_[16][1]); P16_.y = cvt_pk_bf16(S_[16][2], S_[16][3]); } while (0)
            SOFTMAX_PACK(sA, pA, pA16, invA, headA);
            SOFTMAX_PACK(sB, pB, pB16, invB, headA + 1);
#undef SOFTMAX_PACK
            f32x4 oA[4], oB[4];
#pragma unroll
            for (int dt = 0; dt < 4; ++dt) { oA[dt] = (f32x4){0.f, 0.f, 0.f, 0.f}; oB[dt] = oA[dt]; }
#pragma unroll
            for (int pp = 0; pp < 8; ++pp) {
                const bf16x8 pfA = __builtin_bit_cast(bf16x8, pA[pp]), pfB = __builtin_bit_cast(bf16x8, pB[pp]);
#pragma unroll
                for (int dt = 0; dt < 4; ++dt) {
                    const LAS unsigned char* vb = lds + V_OFF + (dt * 16 + fr) * VSTR + ((qg + 2 * pp) * 16 + fq * 4) * 2 + lofs;
                    const u32x2 va = *(const LAS u32x2*)vb, vc = *(const LAS u32x2*)(vb + 32);
                    u32x4 vw; vw.x = va.x; vw.y = va.y; vw.z = vc.x; vw.w = vc.y;
                    const bf16x8 vf = __builtin_bit_cast(bf16x8, vw);
                    oA[dt] = __builtin_amdgcn_mfma_f32_16x16x32_bf16(vf, pfA, oA[dt], 0, 0, 0);
                    oB[dt] = __builtin_amdgcn_mfma_f32_16x16x32_bf16(vf, pfB, oB[dt], 0, 0, 0);
                }
            }
            {
                const s16x4 pfA = __builtin_bit_cast(s16x4, pA16), pfB = __builtin_bit_cast(s16x4, pB16);
#pragma unroll
                for (int dt = 0; dt < 4; ++dt) {
                    const LAS unsigned char* vb = lds + V_OFF + (dt * 16 + fr) * VSTR + ((qg + 16) * 16 + fq * 4) * 2 + lofs;
                    const s16x4 vf = __builtin_bit_cast(s16x4, *(const LAS u32x2*)vb);
                    oA[dt] = __builtin_amdgcn_mfma_f32_16x16x16bf16_1k(vf, pfA, oA[dt], 0, 0, 0);
                    oB[dt] = __builtin_amdgcn_mfma_f32_16x16x16bf16_1k(vf, pfB, oB[dt], 0, 0, 0);
                }
            }
            bf16_t* op = O + blk_off((int)qrow, headA * 64 + fq * 4, 16);
#pragma unroll
            for (int dt = 0; dt < 4; ++dt) { u32x2 w; w.x = cvt_pk_bf16(oA[dt][0] * invA, oA[dt][1] * invA); w.y = cvt_pk_bf16(oA[dt][2] * invA, oA[dt][3] * invA); *(u32x2*)(op + dt * 16) = w;
                w.x = cvt_pk_bf16(oB[dt][0] * invB, oB[dt][1] * invB); w.y = cvt_pk_bf16(oB[dt][2] * invB, oB[dt][3] * invB); *(u32x2*)(op + 16384 + dt * 16) = w; }
        }
    }
}
__device__ __forceinline__ void pool_phase(LAS unsigned char* lds, const bf16_t* U, bf16_t* P, int G, int bid) {
    constexpr int RS = 1040;
    const int tid = threadIdx.x, c = tid & 63, sub = tid >> 6, g = c >> 4, hw = 1 << g;
    for (int unit = bid; unit < NSEQ * 128; unit += G) {
        const int b = unit >> 7, s0 = (unit & 127) * 64; const size_t seqrow = (size_t)b * SEQ;
        __syncthreads();
#pragma unroll
        for (int it = 0; it < 10; ++it) { const int id = tid + 512 * it, row = id >> 6, ch = id & 63, sp = s0 - 8 + row;
            u32x4 v = {0u, 0u, 0u, 0u}; if (sp >= 0 && sp < SEQ) v = *(const u32x4*)(U + (seqrow + sp) * 512 + ch * 8);
            *(LAS u32x4*)(lds + row * RS + ch * 16) = v; }
        __syncthreads();
        const int rbase = sub * 8 + 8;
        const LAS unsigned char* col = lds + c * 16;
        float S[8];
#pragma unroll
        for (int e = 0; e < 8; ++e) S[e] = 0.f;
#pragma unroll
        for (int k = 0; k < 16; ++k) if (k < 2 * hw) { const u32x4 w = *(const LAS u32x4*)(col + (rbase - hw + k) * RS);
            S[0] += bf_lo(w.x); S[1] += bf_hi(w.x); S[2] += bf_lo(w.y); S[3] += bf_hi(w.y); S[4] += bf_lo(w.z); S[5] += bf_hi(w.z); S[6] += bf_lo(w.w); S[7] += bf_hi(w.w); }
#pragma unroll
        for (int k = 0; k < 8; ++k) { const int sp = s0 + sub * 8 + k; const int lo = (sp - hw) < 0 ? 0 : (sp - hw), hi = (sp + hw) > SEQ ? SEQ : (sp + hw);
            const float ic = 1.0f / (float)(hi - lo);
            const u32x4 w = *(const LAS u32x4*)(col + (rbase + k) * RS);
            u32x4 o; o.x = cvt_pk_bf16(S[0] * ic - bf_lo(w.x), S[1] * ic - bf_hi(w.x)); o.y = cvt_pk_bf16(S[2] * ic - bf_lo(w.y), S[3] * ic - bf_hi(w.y));
            o.z = cvt_pk_bf16(S[4] * ic - bf_lo(w.z), S[5] * ic - bf_hi(w.z)); o.w = cvt_pk_bf16(S[6] * ic - bf_lo(w.w), S[7] * ic - bf_hi(w.w));
            *(u32x4*)(P + blk_off((int)(seqrow + sp), 512 + c * 8, 16)) = o;
            if (k < 7) { const u32x4 wa = *(const LAS u32x4*)(col + (rbase + k + hw) * RS), wd = *(const LAS u32x4*)(col + (rbase + k - hw) * RS);
                S[0] += bf_lo(wa.x) - bf_lo(wd.x); S[1] += bf_hi(wa.x) - bf_hi(wd.x); S[2] += bf_lo(wa.y) - bf_lo(wd.y); S[3] += bf_hi(wa.y) - bf_hi(wd.y);
                S[4] += bf_lo(wa.z) - bf_lo(wd.z); S[5] += bf_hi(wa.z) - bf_hi(wd.z); S[6] += bf_lo(wa.w) - bf_lo(wd.w); S[7] += bf_hi(wa.w) - bf_hi(wd.w); }
        }
    }
}

__global__ void __launch_bounds__(512, 2) mega_fwd(Args a) {
    extern __shared__ __attribute__((aligned(16))) unsigned char lds_raw[];
    LAS unsigned char* lds = (LAS unsigned char*)lds_raw;
    const int G = gridDim.x, bid = blockIdx.x;
    unsigned char* ws = a.ws;
#define IN(k) (a.ph_lo <= (k) && (k) < a.ph_hi)
    volatile LAS unsigned* bst = (volatile LAS unsigned*)(lds + 131072);
    if (threadIdx.x < 4) bst[threadIdx.x] = (threadIdx.x == 3) ? (unsigned)blockIdx.x : 0u;
    __syncthreads();
    XcdBarrier xbar = xcd_barrier_post((unsigned*)(ws + WS_CTL), bst);
    if (a.ph_hi > 1000) cg::this_grid().sync();
#define SEAM(k) do { if (IN(k) && IN((k) + 1)) { xcd_barrier(xbar); } } while (0)
    typedef pg8::StaticOrder SO;
    bf16_t* H = (bf16_t*)(ws + WS_H); bf16_t* Y = (bf16_t*)(ws + WS_Y); bf16_t* ACT = (bf16_t*)(ws + WS_BIG); bf16_t* X1 = (bf16_t*)a.out;

    if (IN(0)) mod_phase(lds, a, G, bid);
    SEAM(0);
    if (IN(0) && IN(1)) {
        if (threadIdx.x == 0) { unsigned* bar = (unsigned*)(ws + WS_CTL); bool ok = (G % 8) == 0;
            for (unsigned jx = 0; jx < 16; ++jx) { const unsigned cx = xb_ld(&bar[XB_XCNT(jx)]); ok = ok && (jx < 8 ? cx == (unsigned)(G / 8) : cx == 0u); }
            if (ok) bst[3] = bst[2] * 8u + xbar.x; }
        __syncthreads();
    }
#define VCU() __builtin_amdgcn_readfirstlane((int)bst[3])
    if (IN(1)) { prep_phase(lds, a, G, bid); norm_phase<0, true>(a, 0, 0.f, G, bid, nullptr, nullptr, nullptr); }
    SEAM(1);
    if (IN(2)) for (int rep = 0; rep < MK_GEMM_REP; ++rep) { pg8::Gemm g{H, (const bf16_t*)(ws + WS_W1GU), T, 2 * FF, D}; SO S; S.init(T, 2 * FF, G, VCU()); pg8::EpiSwiGLU E{ACT, FF};
        pg8::gemm_phase<pg8::EpiSwiGLU, SO, true, true>(lds, g, S, E); }
    SEAM(2);
    if (IN(3)) for (int rep = 0; rep < MK_GEMM_REP; ++rep) { pg8::Gemm g{ACT, (const bf16_t*)(ws + WS_W1D), T, D, FF}; SO S; S.init(T, D, G, VCU()); pg8::EpiBf16 E{Y, D};
        pg8::gemm_phase<pg8::EpiBf16, SO, true, true>(lds, g, S, E); }
    SEAM(3);
    if (IN(4)) norm_phase<1, true>(a, 0, 0.5f, G, bid, nullptr, Y, X1);
    SEAM(4);
    if (IN(5)) for (int rep = 0; rep < MK_GEMM_REP; ++rep) { pg8::Gemm g{H, (const bf16_t*)(ws + WS_WIN), T, NIN, D}; SO S; S.init(T, NIN, G, VCU());
        pg8::EpiProj E{(bf16_t*)(ws + WS_Q), (bf16_t*)(ws + WS_K), (bf16_t*)(ws + WS_V), (bf16_t*)(ws + WS_U), (bf16_t*)(ws + WS_GA), (bf16_t*)(ws + WS_GB), (const float*)(ws + WS_CT), (const float*)(ws + WS_ST)};
        pg8::gemm_phase<pg8::EpiProj, SO, true, true>(lds, g, S, E); }
    SEAM(5);
    if (IN(6)) {
        attn_phase(lds, (const bf16_t*)(ws + WS_Q), (const bf16_t*)(ws + WS_K), (const bf16_t*)(ws + WS_V), Y, a.in[I_SINK], G, bid);
        pool_phase(lds, (const bf16_t*)(ws + WS_U), Y, G, bid);
        __syncthreads();
        if (MK_DUP == 6) {
            attn_phase(lds, (const bf16_t*)(ws + WS_Q), (const bf16_t*)(ws + WS_K), (const bf16_t*)(ws + WS_V), Y, a.in[I_SINK], G, bid);
            pool_phase(lds, (const bf16_t*)(ws + WS_U), Y, G, bid);
            __syncthreads();
        }
    }
    SEAM(6);
    if (IN(7)) for (int rep = 0; rep < MK_GEMM_REP; ++rep) { pg8::Gemm g{Y, (const bf16_t*)(ws + WS_WAB), T, D, D}; SO S; S.init(T, D, G, VCU());
        pg8::EpiMerge E{H, (const bf16_t*)(ws + WS_GA), (const bf16_t*)(ws + WS_GB)};
        pg8::gemm_phase<pg8::EpiMerge, SO, true, true>(lds, g, S, E); }
    SEAM(7);
    if (IN(8)) for (int rep = 0; rep < MK_GEMM_REP; ++rep) { pg8::Gemm g{H, (const bf16_t*)(ws + WS_WOUT), T, D, D}; SO S; S.init(T, D, G, VCU()); pg8::EpiBf16 E{Y, D};
        pg8::gemm_phase<pg8::EpiBf16, SO, true, true>(lds, g, S, E); }
    SEAM(8);
    if (IN(9)) norm_phase<1, false>(a, 1, 1.0f, G, bid, X1, Y, Y);
    SEAM(9);
    if (IN(10)) for (int rep = 0; rep < MK_GEMM_REP; ++rep) { pg8::Gemm g{H, (const bf16_t*)(ws + WS_W2GU), T, 2 * FF, D}; SO S; S.init(T, 2 * FF, G, VCU()); pg8::EpiSwiGLU E{ACT, FF};
        pg8::gemm_phase<pg8::EpiSwiGLU, SO, true, true>(lds, g, S, E); }
    SEAM(10);
    if (IN(11)) for (int rep = 0; rep < MK_GEMM_REP; ++rep) { pg8::Gemm g{ACT, (const bf16_t*)(ws + WS_W2D), T, D, FF}; SO S; S.init(T, D, G, VCU()); pg8::EpiBf16 E{H, D};
        pg8::gemm_phase<pg8::EpiBf16, SO, true, true>(lds, g, S, E); }
    SEAM(11);
    if (IN(12)) norm_phase<2, false>(a, 2, 0.5f, G, bid, Y, H, nullptr);
#undef IN
#undef SEAM
}

__global__ void chk_kernel(const unsigned* p, size_t nwords, unsigned long long* dst) {
    unsigned long long s = 0;
    for (size_t i = (size_t)blockIdx.x * blockDim.x + threadIdx.x; i < nwords; i += (size_t)gridDim.x * blockDim.x) s += p[i];
    atomicAdd(dst, s);
}
__global__ void verdict_kernel(const unsigned long long* chk, float* out, size_t n) {
    int code = 0;
    for (int p = 0; p < 6; ++p) if (chk[p] != chk[16 + p]) code |= 1 << p;
    for (size_t i = (size_t)blockIdx.x * blockDim.x + threadIdx.x; i < n; i += (size_t)gridDim.x * blockDim.x) out[i] = (float)code;
}
constexpr int NPHASE = 13;
extern "C" void kernel_launch(void* const* d_in, const int* in_sizes, int n_in, void* d_out, int out_size, void* d_ws, size_t ws_size, hipStream_t stream) {
    static int grid = 0;
    if (grid == 0) {
        if (n_in != 21 || out_size != T * D || ws_size < WS_END) { fprintf(stderr, "kernel_launch: unexpected shapes: n_in %d out %d ws %zu (need %zu)\n", n_in, out_size, ws_size, (size_t)WS_END); grid = -1; return; }
        int dev = 0, cus = 0, per_cu = 0;
        if (hipGetDevice(&dev) != hipSuccess || hipDeviceGetAttribute(&cus, hipDeviceAttributeMultiprocessorCount, dev) != hipSuccess) { grid = -1; return; }
        if (hipFuncSetAttribute((const void*)mega_fwd, hipFuncAttributeMaxDynamicSharedMemorySize, LDS_BYTES) != hipSuccess) { fprintf(stderr, "kernel_launch: hipFuncSetAttribute failed\n"); grid = -1; return; }
        if (hipOccupancyMaxActiveBlocksPerMultiprocessor(&per_cu, (const void*)mega_fwd, 512, LDS_BYTES) != hipSuccess || per_cu < 1) { fprintf(stderr, "kernel_launch: occupancy query says %d\n", per_cu); per_cu = 1; }
        (void)hipGetLastError();
        grid = cus * 1;
    }
    if (grid < 0) return;
    (void)hipMemsetAsync((unsigned char*)d_ws + WS_CTL, 0, CTL_BYTES, stream);
    Args a{};
    for (int i = 0; i < 21; ++i) a.in[i] = (const float*)d_in[i];
    a.out = (float*)d_out; a.ws = (unsigned char*)d_ws;
#if MK_MULTI_LAUNCH == 2
    {
        unsigned char* ws = (unsigned char*)d_ws; unsigned long long* chk = (unsigned long long*)(ws + 900 * MiB);
        (void)hipMemsetAsync(chk, 0, 4096, stream);
        const size_t offs[7] = {WS_Q, WS_K, WS_V, WS_U, WS_GA, WS_GB, WS_END};
        for (int run = 0; run < 2; ++run) {
            for (int p = 0; p < 6; ++p) { a.ph_lo = p; a.ph_hi = p + 1; hipLaunchKernelGGL(mega_fwd, dim3(grid), dim3(512), LDS_BYTES, stream, a); }
            for (int i = 0; i < 6; ++i) hipLaunchKernelGGL(chk_kernel, dim3(2048), dim3(256), 0, stream, (const unsigned*)(ws + offs[i]), (offs[i + 1] - offs[i]) / 4, chk + run * 16 + i);
        }
        hipLaunchKernelGGL(verdict_kernel, dim3(2048), dim3(256), 0, stream, (const unsigned long long*)chk, (float*)d_out, (size_t)T * D);
    }
#elif MK_MULTI_LAUNCH
    for (int p = 0; p < NPHASE; ++p) { const bool is_gemm = (p == 2 || p == 3 || p == 5 || p == 7 || p == 8 || p == 10 || p == 11);
        const int reps = (MK_MULTI_LAUNCH == 3 && is_gemm) ? 2 : ((MK_MULTI_LAUNCH == 4 && !is_gemm && p != 9 && p != 12) ? 2 : 1);
        for (int rep = 0; rep < reps; ++rep) { a.ph_lo = p; a.ph_hi = p + 1; hipLaunchKernelGGL(mega_fwd, dim3(grid), dim3(512), LDS_BYTES, stream, a); } }
#else
    a.ph_lo = 0; a.ph_hi = NPHASE;
    void* args[] = {&a};
    hipError_t e = hipLaunchCooperativeKernel((const void*)mega_fwd, dim3(grid), dim3(512), args, LDS_BYTES, stream);
    if (e != hipSuccess) fprintf(stderr, "kernel_launch: cooperative launch failed: %s (grid %d)\n", hipGetErrorString(e), grid);
#endif
}
```
